# Optimizing an MI355X kernel written in HIP

```python
import jax, jax.numpy as jnp
from jax import lax
import numpy as np

D_MODEL = 1024
BATCH = 4
SEQ = 8192
DEPTH = 2

CHUNK = 64
N_EVEN = (DEPTH + 1) // 2
N_ODD = DEPTH // 2

A_WIDTH = D_MODEL // 2
A_HEADS = 4
A_HEAD_DIM = A_WIDTH // A_HEADS
A_BLOCK = 128
B_WIDTH = D_MODEL // 2
POOL_WINDOWS = (2, 4, 8, 16)
B_GROUPS = len(POOL_WINDOWS)
B_GROUP_DIM = B_WIDTH // B_GROUPS
EVEN_IN = 2 * A_WIDTH + B_WIDTH
EVEN_MIX = A_WIDTH + B_WIDTH

C_WIDTH = D_MODEL // 2
C_KERNEL = 31
D_WIDTH = D_MODEL // 2
D_KERNEL = 3
ODD_IN = 2 * C_WIDTH + 3 * D_WIDTH
ODD_MIX = C_WIDTH + D_WIDTH

D_FF = -(-8 * D_MODEL // (3 * 256)) * 256
EPS = 1e-6

kernel_name = "hybrid_gmlp_pool_conformer_shortconv_trunk"


def rmsnorm(x, g):
    xf = x.astype(jnp.float32)
    y = xf * lax.rsqrt(jnp.mean(xf * xf, axis=-1, keepdims=True) + EPS)
    return (y * g.astype(jnp.float32)).astype(x.dtype)


def layernorm(x, g, b):
    xf = x.astype(jnp.float32)
    mu = jnp.mean(xf, axis=-1, keepdims=True)
    var = jnp.mean(jnp.square(xf - mu), axis=-1, keepdims=True)
    y = (xf - mu) * lax.rsqrt(var + EPS)
    return (y * g.astype(jnp.float32) + b.astype(jnp.float32)).astype(x.dtype)


def causal_depthwise_conv(x, w):
    k, c = w.shape
    return lax.conv_general_dilated(
        x, w[:, None, :].astype(x.dtype), window_strides=(1,), padding=[(k - 1, 0)],
        dimension_numbers=("NWC", "WIO", "NWC"), feature_group_count=c)


def mixer_a(u, v, w_s, b_s, ln_g, ln_b):
    bsz, s, _ = u.shape
    v = layernorm(v, ln_g, ln_b).reshape(bsz, s // A_BLOCK, A_BLOCK, A_HEADS, A_HEAD_DIM)
    pos = jnp.arange(A_BLOCK)
    mask = (pos[:, None] // CHUNK) >= (pos[None, :] // CHUNK)
    w = jnp.where(mask[None], w_s, jnp.zeros_like(w_s))
    sv = jnp.einsum("hij,bnjhd->bnihd", w, v) + b_s.T[None, None, :, :, None]
    return u * sv.reshape(bsz, s, A_WIDTH)


def mixer_b(x, w_pool, scale):
    bsz, s, _ = x.shape
    xf = x.astype(jnp.float32)
    csum = jnp.cumsum(xf, axis=1)
    t = jnp.arange(s)
    outs = []
    for gi, win in enumerate(POOL_WINDOWS):
        sl = slice(gi * B_GROUP_DIM, (gi + 1) * B_GROUP_DIM)
        cg = csum[..., sl]
        shifted = jnp.pad(cg, ((0, 0), (win, 0), (0, 0)))[:, :s]
        cnt = jnp.minimum(t + 1, win).astype(jnp.float32)[None, :, None]
        outs.append((cg - shifted) / cnt - xf[..., sl])
    pooled = jnp.stack(outs, axis=2).astype(x.dtype)
    y = jnp.einsum("bsgc,gcd->bsgd", pooled, w_pool).reshape(bsz, s, B_WIDTH)
    return y * scale


def mixer_c(a, g, w_dw, b_dw, ln_g, ln_b):
    h = a * jax.nn.sigmoid(g)
    h = causal_depthwise_conv(h, w_dw) + b_dw
    h = layernorm(h, ln_g, ln_b)
    return jax.nn.silu(h)


def mixer_d(bg, cg, xin, w_dw):
    return bg * causal_depthwise_conv(cg * xin, w_dw)


def swiglu(h, wg, wu, wd):
    return (jax.nn.silu(h @ wg) * (h @ wu)) @ wd


def setup_inputs(seed: int = 0) -> dict:
    key = jax.random.key(seed)
    ks = jax.random.split(key, 24)
    f = jnp.float32

    def nrm(k, shape, fan_in):
        return jax.random.normal(k, shape, f) * (fan_in ** -0.5)

    def gain(k, shape):
        return jnp.ones(shape, f) + 0.02 * jax.random.normal(k, shape, f)

    def small(k, shape):
        return 0.02 * jax.random.normal(k, shape, f)

    return {
        "x": jax.random.normal(ks[0], (BATCH, SEQ, D_MODEL), f),
        "even_w_in": nrm(ks[1], (N_EVEN, D_MODEL, EVEN_IN), D_MODEL),
        "even_w_out": nrm(ks[2], (N_EVEN, EVEN_MIX, D_MODEL), EVEN_MIX),
        "a_w_s": nrm(ks[3], (N_EVEN, A_HEADS, A_BLOCK, A_BLOCK), A_BLOCK),
        "a_b_s": gain(ks[4], (N_EVEN, A_HEADS, A_BLOCK)),
        "a_ln_g": gain(ks[5], (N_EVEN, A_WIDTH)),
        "a_ln_b": small(ks[6], (N_EVEN, A_WIDTH)),
        "b_w_pool": nrm(ks[7], (N_EVEN, B_GROUPS, B_GROUP_DIM, B_GROUP_DIM), B_GROUP_DIM),
        "b_scale": gain(ks[8], (N_EVEN, B_WIDTH)),
        "odd_w_in": nrm(ks[9], (N_ODD, D_MODEL, ODD_IN), D_MODEL),
        "odd_w_out": nrm(ks[10], (N_ODD, ODD_MIX, D_MODEL), ODD_MIX),
        "c_w_dw": nrm(ks[11], (N_ODD, C_KERNEL, C_WIDTH), C_KERNEL),
        "c_b_dw": small(ks[12], (N_ODD, C_WIDTH)),
        "c_ln_g": gain(ks[13], (N_ODD, C_WIDTH)),
        "c_ln_b": small(ks[14], (N_ODD, C_WIDTH)),
        "d_w_dw": nrm(ks[15], (N_ODD, D_KERNEL, D_WIDTH), D_KERNEL),
        "norm_mix_g": gain(ks[16], (DEPTH, D_MODEL)),
        "norm_ffn_g": gain(ks[17], (DEPTH, D_MODEL)),
        "ffn_w_gate": nrm(ks[18], (DEPTH, D_MODEL, D_FF), D_MODEL),
        "ffn_w_up": nrm(ks[19], (DEPTH, D_MODEL, D_FF), D_MODEL),
        "ffn_w_down": nrm(ks[20], (DEPTH, D_FF, D_MODEL), D_FF),
        "final_norm_g": gain(ks[21], (D_MODEL,)),
    }


def reference(x, even_w_in, even_w_out, a_w_s, a_b_s, a_ln_g, a_ln_b, b_w_pool, b_scale,
              odd_w_in, odd_w_out, c_w_dw, c_b_dw, c_ln_g, c_ln_b, d_w_dw,
              norm_mix_g, norm_ffn_g, ffn_w_gate, ffn_w_up, ffn_w_down, final_norm_g):
    h = x
    for layer in range(DEPTH):
        hn = rmsnorm(h, norm_mix_g[layer])
        if layer % 2 == 0:
            e = layer // 2
            z = hn @ even_w_in[e]
            za = jax.nn.gelu(z[..., :2 * A_WIDTH])
            u, v = za[..., :A_WIDTH], za[..., A_WIDTH:]
            zb = z[..., 2 * A_WIDTH:]
            ya = mixer_a(u, v, a_w_s[e], a_b_s[e], a_ln_g[e], a_ln_b[e])
            yb = mixer_b(zb, b_w_pool[e], b_scale[e])
            h = h + jnp.concatenate([ya, yb], axis=-1) @ even_w_out[e]
        else:
            o = layer // 2
            z = hn @ odd_w_in[o]
            ca = z[..., :C_WIDTH]
            cgt = z[..., C_WIDTH:2 * C_WIDTH]
            off = 2 * C_WIDTH
            dbg = z[..., off:off + D_WIDTH]
            dcg = z[..., off + D_WIDTH:off + 2 * D_WIDTH]
            dxin = z[..., off + 2 * D_WIDTH:]
            yc = mixer_c(ca, cgt, c_w_dw[o], c_b_dw[o], c_ln_g[o], c_ln_b[o])
            yd = mixer_d(dbg, dcg, dxin, d_w_dw[o])
            h = h + jnp.concatenate([yc, yd], axis=-1) @ odd_w_out[o]
        h = h + swiglu(rmsnorm(h, norm_ffn_g[layer]), ffn_w_gate[layer], ffn_w_up[layer],
                       ffn_w_down[layer])
    return rmsnorm(h, final_norm_g)
```

```cpp
#include <hip/hip_runtime.h>
#include <hip/hip_cooperative_groups.h>
#include <cstdio>
#include <cstdint>
namespace cg = cooperative_groups;

#ifndef MK_PER_PHASE
#define MK_PER_PHASE 0
#endif

#define LAS __attribute__((address_space(3)))
typedef unsigned short bf16_t;
typedef short bf16x8 __attribute__((ext_vector_type(8)));
typedef short s16x4 __attribute__((ext_vector_type(4)));
typedef float f32x4 __attribute__((ext_vector_type(4)));
typedef float f32x2 __attribute__((ext_vector_type(2)));
typedef unsigned u32x4 __attribute__((ext_vector_type(4)));
typedef unsigned u32x2 __attribute__((ext_vector_type(2)));

constexpr int M_TOK = 32768, D = 1024, SEQ = 8192;
constexpr int EVEN_IN = 1536, ODD_IN = 2560, DFF = 2816, GU = 2 * DFF;
constexpr float EPS = 1e-6f;
constexpr int NWAVES = 8, NTHREADS = 512;

constexpr size_t MiB = 1u << 20;
constexpr size_t WS_CTL = 0, CTL_BYTES = 1 * MiB;
constexpr size_t WS_WIN0 = 2 * MiB, WS_WOUT0 = 5 * MiB, WS_WGU0 = 7 * MiB, WS_WDN0 = 18 * MiB;
constexpr size_t WS_WIN1 = 24 * MiB, WS_WOUT1 = 29 * MiB, WS_WGU1 = 31 * MiB, WS_WDN1 = 42 * MiB;
constexpr size_t WS_WS = 48 * MiB, WS_WP = 49 * MiB;
constexpr size_t WS_SS = 50 * MiB;
constexpr size_t WS_XB = 64 * MiB;
constexpr size_t WS_Y = 128 * MiB;
constexpr size_t WS_Z = 192 * MiB;
constexpr size_t WS_END = 368 * MiB;

constexpr int LDS_BYTES = 147456;

__device__ __forceinline__ unsigned cvt_pk_bf16(float lo, float hi) { unsigned r; asm volatile("v_cvt_pk_bf16_f32 %0, %1, %2" : "=v"(r) : "v"(lo), "v"(hi)); return r; }
__device__ __forceinline__ float bf_lo(unsigned u) { return __uint_as_float(u << 16); }
__device__ __forceinline__ float bf_hi(unsigned u) { return __uint_as_float(u & 0xffff0000u); }
__device__ __forceinline__ float wave_sum(float v) {
#pragma unroll
    for (int o = 1; o < 64; o <<= 1) v += __shfl_xor(v, o);
    return v;
}
__device__ __forceinline__ float sigmoid_f(float x) { return __builtin_amdgcn_rcpf(1.0f + __expf(-x)); }
__device__ __forceinline__ float silu_f(float x) { return x * sigmoid_f(x); }
__device__ __forceinline__ float gelu_tanh_f(float x) { const float u = 0.7978845608028654f * (x + 0.044715f * x * x * x); return x * sigmoid_f(2.0f * u); }
__device__ __forceinline__ void unpack8(const u32x4 r, float (&v)[8]) {
    v[0] = bf_lo(r.x); v[1] = bf_hi(r.x); v[2] = bf_lo(r.y); v[3] = bf_hi(r.y); v[4] = bf_lo(r.z); v[5] = bf_hi(r.z); v[6] = bf_lo(r.w); v[7] = bf_hi(r.w);
}
__device__ __forceinline__ u32x4 pack8(const float (&v)[8]) {
    u32x4 r; r.x = cvt_pk_bf16(v[0], v[1]); r.y = cvt_pk_bf16(v[2], v[3]); r.z = cvt_pk_bf16(v[4], v[5]); r.w = cvt_pk_bf16(v[6], v[7]); return r;
}
__device__ __forceinline__ float row_rstd(const float* ss, int row) {
    const f32x4* p = (const f32x4*)(ss + (size_t)row * 16);
    const f32x4 a = p[0], b = p[1], c = p[2], d = p[3];
    const f32x4 s = (a + b) + (c + d);
    return rsqrtf(((s.x + s.y) + (s.z + s.w)) * (1.0f / 1024.0f) + EPS);
}

namespace pg8 {
constexpr int BM = 256, BK = 64, HALF = 128, HTB = HALF * BK * 2, STAGE_BYTES = 8 * HTB, NXCD = 8, WGM = 8;
__device__ __forceinline__ int lds_byte(int r, int c) { const int st = (r >> 4) * 2 + (c >> 5), rr = r & 15, cc = c & 31, ob = rr * 64 + cc * 2; return st * 1024 + (ob ^ (((ob >> 9) & 1) << 5)); }
__device__ __forceinline__ void stage_rc(int b, int& R, int& C) { const int st = b / 1024, sb = b % 1024, swz = sb ^ (((sb >> 9) & 1) << 5); R = (st >> 1) * 16 + swz / 64; C = (st & 1) * 32 + (swz % 64) / 2; }
__device__ __forceinline__ int perm32(int rho) { const int n = rho >> 4, i = rho & 15; return 8 * (i >> 2) + 4 * n + (i & 3); }

struct Unit { int pm, pn; };
struct Gemm { const bf16_t* A; const bf16_t* Bt; int M, N, K; };

struct StaticOrder {
    int nM, nN, nwg, G, c;
    __device__ void init(int M, int N, int G_, int c_) { nM = M / BM; nN = N / BM; nwg = nM * nN; G = G_; c = c_; }
    __device__ bool next(int i, Unit& u) const {
        const long L = (long)i * G + c; if (L >= nwg) return false;
        int wgid = (int)L; { const int q = nwg / NXCD, r = nwg % NXCD, xcd = wgid % NXCD, off = wgid / NXCD; wgid = (xcd < r ? xcd * (q + 1) : r * (q + 1) + (xcd - r) * q) + off; }
        const int nig = WGM * nN, gid = wgid / nig, fm = gid * WGM, gsz = (nM - fm) < WGM ? (nM - fm) : WGM;
        u.pm = fm + ((wgid % nig) % gsz); u.pn = (wgid % nig) / gsz; return true;
    }
};

struct EpiScaleBf16 {
    static constexpr bool PERM = true;
    bf16_t* O; int ldc; const float* ss; int gelu_tiles;
    __device__ __forceinline__ void operator()(const f32x4 (&acc)[2][2][4][2], const Unit& u, int wr, int wc, int fr, int fq) const {
        const int row0 = u.pm * BM + wr * 64 + fr, col0 = u.pn * BM + wc * 32 + 8 * fq;
        const bool act = u.pn < gelu_tiles;
#pragma unroll
        for (int ai = 0; ai < 2; ++ai)
#pragma unroll
            for (int m = 0; m < 4; ++m) {
                const int row = row0 + ai * HALF + m * 16; const float rs = row_rstd(ss, row);
                bf16_t* rowp = O + (size_t)row * ldc + col0;
#pragma unroll
                for (int bj = 0; bj < 2; ++bj) {
                    f32x4 v0 = acc[ai][bj][m][0] * rs, v1 = acc[ai][bj][m][1] * rs;
                    if (act) {
#pragma unroll
                        for (int j = 0; j < 4; ++j) { v0[j] = gelu_tanh_f(v0[j]); v1[j] = gelu_tanh_f(v1[j]); }
                    }
                    u32x4 w; w.x = cvt_pk_bf16(v0[0], v0[1]); w.y = cvt_pk_bf16(v0[2], v0[3]); w.z = cvt_pk_bf16(v1[0], v1[1]); w.w = cvt_pk_bf16(v1[2], v1[3]);
                    *(u32x4*)(rowp + bj * HALF) = w;
                }
                if (m & 1) asm volatile("" ::: "memory");
            }
    }
};
struct EpiSwiGLU {
    static constexpr bool PERM = true;
    bf16_t* O; const float* ss;
    __device__ __forceinline__ void operator()(const f32x4 (&acc)[2][2][4][2], const Unit& u, int wr, int wc, int fr, int fq) const {
        const int row0 = u.pm * BM + wr * 64 + fr, f0 = u.pn * HALF + wc * 32 + 8 * fq;
#pragma unroll
        for (int ai = 0; ai < 2; ++ai)
#pragma unroll
            for (int m = 0; m < 4; ++m) {
                const int row = row0 + ai * HALF + m * 16; const float rs = row_rstd(ss, row);
                const f32x4 g0 = acc[ai][0][m][0] * rs, g1 = acc[ai][0][m][1] * rs, u0 = acc[ai][1][m][0] * rs, u1 = acc[ai][1][m][1] * rs;
                f32x4 a0, a1;
#pragma unroll
                for (int j = 0; j < 4; ++j) { a0[j] = silu_f(g0[j]) * u0[j]; a1[j] = silu_f(g1[j]) * u1[j]; }
                u32x4 w; w.x = cvt_pk_bf16(a0[0], a0[1]); w.y = cvt_pk_bf16(a0[2], a0[3]); w.z = cvt_pk_bf16(a1[0], a1[1]); w.w = cvt_pk_bf16(a1[2], a1[3]);
                *(u32x4*)(O + (size_t)row * DFF + f0) = w;
                if (m & 1) asm volatile("" ::: "memory");
            }
    }
};
struct EpiResid {
    static constexpr bool PERM = false;
    const float* resid; float* out; bf16_t* xb; float* ss;
    __device__ __forceinline__ void operator()(const f32x4 (&acc)[2][2][4][2], const Unit& u, int wr, int wc, int fr, int fq) const {
        const int row0 = u.pm * BM + wr * 64 + fr, col0 = u.pn * BM + wc * 32 + 4 * fq;
#pragma unroll
        for (int ai = 0; ai < 2; ++ai)
#pragma unroll
            for (int m = 0; m < 4; ++m) {
                const int row = row0 + ai * HALF + m * 16; const size_t off = (size_t)row * D + col0; float q = 0.f;
#pragma unroll
                for (int bj = 0; bj < 2; ++bj)
#pragma unroll
                    for (int n = 0; n < 2; ++n) {
                        const size_t o = off + bj * HALF + n * 16;
                        const f32x4 h = *(const f32x4*)(resid + o) + acc[ai][bj][m][n];
                        *(f32x4*)(out + o) = h;
                        q += (h.x * h.x + h.y * h.y) + (h.z * h.z + h.w * h.w);
                        if (xb) { u32x2 w; w.x = cvt_pk_bf16(h.x, h.y); w.y = cvt_pk_bf16(h.z, h.w); *(u32x2*)(xb + o) = w; }
                    }
                q += __shfl_xor(q, 16); q += __shfl_xor(q, 32);
                if (fq == 0) ss[(size_t)row * 16 + u.pn * 4 + wc] = q;
                asm volatile("" ::: "memory");
            }
    }
};

template <class Epi, bool ALIGN_EPI, bool SP2>
__device__ __forceinline__ void gemm_phase(LAS unsigned char* lds, const Gemm g, const StaticOrder& S, const Epi& E) {
    int tid_ = threadIdx.x; asm volatile("" : "+v"(tid_));
    const int tid = tid_, wid = __builtin_amdgcn_readfirstlane(tid >> 6), lane = tid & 63, wr = wid >> 2, wc = wid & 3, fr = lane & 15, fq = lane >> 4;
    const int K = g.K, nt = K / BK;
    unsigned voffA[2], voffB[2];
#pragma unroll
    for (int i = 0; i < 2; ++i) { int R, C; stage_rc(tid * 16 + i * 8192, R, C); const int Rb = Epi::PERM ? ((R & ~31) + perm32(R & 31)) : R;
        voffA[i] = (unsigned)(R * K + C) * 2u; voffB[i] = (unsigned)(Rb * K + C) * 2u; }
    const size_t kstep = (size_t)(BK * 2);
    const size_t hstep = (size_t)HALF * K * 2;
    const size_t tstep = 2 * hstep;
    const unsigned ldsw = (unsigned)wid * 1024u;
    const int aoff = lds_byte(wr * 64 + fr, fq * 8), boff = lds_byte(wc * 32 + fr, fq * 8);
#define PG8_SA(b, h) (((b) * 2 + (h)) * HTB)
#define PG8_SB(b, h) ((4 + (b) * 2 + (h)) * HTB)
#define PG8_STAGE(bufoff, gbase, voff) do { _Pragma("unroll") for (int _i = 0; _i < 2; ++_i) \
        __builtin_amdgcn_global_load_lds((const unsigned*)((const char*)(gbase) + (voff)[_i]), (LAS unsigned*)(lds + (bufoff) + ldsw + _i * 8192), 16, 0, 0); } while (0)
#define PG8_LDA(dst, b, h) do { _Pragma("unroll") for (int m = 0; m < 4; ++m) _Pragma("unroll") for (int k = 0; k < 2; ++k) dst[m][k] = *(const LAS bf16x8*)(lds + PG8_SA(b, h) + aoff + m * 2048 + k * 1024); } while (0)
#define PG8_LDB(dst, b, h) do { _Pragma("unroll") for (int n = 0; n < 2; ++n) _Pragma("unroll") for (int k = 0; k < 2; ++k) dst[n][k] = *(const LAS bf16x8*)(lds + PG8_SB(b, h) + boff + n * 2048 + k * 1024); } while (0)
#define PG8_MMA(ai, bj, At, Bt) do { __builtin_amdgcn_s_setprio(1); _Pragma("unroll") for (int m = 0; m < 4; ++m) _Pragma("unroll") for (int n = 0; n < 2; ++n) _Pragma("unroll") for (int k = 0; k < 2; ++k) \
        acc[ai][bj][m][n] = __builtin_amdgcn_mfma_f32_16x16x32_bf16(Bt[n][k], At[m][k], acc[ai][bj][m][n], 0, 0, 0); __builtin_amdgcn_s_setprio(0); } while (0)
#define PG8_WAIT_V(n) asm volatile("s_waitcnt vmcnt(" #n ")" ::: "memory")
#define PG8_WAIT_L(n) asm volatile("s_waitcnt lgkmcnt(" #n ")" ::: "memory")
#define PG8_BAR __builtin_amdgcn_s_barrier()
#define PG8_SCHED __builtin_amdgcn_sched_barrier(0)
    Unit cur, nxt; int ui = 0;
    if (!S.next(0, cur)) return;
    f32x4 acc[2][2][4][2];
#pragma unroll
    for (int a = 0; a < 2; ++a)
#pragma unroll
        for (int b = 0; b < 2; ++b)
#pragma unroll
            for (int m = 0; m < 4; ++m)
#pragma unroll
                for (int n = 0; n < 2; ++n) acc[a][b][m][n] = (f32x4){0.f, 0.f, 0.f, 0.f};
    bf16x8 At[4][2], B0[2][2], B1[2][2];
    const char* cA = (const char*)g.A + (size_t)cur.pm * tstep; const char* cB = (const char*)g.Bt + (size_t)cur.pn * tstep;
    if constexpr (SP2) {
        PG8_STAGE(PG8_SB(0, 0), cB, voffB); PG8_STAGE(PG8_SB(0, 1), cB + hstep, voffB); PG8_STAGE(PG8_SA(0, 0), cA, voffA); PG8_STAGE(PG8_SA(0, 1), cA + hstep, voffA);
        if (wr == 1) PG8_BAR;
        PG8_WAIT_V(2); PG8_BAR;
        PG8_STAGE(PG8_SB(1, 0), cB + kstep, voffB); PG8_STAGE(PG8_SA(1, 0), cA + kstep, voffA); PG8_STAGE(PG8_SB(1, 1), cB + hstep + kstep, voffB);
        PG8_WAIT_V(6); PG8_BAR;
    } else {
        PG8_STAGE(PG8_SB(0, 0), cB, voffB); PG8_STAGE(PG8_SA(0, 0), cA, voffA); PG8_STAGE(PG8_SB(0, 1), cB + hstep, voffB); PG8_STAGE(PG8_SA(0, 1), cA + hstep, voffA);
        if (wr == 1) PG8_BAR;
        PG8_WAIT_V(4); PG8_BAR;
        PG8_STAGE(PG8_SB(1, 0), cB + kstep, voffB); PG8_STAGE(PG8_SA(1, 0), cA + kstep, voffA); PG8_STAGE(PG8_SB(1, 1), cB + hstep + kstep, voffB);
        PG8_WAIT_V(6); PG8_BAR;
    }
    for (;;) {
        const bool has_next = S.next(ui + 1, nxt);
        const char* nA = has_next ? (const char*)g.A + (size_t)nxt.pm * tstep : cA; const char* nB = has_next ? (const char*)g.Bt + (size_t)nxt.pn * tstep : cB;
        for (int t = 0; t < nt; t += 2) {
            const bool last = (t == nt - 2);
            const char* a1 = cA + (size_t)(t + 1) * kstep;
            const char* a2 = last ? nA : cA + (size_t)(t + 2) * kstep; const char* b2 = last ? nB : cB + (size_t)(t + 2) * kstep;
            const char* a3 = a2 + kstep; const char* b3 = b2 + kstep;
            if constexpr (SP2) {
            PG8_LDB(B0, 0, 0); PG8_LDB(B1, 0, 1); PG8_SCHED; PG8_LDA(At, 0, 0); PG8_STAGE(PG8_SA(1, 1), a1 + hstep, voffA);
            PG8_WAIT_V(8); PG8_WAIT_L(0); PG8_BAR; PG8_MMA(0, 0, At, B0); PG8_MMA(0, 1, At, B1); PG8_BAR; PG8_SCHED;
            PG8_LDA(At, 0, 1); PG8_STAGE(PG8_SB(0, 0), b2, voffB); PG8_STAGE(PG8_SB(0, 1), b2 + hstep, voffB); PG8_STAGE(PG8_SA(0, 0), a2, voffA);
            PG8_WAIT_V(8); PG8_WAIT_L(0); PG8_BAR; PG8_MMA(1, 0, At, B0); PG8_MMA(1, 1, At, B1); PG8_BAR; PG8_SCHED;
            PG8_LDB(B0, 1, 0); PG8_LDB(B1, 1, 1); PG8_SCHED; PG8_LDA(At, 1, 0); PG8_STAGE(PG8_SA(0, 1), a2 + hstep, voffA);
            PG8_WAIT_V(8); PG8_WAIT_L(0); PG8_BAR; PG8_MMA(0, 0, At, B0); PG8_MMA(0, 1, At, B1); PG8_BAR; PG8_SCHED;
            PG8_LDA(At, 1, 1); PG8_STAGE(PG8_SB(1, 0), b3, voffB); PG8_STAGE(PG8_SB(1, 1), b3 + hstep, voffB); PG8_STAGE(PG8_SA(1, 0), a3, voffA);
            PG8_WAIT_V(8); PG8_WAIT_L(0); PG8_BAR; PG8_MMA(1, 0, At, B0); PG8_MMA(1, 1, At, B1); PG8_BAR; PG8_SCHED;
            } else {
            PG8_LDB(B0, 0, 0); PG8_SCHED; PG8_LDA(At, 0, 0); PG8_STAGE(PG8_SA(1, 1), a1 + hstep, voffA);
            PG8_WAIT_L(8); PG8_BAR; PG8_WAIT_L(0); PG8_MMA(0, 0, At, B0); PG8_BAR; PG8_SCHED;
            PG8_LDB(B1, 0, 1); PG8_STAGE(PG8_SB(0, 0), b2, voffB);
            PG8_BAR; PG8_WAIT_L(0); PG8_MMA(0, 1, At, B1); PG8_BAR;
            PG8_LDA(At, 0, 1); PG8_STAGE(PG8_SA(0, 0), a2, voffA);
            PG8_BAR; PG8_WAIT_L(0); PG8_MMA(1, 0, At, B0); PG8_BAR; PG8_SCHED;
            PG8_STAGE(PG8_SB(0, 1), b2 + hstep, voffB);
            PG8_WAIT_V(6); PG8_BAR; PG8_MMA(1, 1, At, B1); PG8_BAR;
            PG8_LDB(B0, 1, 0); PG8_SCHED; PG8_LDA(At, 1, 0); PG8_STAGE(PG8_SA(0, 1), a2 + hstep, voffA);
            PG8_WAIT_L(8); PG8_BAR; PG8_WAIT_L(0); PG8_MMA(0, 0, At, B0); PG8_BAR; PG8_SCHED;
            PG8_LDB(B1, 1, 1); PG8_STAGE(PG8_SB(1, 0), b3, voffB);
            PG8_BAR; PG8_WAIT_L(0); PG8_MMA(0, 1, At, B1); PG8_BAR;
            PG8_LDA(At, 1, 1); PG8_STAGE(PG8_SA(1, 0), a3, voffA);
            PG8_BAR; PG8_WAIT_L(0); PG8_MMA(1, 0, At, B0); PG8_BAR; PG8_SCHED;
            PG8_STAGE(PG8_SB(1, 1), b3 + hstep, voffB);
            PG8_WAIT_V(6); PG8_BAR; PG8_MMA(1, 1, At, B1); PG8_BAR;
            }
        }
        if constexpr (ALIGN_EPI) { if (wr == 0) PG8_BAR; }
        E(acc, cur, wr, wc, fr, fq);
        if (!has_next) break;
#pragma unroll
        for (int a = 0; a < 2; ++a)
#pragma unroll
            for (int b = 0; b < 2; ++b)
#pragma unroll
                for (int m = 0; m < 4; ++m)
#pragma unroll
                    for (int n = 0; n < 2; ++n) acc[a][b][m][n] = (f32x4){0.f, 0.f, 0.f, 0.f};
        cur = nxt; cA = nA; cB = nB; ++ui;
        if constexpr (ALIGN_EPI) { if (wr == 1) PG8_BAR; }
    }
    PG8_WAIT_V(0);
    if constexpr (!ALIGN_EPI) { if (wr == 0) PG8_BAR; }
    PG8_BAR;
#undef PG8_SA
#undef PG8_SB
#undef PG8_STAGE
#undef PG8_LDA
#undef PG8_LDB
#undef PG8_MMA
#undef PG8_WAIT_V
#undef PG8_WAIT_L
#undef PG8_BAR
#undef PG8_SCHED
}
}

struct Args {
    const float* x; const float* even_w_in; const float* even_w_out; const float* a_w_s; const float* a_b_s; const float* a_ln_g; const float* a_ln_b;
    const float* b_w_pool; const float* b_scale; const float* odd_w_in; const float* odd_w_out; const float* c_w_dw; const float* c_b_dw; const float* c_ln_g; const float* c_ln_b;
    const float* d_w_dw; const float* norm_mix_g; const float* norm_ffn_g; const float* ffn_w_gate; const float* ffn_w_up; const float* ffn_w_down; const float* final_norm_g;
    float* out; unsigned char* ws; int ph_lo, ph_hi;
};

__device__ __forceinline__ void p0_transpose_item(const float* W, int K, int N, bf16_t* WT, int grp, int gstride, int goff, const float* gk, LAS float* scr, int item, int lane) {
    const int nblk = N / 32, kb = item / nblk, nb = item % nblk, k0 = 64 * kb, n0 = 32 * nb;
#pragma unroll 8
    for (int i = 0; i < 32; ++i) { const int kk = 2 * i + (lane >> 5); float v = W[(size_t)(k0 + kk) * N + n0 + (lane & 31)]; if (gk) v *= gk[k0 + kk]; scr[kk * 33 + (lane & 31)] = v; }
    asm volatile("s_waitcnt lgkmcnt(0)" ::: "memory");
    const int c = lane & 7;
    const int drow0 = (n0 / grp) * gstride + goff + (n0 % grp);
#pragma unroll
    for (int j = 0; j < 4; ++j) { const int n = (lane >> 3) + 8 * j; const LAS float* s = scr + (8 * c) * 33 + n;
        u32x4 o; o.x = cvt_pk_bf16(s[0 * 33], s[1 * 33]); o.y = cvt_pk_bf16(s[2 * 33], s[3 * 33]); o.z = cvt_pk_bf16(s[4 * 33], s[5 * 33]); o.w = cvt_pk_bf16(s[6 * 33], s[7 * 33]);
        *(u32x4*)(WT + (size_t)(drow0 + n) * K + k0 + 8 * c) = o; }
    asm volatile("s_waitcnt lgkmcnt(0)" ::: "memory");
}

__device__ __forceinline__ void p0_prologue(const Args& A, LAS unsigned char* lds, int vcu, int G) {
    int tid_ = threadIdx.x; asm volatile("" : "+v"(tid_));
    const int tid = tid_, lane = tid & 63, wave = __builtin_amdgcn_readfirstlane(tid >> 6);
    LAS float* scr = (LAS float*)(lds + wave * 16384);
    const int gw = vcu * NWAVES + wave, NGW = G * NWAVES;
    unsigned char* ws = A.ws;
    constexpr int I_IN0 = 16 * (EVEN_IN / 32), I_OUT = 16 * (D / 32), I_FF = 16 * (DFF / 32), I_DN = (DFF / 64) * (D / 32), I_IN1 = 16 * (ODD_IN / 32), I_WP = 2 * 4;
    constexpr int PER_LAYER_FFN = 2 * I_FF + I_DN;
    constexpr int NITEMS = I_IN0 + I_OUT + I_IN1 + I_OUT + 2 * PER_LAYER_FFN + 4 * I_WP;
    for (int it = gw; it < NITEMS; it += NGW) {
        int r = it;
        if (r < I_IN0) { p0_transpose_item(A.even_w_in, D, EVEN_IN, (bf16_t*)(ws + WS_WIN0), EVEN_IN, 0, 0, A.norm_mix_g, scr, r, lane); continue; } r -= I_IN0;
        if (r < I_OUT) { p0_transpose_item(A.even_w_out, D, D, (bf16_t*)(ws + WS_WOUT0), D, 0, 0, nullptr, scr, r, lane); continue; } r -= I_OUT;
        if (r < I_IN1) { p0_transpose_item(A.odd_w_in, D, ODD_IN, (bf16_t*)(ws + WS_WIN1), ODD_IN, 0, 0, A.norm_mix_g + D, scr, r, lane); continue; } r -= I_IN1;
        if (r < I_OUT) { p0_transpose_item(A.odd_w_out, D, D, (bf16_t*)(ws + WS_WOUT1), D, 0, 0, nullptr, scr, r, lane); continue; } r -= I_OUT;
        if (r < 2 * PER_LAYER_FFN) {
            const int layer = r / PER_LAYER_FFN; r -= layer * PER_LAYER_FFN;
            bf16_t* wgu = (bf16_t*)(ws + (layer ? WS_WGU1 : WS_WGU0)); bf16_t* wdn = (bf16_t*)(ws + (layer ? WS_WDN1 : WS_WDN0));
            const float* gk = A.norm_ffn_g + layer * D;
            if (r < I_FF) { p0_transpose_item(A.ffn_w_gate + (size_t)layer * D * DFF, D, DFF, wgu, 128, 256, 0, gk, scr, r, lane); continue; } r -= I_FF;
            if (r < I_FF) { p0_transpose_item(A.ffn_w_up + (size_t)layer * D * DFF, D, DFF, wgu, 128, 256, 128, gk, scr, r, lane); continue; } r -= I_FF;
            p0_transpose_item(A.ffn_w_down + (size_t)layer * DFF * D, DFF, D, wdn, D, 0, 0, nullptr, scr, r, lane); continue;
        }
        r -= 2 * PER_LAYER_FFN;
        { const int g = r / I_WP; r -= g * I_WP;
          p0_transpose_item(A.b_w_pool + (size_t)g * 128 * 128, 128, 128, (bf16_t*)(ws + WS_WP) + (size_t)g * 128 * 128, 128, 0, 0, nullptr, scr, r, lane); }
    }
    { bf16_t* wm = (bf16_t*)(ws + WS_WS);
      for (int e = (vcu * NTHREADS + tid) * 2; e < 4 * 128 * 128; e += G * NTHREADS * 2) {
          const int i = (e >> 7) & 127, j = e & 127; const bool keep = (i >> 6) >= (j >> 6);
          const float a = keep ? A.a_w_s[e] : 0.f, b = keep ? A.a_w_s[e + 1] : 0.f;
          *(unsigned*)(wm + e) = cvt_pk_bf16(a, b); } }
    { bf16_t* xb = (bf16_t*)(ws + WS_XB); float* ss = (float*)(ws + WS_SS);
      for (int m = gw; m < M_TOK; m += NGW) {
          const f32x4* xr = (const f32x4*)(A.x + (size_t)m * D) + lane; f32x4 v[4]; float s = 0.f;
#pragma unroll
          for (int j = 0; j < 4; ++j) { v[j] = xr[64 * j]; s += (v[j].x * v[j].x + v[j].y * v[j].y) + (v[j].z * v[j].z + v[j].w * v[j].w); }
          s = wave_sum(s);
          u32x2* o8 = (u32x2*)(xb + (size_t)m * D) + lane;
#pragma unroll
          for (int j = 0; j < 4; ++j) { u32x2 w; w.x = cvt_pk_bf16(v[j].x, v[j].y); w.y = cvt_pk_bf16(v[j].z, v[j].w); o8[64 * j] = w; }
          if (lane < 4) { f32x4 t = (f32x4){0.f, 0.f, 0.f, 0.f}; if (lane == 0) t.x = s; *((f32x4*)(ss + (size_t)m * 16) + lane) = t; }
      } }
}

constexpr int VN_STRIDE = 1056;
__device__ __forceinline__ void mixer_even(const Args& A, LAS unsigned char* lds, int vcu, int G) {
    int tid_ = threadIdx.x; asm volatile("" : "+v"(tid_));
    const int tid = tid_, lane = tid & 63, w = __builtin_amdgcn_readfirstlane(tid >> 6), fr = lane & 15, fq = lane >> 4;
    const bf16_t* Z = (const bf16_t*)(A.ws + WS_Z); bf16_t* Y = (bf16_t*)(A.ws + WS_Y);
    const bf16_t* Wm = (const bf16_t*)(A.ws + WS_WS); const bf16_t* WpT = (const bf16_t*)(A.ws + WS_WP);
    for (int blk = vcu; blk < M_TOK / 128; blk += G) {
        const int row_base = blk * 128;
        {
            float lg[8], lb[8];
            { const f32x4 g0 = *(const f32x4*)(A.a_ln_g + 8 * lane), g1 = *(const f32x4*)(A.a_ln_g + 8 * lane + 4), b0 = *(const f32x4*)(A.a_ln_b + 8 * lane), b1 = *(const f32x4*)(A.a_ln_b + 8 * lane + 4);
#pragma unroll
              for (int j = 0; j < 4; ++j) { lg[j] = g0[j]; lg[4 + j] = g1[j]; lb[j] = b0[j]; lb[4 + j] = b1[j]; } }
#pragma unroll 4
            for (int tt = 0; tt < 16; ++tt) {
                const int tok = 16 * w + tt; const size_t row = (size_t)(row_base + tok);
                const u32x4 raw = *(const u32x4*)(Z + row * EVEN_IN + 512 + 8 * lane);
                float v[8]; unpack8(raw, v);
                float s = ((v[0] + v[1]) + (v[2] + v[3])) + ((v[4] + v[5]) + (v[6] + v[7]));
                const float mu = wave_sum(s) * (1.0f / 512.0f);
                float q = 0.f;
#pragma unroll
                for (int j = 0; j < 8; ++j) { v[j] -= mu; q += v[j] * v[j]; }
                const float rstd = rsqrtf(wave_sum(q) * (1.0f / 512.0f) + EPS);
#pragma unroll
                for (int j = 0; j < 8; ++j) v[j] = v[j] * rstd * lg[j] + lb[j];
                *(LAS u32x4*)(lds + tok * VN_STRIDE + lane * 16) = pack8(v);
            }
        }
        __syncthreads();
        {
            const int h = w >> 1, dh = w & 1;
            const int q4 = (lane >> 2) & 3, p4 = lane & 3;
            const LAS unsigned char* vbase = lds + (4 * fq + q4) * VN_STRIDE + (h * 128 + dh * 64 + 4 * p4) * 2;
#pragma unroll
            for (int mh = 0; mh < 2; ++mh) {
                f32x4 acc[4][4];
#pragma unroll
                for (int m = 0; m < 4; ++m)
#pragma unroll
                    for (int n = 0; n < 4; ++n) acc[m][n] = (f32x4){0.f, 0.f, 0.f, 0.f};
#pragma unroll
                for (int ks = 0; ks < 4; ++ks) {
                    if (mh == 0 && ks >= 2) continue;
                    bf16x8 vf[4];
#pragma unroll
                    for (int n = 0; n < 4; ++n) {
                        const s16x4 lo = __builtin_amdgcn_ds_read_tr16_b64_v4i16((LAS s16x4*)(vbase + (ks * 32) * VN_STRIDE + n * 32));
                        const s16x4 hi = __builtin_amdgcn_ds_read_tr16_b64_v4i16((LAS s16x4*)(vbase + (ks * 32 + 16) * VN_STRIDE + n * 32));
                        vf[n] = (bf16x8){lo.x, lo.y, lo.z, lo.w, hi.x, hi.y, hi.z, hi.w};
                    }
#pragma unroll
                    for (int m = 0; m < 4; ++m) {
                        const bf16_t* wp = Wm + ((size_t)(h * 128 + (4 * mh + m) * 16 + fr) * 128 + ks * 32 + 4 * fq);
                        const u32x2 wlo = *(const u32x2*)wp, whi = *(const u32x2*)(wp + 16);
                        union { u32x4 u; bf16x8 b; } wf; wf.u = (u32x4){wlo.x, wlo.y, whi.x, whi.y};
#pragma unroll
                        for (int n = 0; n < 4; ++n) acc[m][n] = __builtin_amdgcn_mfma_f32_16x16x32_bf16(vf[n], wf.b, acc[m][n], 0, 0, 0);
                    }
                }
#pragma unroll
                for (int m = 0; m < 4; ++m) {
                    const int i = (4 * mh + m) * 16 + fr; const float bs = A.a_b_s[h * 128 + i]; const size_t row = (size_t)(row_base + i);
#pragma unroll
                    for (int n = 0; n < 4; ++n) {
                        const int d = h * 128 + dh * 64 + n * 16 + 4 * fq;
                        const u32x2 ur = *(const u32x2*)(Z + row * EVEN_IN + d);
                        const f32x4 sv = acc[m][n];
                        u32x2 o; o.x = cvt_pk_bf16(bf_lo(ur.x) * (sv.x + bs), bf_hi(ur.x) * (sv.y + bs)); o.y = cvt_pk_bf16(bf_lo(ur.y) * (sv.z + bs), bf_hi(ur.y) * (sv.w + bs));
                        *(u32x2*)(Y + row * D + d) = o;
                    }
                }
            }
        }
        {
            const int tok = 16 * w + fr; const int row = row_base + tok; const int pos = row & (SEQ - 1);
#pragma unroll 1
            for (int g = 0; g < 4; ++g) {
                const int win = 2 << g;
                const int cnt = (pos + 1 < win) ? pos + 1 : win; const float inv = 1.0f / (float)cnt;
                f32x4 acc[8];
#pragma unroll
                for (int n = 0; n < 8; ++n) acc[n] = (f32x4){0.f, 0.f, 0.f, 0.f};
#pragma unroll 1
                for (int ks = 0; ks < 4; ++ks) {
                    const int c0 = g * 128 + ks * 32 + 8 * fq;
                    const bf16_t* zp = Z + (size_t)row * EVEN_IN + 1024 + c0;
                    float x0[8]; unpack8(*(const u32x4*)zp, x0);
                    float s[8];
#pragma unroll
                    for (int j = 0; j < 8; ++j) s[j] = x0[j];
                    for (int k = 1; k < cnt; ++k) { float xv[8]; unpack8(*(const u32x4*)(zp - (size_t)k * EVEN_IN), xv);
#pragma unroll
                        for (int j = 0; j < 8; ++j) s[j] += xv[j]; }
#pragma unroll
                    for (int j = 0; j < 8; ++j) s[j] = s[j] * inv - x0[j];
                    union { u32x4 u; bf16x8 b; } pf; pf.u = pack8(s);
#pragma unroll
                    for (int n = 0; n < 8; ++n) {
                        const bf16x8 wf = *(const bf16x8*)(WpT + ((size_t)(g * 128 + n * 16 + fr) * 128 + ks * 32 + 8 * fq));
                        acc[n] = __builtin_amdgcn_mfma_f32_16x16x32_bf16(wf, pf.b, acc[n], 0, 0, 0);
                    }
                }
#pragma unroll
                for (int n = 0; n < 8; ++n) {
                    const int d = g * 128 + n * 16 + 4 * fq;
                    const f32x4 sc = *(const f32x4*)(A.b_scale + d);
                    u32x2 o; o.x = cvt_pk_bf16(acc[n].x * sc.x, acc[n].y * sc.y); o.y = cvt_pk_bf16(acc[n].z * sc.z, acc[n].w * sc.w);
                    *(u32x2*)(Y + (size_t)row * D + 512 + d) = o;
                }
            }
        }
        __syncthreads();
    }
}

template <int S, int T> __device__ __forceinline__ void conv_t(f32x2 (&acc)[32], const f32x2 (&wt)[31], const f32x2 hv) {
    if constexpr (T < 32) { if constexpr (S - T >= 0 && S - T <= 30) acc[T] = acc[T] + wt[S - T] * hv; conv_t<S, T + 1>(acc, wt, hv); }
}
template <int S> __device__ __forceinline__ void conv_s(f32x2 (&acc)[32], const f32x2 (&wt)[31], const LAS unsigned char* hp) {
    if constexpr (S < 62) {
        const unsigned hr = *(const LAS unsigned*)(hp + S * 1024);
        conv_t<S, 0>(acc, wt, (f32x2){bf_lo(hr), bf_hi(hr)});
        conv_s<S + 1>(acc, wt, hp);
    }
}
__device__ __forceinline__ void mixer_odd(const Args& A, LAS unsigned char* lds, int vcu, int G) {
    int tid_ = threadIdx.x; asm volatile("" : "+v"(tid_));
    const int tid = tid_, lane = tid & 63, w = __builtin_amdgcn_readfirstlane(tid >> 6);
    const bf16_t* Z = (const bf16_t*)(A.ws + WS_Z); bf16_t* Y = (bf16_t*)(A.ws + WS_Y);
    constexpr int TT = 64, HALO = 30, HROWS = TT + HALO;
    for (int tile = vcu; tile < M_TOK / TT; tile += G) {
        const int t0 = tile * TT; const int pos0 = t0 & (SEQ - 1);
        for (int task = tid; task < HROWS * 64; task += NTHREADS) {
            const int r = task >> 6, c8 = task & 63; const int pos = pos0 + r - HALO;
            u32x4 o = (u32x4){0u, 0u, 0u, 0u};
            if (pos >= 0) {
                const bf16_t* zp = Z + (size_t)(t0 + r - HALO) * ODD_IN + 8 * c8;
                float a[8], g[8]; unpack8(*(const u32x4*)zp, a); unpack8(*(const u32x4*)(zp + 512), g);
#pragma unroll
                for (int j = 0; j < 8; ++j) a[j] = a[j] * sigmoid_f(g[j]);
                o = pack8(a);
            }
            *(LAS u32x4*)(lds + r * 1024 + c8 * 16) = o;
        }
        __syncthreads();
        const int cp = tid & 255, th = tid >> 8;
        f32x2 acc[32];
        {
            f32x2 wt[31];
            const float* wbase = A.c_w_dw + 2 * cp;
#pragma unroll
            for (int j = 0; j < 31; ++j) wt[j] = *(const f32x2*)(wbase + j * 512);
            const f32x2 bias = *(const f32x2*)(A.c_b_dw + 2 * cp);
#pragma unroll
            for (int t = 0; t < 32; ++t) acc[t] = bias;
            const LAS unsigned char* hp = lds + (32 * th) * 1024 + 4 * cp;
            conv_s<0>(acc, wt, hp);
        }
        __syncthreads();
#pragma unroll
        for (int t = 0; t < 32; ++t) *(LAS unsigned*)(lds + (32 * th + t) * 1024 + 4 * cp) = cvt_pk_bf16(acc[t].x, acc[t].y);
        __syncthreads();
        {
            float lg[8], lb[8];
            { const f32x4 g0 = *(const f32x4*)(A.c_ln_g + 8 * lane), g1 = *(const f32x4*)(A.c_ln_g + 8 * lane + 4), b0 = *(const f32x4*)(A.c_ln_b + 8 * lane), b1 = *(const f32x4*)(A.c_ln_b + 8 * lane + 4);
#pragma unroll
              for (int j = 0; j < 4; ++j) { lg[j] = g0[j]; lg[4 + j] = g1[j]; lb[j] = b0[j]; lb[4 + j] = b1[j]; } }
#pragma unroll 2
            for (int tt = 0; tt < 8; ++tt) {
                const int tok = 8 * w + tt;
                float v[8]; unpack8(*(const LAS u32x4*)(lds + tok * 1024 + lane * 16), v);
                float s = ((v[0] + v[1]) + (v[2] + v[3])) + ((v[4] + v[5]) + (v[6] + v[7]));
                const float mu = wave_sum(s) * (1.0f / 512.0f);
                float q = 0.f;
#pragma unroll
                for (int j = 0; j < 8; ++j) { v[j] -= mu; q += v[j] * v[j]; }
                const float rstd = rsqrtf(wave_sum(q) * (1.0f / 512.0f) + EPS);
#pragma unroll
                for (int j = 0; j < 8; ++j) v[j] = silu_f(v[j] * rstd * lg[j] + lb[j]);
                *(u32x4*)(Y + (size_t)(t0 + tok) * D + 8 * lane) = pack8(v);
            }
        }
        {
            const int c8 = tid & 63, tsub = tid >> 6;
            float w0[8], w1[8], w2[8];
            { const float* wp = A.d_w_dw + 8 * c8;
              const f32x4 a0 = *(const f32x4*)wp, a1 = *(const f32x4*)(wp + 4), b0 = *(const f32x4*)(wp + 512), b1 = *(const f32x4*)(wp + 516), c0 = *(const f32x4*)(wp + 1024), c1 = *(const f32x4*)(wp + 1028);
#pragma unroll
              for (int j = 0; j < 4; ++j) { w0[j] = a0[j]; w0[4 + j] = a1[j]; w1[j] = b0[j]; w1[4 + j] = b1[j]; w2[j] = c0[j]; w2[4 + j] = c1[j]; } }
#pragma unroll 2
            for (int it = 0; it < 8; ++it) {
                const int tok = it * 8 + tsub; const int row = t0 + tok; const int pos = pos0 + tok;
                const bf16_t* zp = Z + (size_t)row * ODD_IN + 1024 + 8 * c8;
                float bg[8], c[8], xi[8], p[8], o[8];
                unpack8(*(const u32x4*)zp, bg);
                unpack8(*(const u32x4*)(zp + 512), c); unpack8(*(const u32x4*)(zp + 1024), xi);
#pragma unroll
                for (int j = 0; j < 8; ++j) o[j] = w2[j] * (c[j] * xi[j]);
                if (pos >= 1) { unpack8(*(const u32x4*)(zp - ODD_IN + 512), c); unpack8(*(const u32x4*)(zp - ODD_IN + 1024), xi);
#pragma unroll
                    for (int j = 0; j < 8; ++j) o[j] += w1[j] * (c[j] * xi[j]); }
                if (pos >= 2) { unpack8(*(const u32x4*)(zp - 2 * ODD_IN + 512), c); unpack8(*(const u32x4*)(zp - 2 * ODD_IN + 1024), xi);
#pragma unroll
                    for (int j = 0; j < 8; ++j) o[j] += w0[j] * (c[j] * xi[j]); }
#pragma unroll
                for (int j = 0; j < 8; ++j) p[j] = bg[j] * o[j];
                *(u32x4*)(Y + (size_t)row * D + 512 + 8 * c8) = pack8(p);
            }
        }
        __syncthreads();
    }
}

__device__ __forceinline__ void final_norm(const Args& A, int vcu, int G) {
    int tid_ = threadIdx.x; asm volatile("" : "+v"(tid_));
    const int tid = tid_, lane = tid & 63, wave = __builtin_amdgcn_readfirstlane(tid >> 6);
    const int gw = vcu * NWAVES + wave, NGW = G * NWAVES;
    const float* ss = (const float*)(A.ws + WS_SS);
    f32x4 gg[4];
#pragma unroll
    for (int j = 0; j < 4; ++j) gg[j] = *((const f32x4*)A.final_norm_g + lane + 64 * j);
    for (int m = gw; m < M_TOK; m += NGW) {
        const float rs = row_rstd(ss, m);
        f32x4* xr = (f32x4*)(A.out + (size_t)m * D) + lane;
#pragma unroll
        for (int j = 0; j < 4; ++j) { const f32x4 v = xr[64 * j]; xr[64 * j] = v * rs * gg[j]; }
    }
}

#ifndef PG8_SP2
#define PG8_SP2 true
#endif
#ifndef PG8_ALIGN
#define PG8_ALIGN true
#endif
__global__ void __launch_bounds__(NTHREADS, 2) trunk_fwd(Args args) {
    extern __shared__ __attribute__((aligned(16))) unsigned char lds_raw[];
    LAS unsigned char* lds = (LAS unsigned char*)lds_raw;
    const int G = gridDim.x, bx = blockIdx.x;
    const int vcu = (G % 8 == 0) ? (bx % 8) * (G / 8) + bx / 8 : bx;
    const int lo = args.ph_lo, hi = args.ph_hi;
    unsigned char* ws = args.ws;
    bf16_t* XB = (bf16_t*)(ws + WS_XB); bf16_t* Yb = (bf16_t*)(ws + WS_Y); bf16_t* Zb = (bf16_t*)(ws + WS_Z); float* SS = (float*)(ws + WS_SS);
#ifndef KIND_MASK
#define KIND_MASK 0xff
#endif
#define KIND(b) (((KIND_MASK) >> (b)) & 1)
#define IN(k) (lo <= (k) && (k) < hi)
#define SEAM(k) do { if (IN(k) && IN((k) + 1)) { cg::this_grid().sync(); } } while (0)

    if (KIND(0) && IN(0)) { p0_prologue(args, lds, vcu, G); }
    SEAM(0);
#pragma unroll 1
    for (int layer = 0; layer < 2; ++layer) {
        const int pb = 1 + 5 * layer;
        if (KIND(1) && IN(pb + 0)) {
            const int N = layer ? ODD_IN : EVEN_IN;
            pg8::Gemm g{XB, (const bf16_t*)(ws + (layer ? WS_WIN1 : WS_WIN0)), M_TOK, N, D}; pg8::StaticOrder S; S.init(M_TOK, N, G, bx);
            pg8::EpiScaleBf16 E{Zb, N, SS, layer ? 0 : 4};
            pg8::gemm_phase<pg8::EpiScaleBf16, PG8_ALIGN, PG8_SP2>(lds, g, S, E);
        }
        SEAM(pb + 0);
        if (IN(pb + 1)) { if (layer == 0) { if (KIND(2)) mixer_even(args, lds, vcu, G); } else { if (KIND(3)) mixer_odd(args, lds, vcu, G); } }
        SEAM(pb + 1);
        if (KIND(4) && IN(pb + 2)) {
            pg8::Gemm g{Yb, (const bf16_t*)(ws + (layer ? WS_WOUT1 : WS_WOUT0)), M_TOK, D, D}; pg8::StaticOrder S; S.init(M_TOK, D, G, bx);
            pg8::EpiResid E{layer ? (const float*)args.out : args.x, args.out, XB, SS};
            pg8::gemm_phase<pg8::EpiResid, PG8_ALIGN, PG8_SP2>(lds, g, S, E);
        }
        SEAM(pb + 2);
        if (KIND(5) && IN(pb + 3)) {
            pg8::Gemm g{XB, (const bf16_t*)(ws + (layer ? WS_WGU1 : WS_WGU0)), M_TOK, GU, D}; pg8::StaticOrder S; S.init(M_TOK, GU, G, bx);
            pg8::EpiSwiGLU E{Zb, SS};
            pg8::gemm_phase<pg8::EpiSwiGLU, PG8_ALIGN, PG8_SP2>(lds, g, S, E);
        }
        SEAM(pb + 3);
        if (KIND(6) && IN(pb + 4)) {
            pg8::Gemm g{Zb, (const bf16_t*)(ws + (layer ? WS_WDN1 : WS_WDN0)), M_TOK, D, DFF}; pg8::StaticOrder S; S.init(M_TOK, D, G, bx);
            pg8::EpiResid E{(const float*)args.out, args.out, layer ? (bf16_t*)nullptr : XB, SS};
            pg8::gemm_phase<pg8::EpiResid, PG8_ALIGN, PG8_SP2>(lds, g, S, E);
        }
        SEAM(pb + 4);
    }
    if (KIND(7) && IN(11)) final_norm(args, vcu, G);
#undef IN
#undef SEAM
}

extern "C" void kernel_launch(void* const* d_in, const int* in_sizes, int n_in, void* d_out, int out_size, void* d_ws, size_t ws_size, hipStream_t stream) {
    static int grid = 0;
    if (grid == 0) {
        if (n_in != 22 || in_sizes[0] != M_TOK * D || out_size != M_TOK * D || ws_size < WS_END) {
            fprintf(stderr, "kernel_launch: unexpected shapes: n_in %d in0 %d out %d ws %zu (need %zu)\n", n_in, n_in > 0 ? in_sizes[0] : -1, out_size, ws_size, (size_t)WS_END); grid = -1; return; }
        int dev = 0, cus = 0, per_cu = 0;
        if (hipGetDevice(&dev) != hipSuccess || hipDeviceGetAttribute(&cus, hipDeviceAttributeMultiprocessorCount, dev) != hipSuccess) { fprintf(stderr, "kernel_launch: device query failed\n"); grid = -1; return; }
        if (hipFuncSetAttribute((const void*)trunk_fwd, hipFuncAttributeMaxDynamicSharedMemorySize, LDS_BYTES) != hipSuccess) { fprintf(stderr, "kernel_launch: hipFuncSetAttribute failed\n"); grid = -1; return; }
        if (hipOccupancyMaxActiveBlocksPerMultiprocessor(&per_cu, (const void*)trunk_fwd, NTHREADS, LDS_BYTES) != hipSuccess || per_cu < 1) { fprintf(stderr, "kernel_launch: occupancy query says %d blocks/CU\n", per_cu); per_cu = 1; }
        (void)hipGetLastError();
        grid = cus;
        fprintf(stderr, "kernel_launch: cus %d per_cu %d grid %d\n", cus, per_cu, grid);
    }
    if (grid < 0) return;
    Args a{};
    const float** f = (const float**)&a;
    for (int i = 0; i < 22; ++i) f[i] = (const float*)d_in[i];
    a.out = (float*)d_out; a.ws = (unsigned char*)d_ws;
#if MK_PER_PHASE
    for (int p = 0; p < 12; ++p) {
        a.ph_lo = p; a.ph_hi = p + 1;
        hipLaunchKernelGGL(trunk_fwd, dim3(grid), dim3(NTHREADS), LDS_BYTES, stream, a);
    }
#else
    a.ph_lo = 0; a.ph_hi = 12;
    void* kargs[] = {&a};
    hipError_t e = hipLaunchCooperativeKernel((const void*)trunk_fwd, dim3(grid), dim3(NTHREADS), kargs, LDS_BYTES, stream);
    if (e != hipSuccess) fprintf(stderr, "kernel_launch: cooperative launch failed: %s (grid %d)\n", hipGetErrorString(e), grid);
#endif
}
```

```cpp
#include <hip/hip_runtime.h>
#include <hip/hip_cooperative_groups.h>
#include <cstdio>
#include <cstdint>
namespace cg = cooperative_groups;

#ifndef MK_PER_PHASE
#define MK_PER_PHASE 0
#endif

#ifndef PROBE_DUP
#define PROBE_DUP 0
#endif

#define LAS __attribute__((address_space(3)))
typedef unsigned short bf16_t;
typedef short bf16x8 __attribute__((ext_vector_type(8)));
typedef short s16x4 __attribute__((ext_vector_type(4)));
typedef float f32x4 __attribute__((ext_vector_type(4)));
typedef float f32x2 __attribute__((ext_vector_type(2)));
typedef unsigned u32x4 __attribute__((ext_vector_type(4)));
typedef unsigned u32x2 __attribute__((ext_vector_type(2)));

constexpr int M_TOK = 32768, D = 1024, SEQ = 8192;
constexpr int EVEN_IN = 1536, ODD_IN = 2560, DFF = 2816, GU = 2 * DFF;
constexpr float EPS = 1e-6f;
constexpr int NWAVES = 8, NTHREADS = 512;

constexpr size_t MiB = 1u << 20;
constexpr size_t WS_CTL = 0, CTL_BYTES = 1 * MiB;
constexpr size_t WS_WIN0 = 2 * MiB, WS_WOUT0 = 5 * MiB, WS_WGU0 = 7 * MiB, WS_WDN0 = 18 * MiB;
constexpr size_t WS_WIN1 = 24 * MiB, WS_WOUT1 = 29 * MiB, WS_WGU1 = 31 * MiB, WS_WDN1 = 42 * MiB;
constexpr size_t WS_WS = 48 * MiB, WS_WP = 49 * MiB;
constexpr size_t WS_SS = 50 * MiB;
constexpr size_t WS_XB = 64 * MiB;
constexpr size_t WS_Y = 128 * MiB;
constexpr size_t WS_Z = 192 * MiB;
constexpr size_t WS_END = 368 * MiB;

constexpr int LDS_BYTES = 147456;
constexpr int LDS_MISC_OFF = LDS_BYTES - 256;
constexpr int CW_BAR = 4096;
#ifndef USE_CG_SYNC
#define USE_CG_SYNC 0
#endif

__device__ __forceinline__ unsigned cvt_pk_bf16(float lo, float hi) { unsigned r; asm volatile("v_cvt_pk_bf16_f32 %0, %1, %2" : "=v"(r) : "v"(lo), "v"(hi)); return r; }
__device__ __forceinline__ float bf_lo(unsigned u) { return __uint_as_float(u << 16); }
__device__ __forceinline__ float bf_hi(unsigned u) { return __uint_as_float(u & 0xffff0000u); }
__device__ __forceinline__ float wave_sum(float v) {
#pragma unroll
    for (int o = 1; o < 64; o <<= 1) v += __shfl_xor(v, o);
    return v;
}
__device__ __forceinline__ float sigmoid_f(float x) { return __builtin_amdgcn_rcpf(1.0f + __expf(-x)); }
__device__ __forceinline__ float silu_f(float x) { return x * sigmoid_f(x); }
__device__ __forceinline__ float gelu_tanh_f(float x) { const float u = 0.7978845608028654f * (x + 0.044715f * x * x * x); return x * sigmoid_f(2.0f * u); }
__device__ __forceinline__ void unpack8(const u32x4 r, float (&v)[8]) {
    v[0] = bf_lo(r.x); v[1] = bf_hi(r.x); v[2] = bf_lo(r.y); v[3] = bf_hi(r.y); v[4] = bf_lo(r.z); v[5] = bf_hi(r.z); v[6] = bf_lo(r.w); v[7] = bf_hi(r.w);
}
__device__ __forceinline__ u32x4 pack8(const float (&v)[8]) {
    u32x4 r; r.x = cvt_pk_bf16(v[0], v[1]); r.y = cvt_pk_bf16(v[2], v[3]); r.z = cvt_pk_bf16(v[4], v[5]); r.w = cvt_pk_bf16(v[6], v[7]); return r;
}
__device__ __forceinline__ float row_rstd(const float* ss, int row) {
    const f32x4* p = (const f32x4*)(ss + (size_t)row * 16);
    const f32x4 a = p[0], b = p[1], c = p[2], d = p[3];
    const f32x4 s = (a + b) + (c + d);
    return rsqrtf(((s.x + s.y) + (s.z + s.w)) * (1.0f / 1024.0f) + EPS);
}


typedef __attribute__((address_space(1))) unsigned gu32;
#define XB_TMO      128
#define XB_XCNT(j)  (256  + 64 * (j))
#define XB_XSUB(j)  (1280 + 64 * (j))
#define XB_XGEN(j)  (2304 + 64 * (j))
#define XB_TOP      3328
#define XB_TOPGEN   3392
#define XCD_BAR_WORDS 3456
#define XB_SPIN_CAP (1u << 18)
__device__ __forceinline__ unsigned xb_ld(unsigned* p)              { return __hip_atomic_load(p, __ATOMIC_RELAXED, __HIP_MEMORY_SCOPE_AGENT); }
__device__ __forceinline__ unsigned xb_add(unsigned* p, unsigned v) { return __hip_atomic_fetch_add(p, v, __ATOMIC_RELAXED, __HIP_MEMORY_SCOPE_AGENT); }
__device__ __forceinline__ unsigned xb_xcc_id() { return (unsigned)__builtin_amdgcn_s_getreg((3 << 11) | 20) & 0xFu; }
#define XB_SPIN(cond, bar) do { unsigned _sp = 0; while (cond) { __builtin_amdgcn_s_sleep(1); \
    if ((++_sp & 255u) == 0u) { if (xb_ld(&(bar)[XB_TMO])) break; if (_sp > XB_SPIN_CAP) { atomicAdd(&(bar)[XB_TMO], 1u); break; } } } } while (0)
struct XcdBarrier { unsigned* bar; unsigned x; volatile LAS unsigned* st; };
__device__ __forceinline__ XcdBarrier xcd_barrier_post(unsigned* bar, volatile LAS unsigned* st) {
    XcdBarrier b; b.bar = bar; b.x = xb_xcc_id(); b.st = st;
    if (threadIdx.x == 0) (void)xb_add(&bar[XB_XCNT(b.x)], 1u);
    return b;
}
__device__ __forceinline__ void xcd_barrier_complete(unsigned* bar, unsigned x, unsigned& nloc, unsigned& nx) {
    const unsigned G = gridDim.x * gridDim.y * gridDim.z;
    unsigned sum, cnt, mine, sp = 0u;
    for (;;) {
        sum = 0u; cnt = 0u; mine = 0u;
#pragma unroll
        for (unsigned j = 0; j < 16; ++j) { const unsigned c = xb_ld(&bar[XB_XCNT(j)]); sum += c; cnt += (c > 0u) ? 1u : 0u; mine = (j == x) ? c : mine; }
        if (sum == G) break;
        __builtin_amdgcn_s_sleep(1);
        if ((++sp & 255u) == 0u) { if (xb_ld(&bar[XB_TMO])) break; if (sp > XB_SPIN_CAP) { atomicAdd(&bar[XB_TMO], 1u); break; } }
    }
    nloc = mine > 0u ? mine : 1u; nx = cnt > 0u ? cnt : 1u;
}
__device__ __forceinline__ void xcd_barrier(const XcdBarrier& b) {
    asm volatile("s_waitcnt vmcnt(0)" ::: "memory");
    __syncthreads();
    if (threadIdx.x == 0) {
        unsigned* bar = b.bar;
        __builtin_amdgcn_s_waitcnt(0);
        unsigned nloc = b.st[0], nx = b.st[1];
        if (nloc == 0u) { xcd_barrier_complete(bar, b.x, nloc, nx); b.st[0] = nloc; b.st[1] = nx; }
        const unsigned old = xb_add(&bar[XB_XSUB(b.x)], 1u);
        const unsigned gen = old / nloc;
        if (old + 1u == (gen + 1u) * nloc) {
            __builtin_amdgcn_fence(__ATOMIC_RELEASE, "agent");
            asm volatile("s_waitcnt vmcnt(0)" ::: "memory");
            const unsigned og = xb_add(&bar[XB_TOP], 1u);
            const unsigned tg = og / nx;
            if (og + 1u == (tg + 1u) * nx) xb_add(&bar[XB_TOPGEN], 1u);
            else XB_SPIN(xb_ld(&bar[XB_TOPGEN]) == tg, bar);
            __builtin_amdgcn_fence(__ATOMIC_ACQUIRE, "agent");
            xb_add(&bar[XB_XGEN(b.x)], 1u);
            asm volatile("s_waitcnt vmcnt(0)" ::: "memory");
        } else {
            XB_SPIN(xb_ld(&bar[XB_XGEN(b.x)]) == gen, bar);
            __builtin_amdgcn_fence(__ATOMIC_ACQUIRE, "agent");
            asm volatile("s_waitcnt vmcnt(0)" ::: "memory");
        }
    }
    __syncthreads();
}

__device__ __forceinline__ float row_sumsq_part(const float* ss, int row, int fq) { const f32x4 a = *(const f32x4*)(ss + (size_t)row * 16 + 4 * fq); return (a.x + a.y) + (a.z + a.w); }
__device__ __forceinline__ float rstd_from_part(float p) { p += __shfl_xor(p, 16); p += __shfl_xor(p, 32); return rsqrtf(p * (1.0f / 1024.0f) + EPS); }

namespace pg8 {
constexpr int BM = 256, BK = 64, HALF = 128, HTB = HALF * BK * 2, STAGE_BYTES = 8 * HTB, NXCD = 8, WGM = 8;
__device__ __forceinline__ int lds_byte(int r, int c) { const int st = (r >> 4) * 2 + (c >> 5), rr = r & 15, cc = c & 31, ob = rr * 64 + cc * 2; return st * 1024 + (ob ^ (((ob >> 9) & 1) << 5)); }
__device__ __forceinline__ void stage_rc(int b, int& R, int& C) { const int st = b / 1024, sb = b % 1024, swz = sb ^ (((sb >> 9) & 1) << 5); R = (st >> 1) * 16 + swz / 64; C = (st & 1) * 32 + (swz % 64) / 2; }
__device__ __forceinline__ int perm32(int rho) { const int n = rho >> 4, i = rho & 15; return 8 * (i >> 2) + 4 * n + (i & 3); }

struct Unit { int pm, pn; };
struct Gemm { const bf16_t* A; const bf16_t* Bt; int M, N, K; };

struct StaticOrder {
    int nM, nN, nwg, G, c;
    __device__ void init(int M, int N, int G_, int c_) { nM = M / BM; nN = N / BM; nwg = nM * nN; G = G_; c = c_; }
    __device__ bool next(int i, Unit& u) const {
        const long L = (long)i * G + c; if (L >= nwg) return false;
        int wgid = (int)L; { const int q = nwg / NXCD, r = nwg % NXCD, xcd = wgid % NXCD, off = wgid / NXCD; wgid = (xcd < r ? xcd * (q + 1) : r * (q + 1) + (xcd - r) * q) + off; }
        const int nig = WGM * nN, gid = wgid / nig, fm = gid * WGM, gsz = (nM - fm) < WGM ? (nM - fm) : WGM;
        u.pm = fm + ((wgid % nig) % gsz); u.pn = (wgid % nig) / gsz; return true;
    }
};

struct EpiScaleBf16 {
    static constexpr bool PERM = true;
    bf16_t* O; int ldc; const float* ss; int gelu_tiles;
    __device__ __forceinline__ void operator()(const f32x4 (&acc)[2][2][4][2], const Unit& u, int wr, int wc, int fr, int fq) const {
        const int row0 = u.pm * BM + wr * 64 + fr, col0 = u.pn * BM + wc * 32 + 8 * fq;
        const bool act = u.pn < gelu_tiles;
        float part[2][4];
#pragma unroll
        for (int ai = 0; ai < 2; ++ai)
#pragma unroll
            for (int m = 0; m < 4; ++m) part[ai][m] = row_sumsq_part(ss, row0 + ai * HALF + m * 16, fq);
#pragma unroll
        for (int ai = 0; ai < 2; ++ai)
#pragma unroll
            for (int m = 0; m < 4; ++m) {
                const int row = row0 + ai * HALF + m * 16; const float rs = rstd_from_part(part[ai][m]);
                bf16_t* rowp = O + (size_t)row * ldc + col0;
#pragma unroll
                for (int bj = 0; bj < 2; ++bj) {
                    f32x4 v0 = acc[ai][bj][m][0] * rs, v1 = acc[ai][bj][m][1] * rs;
                    if (act) {
#pragma unroll
                        for (int j = 0; j < 4; ++j) { v0[j] = gelu_tanh_f(v0[j]); v1[j] = gelu_tanh_f(v1[j]); }
                    }
                    u32x4 w; w.x = cvt_pk_bf16(v0[0], v0[1]); w.y = cvt_pk_bf16(v0[2], v0[3]); w.z = cvt_pk_bf16(v1[0], v1[1]); w.w = cvt_pk_bf16(v1[2], v1[3]);
                    *(u32x4*)(rowp + bj * HALF) = w;
                }
            }
    }
};
struct EpiSwiGLU {
    static constexpr bool PERM = true;
    bf16_t* O; const float* ss;
    __device__ __forceinline__ void operator()(const f32x4 (&acc)[2][2][4][2], const Unit& u, int wr, int wc, int fr, int fq) const {
        const int row0 = u.pm * BM + wr * 64 + fr, f0 = u.pn * HALF + wc * 32 + 8 * fq;
        float part[2][4];
#pragma unroll
        for (int ai = 0; ai < 2; ++ai)
#pragma unroll
            for (int m = 0; m < 4; ++m) part[ai][m] = row_sumsq_part(ss, row0 + ai * HALF + m * 16, fq);
#pragma unroll
        for (int ai = 0; ai < 2; ++ai)
#pragma unroll
            for (int m = 0; m < 4; ++m) {
                const int row = row0 + ai * HALF + m * 16; const float rs = rstd_from_part(part[ai][m]);
                const f32x4 g0 = acc[ai][0][m][0] * rs, g1 = acc[ai][0][m][1] * rs, u0 = acc[ai][1][m][0] * rs, u1 = acc[ai][1][m][1] * rs;
                f32x4 a0, a1;
#pragma unroll
                for (int j = 0; j < 4; ++j) { a0[j] = silu_f(g0[j]) * u0[j]; a1[j] = silu_f(g1[j]) * u1[j]; }
                u32x4 w; w.x = cvt_pk_bf16(a0[0], a0[1]); w.y = cvt_pk_bf16(a0[2], a0[3]); w.z = cvt_pk_bf16(a1[0], a1[1]); w.w = cvt_pk_bf16(a1[2], a1[3]);
                *(u32x4*)(O + (size_t)row * DFF + f0) = w;
            }
    }
};
struct EpiResid {
    static constexpr bool PERM = true;
    bf16_t* xb; float* ss;
    __device__ __forceinline__ void operator()(const f32x4 (&acc)[2][2][4][2], const Unit& u, int wr, int wc, int fr, int fq) const {
        const int row0 = u.pm * BM + wr * 64 + fr, col0 = u.pn * BM + wc * 32 + 8 * fq;
#pragma unroll
        for (int ai = 0; ai < 2; ++ai) {
            u32x4 rv[4][2];
#pragma unroll
            for (int m = 0; m < 4; ++m)
#pragma unroll
                for (int bj = 0; bj < 2; ++bj) rv[m][bj] = *(const u32x4*)(xb + (size_t)(row0 + ai * HALF + m * 16) * D + col0 + bj * HALF);
#pragma unroll
            for (int m = 0; m < 4; ++m) {
                const int row = row0 + ai * HALF + m * 16; float q = 0.f;
#pragma unroll
                for (int bj = 0; bj < 2; ++bj) {
                    float r[8]; unpack8(rv[m][bj], r);
                    const f32x4 a0 = acc[ai][bj][m][0], a1 = acc[ai][bj][m][1];
                    float h[8];
#pragma unroll
                    for (int j = 0; j < 4; ++j) { h[j] = r[j] + a0[j]; h[4 + j] = r[4 + j] + a1[j]; }
#pragma unroll
                    for (int j = 0; j < 8; ++j) q += h[j] * h[j];
                    *(u32x4*)(xb + (size_t)row * D + col0 + bj * HALF) = pack8(h);
                }
                q += __shfl_xor(q, 16); q += __shfl_xor(q, 32);
                if (fq == 0) ss[(size_t)row * 16 + u.pn * 4 + wc] = q;
            }
            asm volatile("" ::: "memory");
        }
    }
};

template <class Epi, bool ALIGN_EPI, bool SP2>
__device__ __forceinline__ void gemm_phase(LAS unsigned char* lds, const Gemm g, const StaticOrder& S, const Epi& E) {
    int tid_ = threadIdx.x; asm volatile("" : "+v"(tid_));
    const int tid = tid_, wid = __builtin_amdgcn_readfirstlane(tid >> 6), lane = tid & 63, wr = wid >> 2, wc = wid & 3, fr = lane & 15, fq = lane >> 4;
    const int K = g.K, nt = K / BK;
    unsigned voffA[2], voffB[2];
#pragma unroll
    for (int i = 0; i < 2; ++i) { int R, C; stage_rc(tid * 16 + i * 8192, R, C); const int Rb = Epi::PERM ? ((R & ~31) + perm32(R & 31)) : R;
        voffA[i] = (unsigned)(R * K + C) * 2u; voffB[i] = (unsigned)(Rb * K + C) * 2u; }
    const size_t kstep = (size_t)(BK * 2);
    const size_t hstep = (size_t)HALF * K * 2;
    const size_t tstep = 2 * hstep;
    const unsigned ldsw = (unsigned)wid * 1024u;
    const int aoff = lds_byte(wr * 64 + fr, fq * 8), boff = lds_byte(wc * 32 + fr, fq * 8);
#define PG8_SA(b, h) (((b) * 2 + (h)) * HTB)
#define PG8_SB(b, h) ((4 + (b) * 2 + (h)) * HTB)
#define PG8_STAGE(bufoff, gbase, voff) do { _Pragma("unroll") for (int _i = 0; _i < 2; ++_i) \
        __builtin_amdgcn_global_load_lds((const unsigned*)((const char*)(gbase) + (voff)[_i]), (LAS unsigned*)(lds + (bufoff) + ldsw + _i * 8192), 16, 0, 0); } while (0)
#define PG8_LDA(dst, b, h) do { _Pragma("unroll") for (int m = 0; m < 4; ++m) _Pragma("unroll") for (int k = 0; k < 2; ++k) dst[m][k] = *(const LAS bf16x8*)(lds + PG8_SA(b, h) + aoff + m * 2048 + k * 1024); } while (0)
#define PG8_LDB(dst, b, h) do { _Pragma("unroll") for (int n = 0; n < 2; ++n) _Pragma("unroll") for (int k = 0; k < 2; ++k) dst[n][k] = *(const LAS bf16x8*)(lds + PG8_SB(b, h) + boff + n * 2048 + k * 1024); } while (0)
#define PG8_MMA(ai, bj, At, Bt) do { __builtin_amdgcn_s_setprio(1); _Pragma("unroll") for (int m = 0; m < 4; ++m) _Pragma("unroll") for (int n = 0; n < 2; ++n) _Pragma("unroll") for (int k = 0; k < 2; ++k) \
        acc[ai][bj][m][n] = __builtin_amdgcn_mfma_f32_16x16x32_bf16(Bt[n][k], At[m][k], acc[ai][bj][m][n], 0, 0, 0); __builtin_amdgcn_s_setprio(0); } while (0)
#define PG8_WAIT_V(n) asm volatile("s_waitcnt vmcnt(" #n ")" ::: "memory")
#define PG8_WAIT_L(n) asm volatile("s_waitcnt lgkmcnt(" #n ")" ::: "memory")
#define PG8_BAR __builtin_amdgcn_s_barrier()
#define PG8_SCHED __builtin_amdgcn_sched_barrier(0)
    Unit cur, nxt; int ui = 0;
    if (!S.next(0, cur)) return;
    f32x4 acc[2][2][4][2];
#pragma unroll
    for (int a = 0; a < 2; ++a)
#pragma unroll
        for (int b = 0; b < 2; ++b)
#pragma unroll
            for (int m = 0; m < 4; ++m)
#pragma unroll
                for (int n = 0; n < 2; ++n) acc[a][b][m][n] = (f32x4){0.f, 0.f, 0.f, 0.f};
    bf16x8 At[4][2], B0[2][2], B1[2][2];
    const char* cA = (const char*)g.A + (size_t)cur.pm * tstep; const char* cB = (const char*)g.Bt + (size_t)cur.pn * tstep;
    if constexpr (SP2) {
        PG8_STAGE(PG8_SB(0, 0), cB, voffB); PG8_STAGE(PG8_SB(0, 1), cB + hstep, voffB); PG8_STAGE(PG8_SA(0, 0), cA, voffA); PG8_STAGE(PG8_SA(0, 1), cA + hstep, voffA);
        if (wr == 1) PG8_BAR;
        PG8_WAIT_V(2); PG8_BAR;
        PG8_STAGE(PG8_SB(1, 0), cB + kstep, voffB); PG8_STAGE(PG8_SA(1, 0), cA + kstep, voffA); PG8_STAGE(PG8_SB(1, 1), cB + hstep + kstep, voffB);
        PG8_WAIT_V(6); PG8_BAR;
    } else {
        PG8_STAGE(PG8_SB(0, 0), cB, voffB); PG8_STAGE(PG8_SA(0, 0), cA, voffA); PG8_STAGE(PG8_SB(0, 1), cB + hstep, voffB); PG8_STAGE(PG8_SA(0, 1), cA + hstep, voffA);
        if (wr == 1) PG8_BAR;
        PG8_WAIT_V(4); PG8_BAR;
        PG8_STAGE(PG8_SB(1, 0), cB + kstep, voffB); PG8_STAGE(PG8_SA(1, 0), cA + kstep, voffA); PG8_STAGE(PG8_SB(1, 1), cB + hstep + kstep, voffB);
        PG8_WAIT_V(6); PG8_BAR;
    }
    for (;;) {
        const bool has_next = S.next(ui + 1, nxt);
        const char* nA = has_next ? (const char*)g.A + (size_t)nxt.pm * tstep : cA; const char* nB = has_next ? (const char*)g.Bt + (size_t)nxt.pn * tstep : cB;
        for (int t = 0; t < nt; t += 2) {
            const bool last = (t == nt - 2);
            const char* a1 = cA + (size_t)(t + 1) * kstep;
            const char* a2 = last ? nA : cA + (size_t)(t + 2) * kstep; const char* b2 = last ? nB : cB + (size_t)(t + 2) * kstep;
            const char* a3 = a2 + kstep; const char* b3 = b2 + kstep;
            if constexpr (SP2) {
            PG8_LDB(B0, 0, 0); PG8_LDB(B1, 0, 1); PG8_SCHED; PG8_LDA(At, 0, 0); PG8_STAGE(PG8_SA(1, 1), a1 + hstep, voffA);
            PG8_WAIT_V(8); PG8_WAIT_L(0); PG8_BAR; PG8_MMA(0, 0, At, B0); PG8_MMA(0, 1, At, B1); PG8_BAR; PG8_SCHED;
            PG8_LDA(At, 0, 1); PG8_STAGE(PG8_SB(0, 0), b2, voffB); PG8_STAGE(PG8_SB(0, 1), b2 + hstep, voffB); PG8_STAGE(PG8_SA(0, 0), a2, voffA);
            PG8_WAIT_V(8); PG8_WAIT_L(0); PG8_BAR; PG8_MMA(1, 0, At, B0); PG8_MMA(1, 1, At, B1); PG8_BAR; PG8_SCHED;
            PG8_LDB(B0, 1, 0); PG8_LDB(B1, 1, 1); PG8_SCHED; PG8_LDA(At, 1, 0); PG8_STAGE(PG8_SA(0, 1), a2 + hstep, voffA);
            PG8_WAIT_V(8); PG8_WAIT_L(0); PG8_BAR; PG8_MMA(0, 0, At, B0); PG8_MMA(0, 1, At, B1); PG8_BAR; PG8_SCHED;
            PG8_LDA(At, 1, 1); PG8_STAGE(PG8_SB(1, 0), b3, voffB); PG8_STAGE(PG8_SB(1, 1), b3 + hstep, voffB); PG8_STAGE(PG8_SA(1, 0), a3, voffA);
            PG8_WAIT_V(8); PG8_WAIT_L(0); PG8_BAR; PG8_MMA(1, 0, At, B0); PG8_MMA(1, 1, At, B1); PG8_BAR; PG8_SCHED;
            } else {
            PG8_LDB(B0, 0, 0); PG8_SCHED; PG8_LDA(At, 0, 0); PG8_STAGE(PG8_SA(1, 1), a1 + hstep, voffA);
            PG8_WAIT_L(8); PG8_BAR; PG8_WAIT_L(0); PG8_MMA(0, 0, At, B0); PG8_BAR; PG8_SCHED;
            PG8_LDB(B1, 0, 1); PG8_STAGE(PG8_SB(0, 0), b2, voffB);
            PG8_BAR; PG8_WAIT_L(0); PG8_MMA(0, 1, At, B1); PG8_BAR;
            PG8_LDA(At, 0, 1); PG8_STAGE(PG8_SA(0, 0), a2, voffA);
            PG8_BAR; PG8_WAIT_L(0); PG8_MMA(1, 0, At, B0); PG8_BAR; PG8_SCHED;
            PG8_STAGE(PG8_SB(0, 1), b2 + hstep, voffB);
            PG8_WAIT_V(6); PG8_BAR; PG8_MMA(1, 1, At, B1); PG8_BAR;
            PG8_LDB(B0, 1, 0); PG8_SCHED; PG8_LDA(At, 1, 0); PG8_STAGE(PG8_SA(0, 1), a2 + hstep, voffA);
            PG8_WAIT_L(8); PG8_BAR; PG8_WAIT_L(0); PG8_MMA(0, 0, At, B0); PG8_BAR; PG8_SCHED;
            PG8_LDB(B1, 1, 1); PG8_STAGE(PG8_SB(1, 0), b3, voffB);
            PG8_BAR; PG8_WAIT_L(0); PG8_MMA(0, 1, At, B1); PG8_BAR;
            PG8_LDA(At, 1, 1); PG8_STAGE(PG8_SA(1, 0), a3, voffA);
            PG8_BAR; PG8_WAIT_L(0); PG8_MMA(1, 0, At, B0); PG8_BAR; PG8_SCHED;
            PG8_STAGE(PG8_SB(1, 1), b3 + hstep, voffB);
            PG8_WAIT_V(6); PG8_BAR; PG8_MMA(1, 1, At, B1); PG8_BAR;
            }
        }
        if constexpr (ALIGN_EPI) { if (wr == 0) PG8_BAR; }
        E(acc, cur, wr, wc, fr, fq);
        if (!has_next) break;
#pragma unroll
        for (int a = 0; a < 2; ++a)
#pragma unroll
            for (int b = 0; b < 2; ++b)
#pragma unroll
                for (int m = 0; m < 4; ++m)
#pragma unroll
                    for (int n = 0; n < 2; ++n) acc[a][b][m][n] = (f32x4){0.f, 0.f, 0.f, 0.f};
        cur = nxt; cA = nA; cB = nB; ++ui;
        if constexpr (ALIGN_EPI) { if (wr == 1) PG8_BAR; }
    }
    PG8_WAIT_V(0);
    if constexpr (!ALIGN_EPI) { if (wr == 0) PG8_BAR; }
    PG8_BAR;
#undef PG8_SA
#undef PG8_SB
#undef PG8_STAGE
#undef PG8_LDA
#undef PG8_LDB
#undef PG8_MMA
#undef PG8_WAIT_V
#undef PG8_WAIT_L
#undef PG8_BAR
#undef PG8_SCHED
}
}

struct Args {
    const float* x; const float* even_w_in; const float* even_w_out; const float* a_w_s; const float* a_b_s; const float* a_ln_g; const float* a_ln_b;
    const float* b_w_pool; const float* b_scale; const float* odd_w_in; const float* odd_w_out; const float* c_w_dw; const float* c_b_dw; const float* c_ln_g; const float* c_ln_b;
    const float* d_w_dw; const float* norm_mix_g; const float* norm_ffn_g; const float* ffn_w_gate; const float* ffn_w_up; const float* ffn_w_down; const float* final_norm_g;
    float* out; unsigned char* ws; int ph_lo, ph_hi;
};

__device__ __forceinline__ void p0_transpose_item(const float* W, int K, int N, bf16_t* WT, int grp, int gstride, int goff, const float* gk, LAS float* scr, int item, int lane) {
    const int nblk = N / 32, kb = item / nblk, nb = item % nblk, k0 = 64 * kb, n0 = 32 * nb;
#pragma unroll 8
    for (int i = 0; i < 32; ++i) { const int kk = 2 * i + (lane >> 5); float v = W[(size_t)(k0 + kk) * N + n0 + (lane & 31)]; if (gk) v *= gk[k0 + kk]; scr[kk * 33 + (lane & 31)] = v; }
    asm volatile("s_waitcnt lgkmcnt(0)" ::: "memory");
    const int c = lane & 7;
    const int drow0 = (n0 / grp) * gstride + goff + (n0 % grp);
#pragma unroll
    for (int j = 0; j < 4; ++j) { const int n = (lane >> 3) + 8 * j; const LAS float* s = scr + (8 * c) * 33 + n;
        u32x4 o; o.x = cvt_pk_bf16(s[0 * 33], s[1 * 33]); o.y = cvt_pk_bf16(s[2 * 33], s[3 * 33]); o.z = cvt_pk_bf16(s[4 * 33], s[5 * 33]); o.w = cvt_pk_bf16(s[6 * 33], s[7 * 33]);
        *(u32x4*)(WT + (size_t)(drow0 + n) * K + k0 + 8 * c) = o; }
    asm volatile("s_waitcnt lgkmcnt(0)" ::: "memory");
}

__device__ __forceinline__ void p0_prologue(const Args& A, LAS unsigned char* lds, int vcu, int G) {
    int tid_ = threadIdx.x; asm volatile("" : "+v"(tid_));
    const int tid = tid_, lane = tid & 63, wave = __builtin_amdgcn_readfirstlane(tid >> 6);
    LAS float* scr = (LAS float*)(lds + wave * 16384);
    const int gw = vcu * NWAVES + wave, NGW = G * NWAVES;
    unsigned char* ws = A.ws;
    constexpr int I_IN0 = 16 * (EVEN_IN / 32), I_OUT = 16 * (D / 32), I_FF = 16 * (DFF / 32), I_DN = (DFF / 64) * (D / 32), I_IN1 = 16 * (ODD_IN / 32), I_WP = 2 * 4;
    constexpr int PER_LAYER_FFN = 2 * I_FF + I_DN;
    constexpr int NITEMS = I_IN0 + I_OUT + I_IN1 + I_OUT + 2 * PER_LAYER_FFN + 4 * I_WP;
    for (int it = gw; it < NITEMS; it += NGW) {
        int r = it;
        if (r < I_IN0) { p0_transpose_item(A.even_w_in, D, EVEN_IN, (bf16_t*)(ws + WS_WIN0), EVEN_IN, 0, 0, A.norm_mix_g, scr, r, lane); continue; } r -= I_IN0;
        if (r < I_OUT) { p0_transpose_item(A.even_w_out, D, D, (bf16_t*)(ws + WS_WOUT0), D, 0, 0, nullptr, scr, r, lane); continue; } r -= I_OUT;
        if (r < I_IN1) { p0_transpose_item(A.odd_w_in, D, ODD_IN, (bf16_t*)(ws + WS_WIN1), ODD_IN, 0, 0, A.norm_mix_g + D, scr, r, lane); continue; } r -= I_IN1;
        if (r < I_OUT) { p0_transpose_item(A.odd_w_out, D, D, (bf16_t*)(ws + WS_WOUT1), D, 0, 0, nullptr, scr, r, lane); continue; } r -= I_OUT;
        if (r < 2 * PER_LAYER_FFN) {
            const int layer = r / PER_LAYER_FFN; r -= layer * PER_LAYER_FFN;
            bf16_t* wgu = (bf16_t*)(ws + (layer ? WS_WGU1 : WS_WGU0)); bf16_t* wdn = (bf16_t*)(ws + (layer ? WS_WDN1 : WS_WDN0));
            const float* gk = A.norm_ffn_g + layer * D;
            if (r < I_FF) { p0_transpose_item(A.ffn_w_gate + (size_t)layer * D * DFF, D, DFF, wgu, 128, 256, 0, gk, scr, r, lane); continue; } r -= I_FF;
            if (r < I_FF) { p0_transpose_item(A.ffn_w_up + (size_t)layer * D * DFF, D, DFF, wgu, 128, 256, 128, gk, scr, r, lane); continue; } r -= I_FF;
            p0_transpose_item(A.ffn_w_down + (size_t)layer * DFF * D, DFF, D, wdn, D, 0, 0, nullptr, scr, r, lane); continue;
        }
        r -= 2 * PER_LAYER_FFN;
        { const int g = r / I_WP; r -= g * I_WP;
          p0_transpose_item(A.b_w_pool + (size_t)g * 128 * 128, 128, 128, (bf16_t*)(ws + WS_WP) + (size_t)g * 128 * 128, 128, 0, 0, nullptr, scr, r, lane); }
    }
    { bf16_t* wm = (bf16_t*)(ws + WS_WS);
      for (int e = (vcu * NTHREADS + tid) * 2; e < 4 * 128 * 128; e += G * NTHREADS * 2) {
          const int i = (e >> 7) & 127, j = e & 127; const bool keep = (i >> 6) >= (j >> 6);
          const float a = keep ? A.a_w_s[e] : 0.f, b = keep ? A.a_w_s[e + 1] : 0.f;
          *(unsigned*)(wm + e) = cvt_pk_bf16(a, b); } }
    { bf16_t* xb = (bf16_t*)(ws + WS_XB); float* ss = (float*)(ws + WS_SS);
      for (int m = gw; m < M_TOK; m += NGW) {
          const f32x4* xr = (const f32x4*)(A.x + (size_t)m * D) + lane; f32x4 v[4]; float s = 0.f;
#pragma unroll
          for (int j = 0; j < 4; ++j) { v[j] = xr[64 * j]; s += (v[j].x * v[j].x + v[j].y * v[j].y) + (v[j].z * v[j].z + v[j].w * v[j].w); }
          s = wave_sum(s);
          u32x2* o8 = (u32x2*)(xb + (size_t)m * D) + lane;
#pragma unroll
          for (int j = 0; j < 4; ++j) { u32x2 w; w.x = cvt_pk_bf16(v[j].x, v[j].y); w.y = cvt_pk_bf16(v[j].z, v[j].w); o8[64 * j] = w; }
          if (lane < 4) { f32x4 t = (f32x4){0.f, 0.f, 0.f, 0.f}; if (lane == 0) t.x = s; *((f32x4*)(ss + (size_t)m * 16) + lane) = t; }
      } }
}

constexpr int VN_STRIDE = 1056;
__device__ __forceinline__ void mixer_even(const Args& A, LAS unsigned char* lds, int vcu, int G) {
    int tid_ = threadIdx.x; asm volatile("" : "+v"(tid_));
    const int tid = tid_, lane = tid & 63, w = __builtin_amdgcn_readfirstlane(tid >> 6), fr = lane & 15, fq = lane >> 4;
    const bf16_t* Z = (const bf16_t*)(A.ws + WS_Z); bf16_t* Y = (bf16_t*)(A.ws + WS_Y);
    const bf16_t* Wm = (const bf16_t*)(A.ws + WS_WS); const bf16_t* WpT = (const bf16_t*)(A.ws + WS_WP);
    for (int blk = vcu; blk < M_TOK / 128; blk += G) {
        const int row_base = blk * 128;
        {
            float lg[8], lb[8];
            { const f32x4 g0 = *(const f32x4*)(A.a_ln_g + 8 * lane), g1 = *(const f32x4*)(A.a_ln_g + 8 * lane + 4), b0 = *(const f32x4*)(A.a_ln_b + 8 * lane), b1 = *(const f32x4*)(A.a_ln_b + 8 * lane + 4);
#pragma unroll
              for (int j = 0; j < 4; ++j) { lg[j] = g0[j]; lg[4 + j] = g1[j]; lb[j] = b0[j]; lb[4 + j] = b1[j]; } }
#pragma unroll 4
            for (int tt = 0; tt < 16; ++tt) {
                const int tok = 16 * w + tt; const size_t row = (size_t)(row_base + tok);
                const u32x4 raw = *(const u32x4*)(Z + row * EVEN_IN + 512 + 8 * lane);
                float v[8]; unpack8(raw, v);
                float s = ((v[0] + v[1]) + (v[2] + v[3])) + ((v[4] + v[5]) + (v[6] + v[7]));
                const float mu = wave_sum(s) * (1.0f / 512.0f);
                float q = 0.f;
#pragma unroll
                for (int j = 0; j < 8; ++j) { v[j] -= mu; q += v[j] * v[j]; }
                const float rstd = rsqrtf(wave_sum(q) * (1.0f / 512.0f) + EPS);
#pragma unroll
                for (int j = 0; j < 8; ++j) v[j] = v[j] * rstd * lg[j] + lb[j];
                *(LAS u32x4*)(lds + tok * VN_STRIDE + lane * 16) = pack8(v);
            }
        }
        __syncthreads();
        {
            const int h = w >> 1, dh = w & 1;
            const int q4 = (lane >> 2) & 3, p4 = lane & 3;
            const LAS unsigned char* vbase = lds + (4 * fq + q4) * VN_STRIDE + (h * 128 + dh * 64 + 4 * p4) * 2;
#pragma unroll
            for (int mh = 0; mh < 2; ++mh) {
                f32x4 acc[4][4];
#pragma unroll
                for (int m = 0; m < 4; ++m)
#pragma unroll
                    for (int n = 0; n < 4; ++n) acc[m][n] = (f32x4){0.f, 0.f, 0.f, 0.f};
#pragma unroll
                for (int ks = 0; ks < 4; ++ks) {
                    if (mh == 0 && ks >= 2) continue;
                    bf16x8 vf[4];
#pragma unroll
                    for (int n = 0; n < 4; ++n) {
                        const s16x4 lo = __builtin_amdgcn_ds_read_tr16_b64_v4i16((LAS s16x4*)(vbase + (ks * 32) * VN_STRIDE + n * 32));
                        const s16x4 hi = __builtin_amdgcn_ds_read_tr16_b64_v4i16((LAS s16x4*)(vbase + (ks * 32 + 16) * VN_STRIDE + n * 32));
                        vf[n] = (bf16x8){lo.x, lo.y, lo.z, lo.w, hi.x, hi.y, hi.z, hi.w};
                    }
#pragma unroll
                    for (int m = 0; m < 4; ++m) {
                        const bf16_t* wp = Wm + ((size_t)(h * 128 + (4 * mh + m) * 16 + fr) * 128 + ks * 32 + 4 * fq);
                        const u32x2 wlo = *(const u32x2*)wp, whi = *(const u32x2*)(wp + 16);
                        union { u32x4 u; bf16x8 b; } wf; wf.u = (u32x4){wlo.x, wlo.y, whi.x, whi.y};
#pragma unroll
                        for (int n = 0; n < 4; ++n) acc[m][n] = __builtin_amdgcn_mfma_f32_16x16x32_bf16(vf[n], wf.b, acc[m][n], 0, 0, 0);
                    }
                }
#pragma unroll
                for (int m = 0; m < 4; ++m) {
                    const int i = (4 * mh + m) * 16 + fr; const float bs = A.a_b_s[h * 128 + i]; const size_t row = (size_t)(row_base + i);
#pragma unroll
                    for (int n = 0; n < 4; ++n) {
                        const int d = h * 128 + dh * 64 + n * 16 + 4 * fq;
                        const u32x2 ur = *(const u32x2*)(Z + row * EVEN_IN + d);
                        const f32x4 sv = acc[m][n];
                        u32x2 o; o.x = cvt_pk_bf16(bf_lo(ur.x) * (sv.x + bs), bf_hi(ur.x) * (sv.y + bs)); o.y = cvt_pk_bf16(bf_lo(ur.y) * (sv.z + bs), bf_hi(ur.y) * (sv.w + bs));
                        *(u32x2*)(Y + row * D + d) = o;
                    }
                }
            }
        }
        {
            const int tok = 16 * w + fr; const int row = row_base + tok; const int pos = row & (SEQ - 1);
#pragma unroll 1
            for (int g = 0; g < 4; ++g) {
                const int win = 2 << g;
                const int cnt = (pos + 1 < win) ? pos + 1 : win; const float inv = 1.0f / (float)cnt;
                f32x4 acc[8];
#pragma unroll
                for (int n = 0; n < 8; ++n) acc[n] = (f32x4){0.f, 0.f, 0.f, 0.f};
#pragma unroll 1
                for (int ks = 0; ks < 4; ++ks) {
                    const int c0 = g * 128 + ks * 32 + 8 * fq;
                    const bf16_t* zp = Z + (size_t)row * EVEN_IN + 1024 + c0;
                    float x0[8]; unpack8(*(const u32x4*)zp, x0);
                    float s[8];
#pragma unroll
                    for (int j = 0; j < 8; ++j) s[j] = x0[j];
                    for (int k = 1; k < cnt; ++k) { float xv[8]; unpack8(*(const u32x4*)(zp - (size_t)k * EVEN_IN), xv);
#pragma unroll
                        for (int j = 0; j < 8; ++j) s[j] += xv[j]; }
#pragma unroll
                    for (int j = 0; j < 8; ++j) s[j] = s[j] * inv - x0[j];
                    union { u32x4 u; bf16x8 b; } pf; pf.u = pack8(s);
#pragma unroll
                    for (int n = 0; n < 8; ++n) {
                        const bf16x8 wf = *(const bf16x8*)(WpT + ((size_t)(g * 128 + n * 16 + fr) * 128 + ks * 32 + 8 * fq));
                        acc[n] = __builtin_amdgcn_mfma_f32_16x16x32_bf16(wf, pf.b, acc[n], 0, 0, 0);
                    }
                }
#pragma unroll
                for (int n = 0; n < 8; ++n) {
                    const int d = g * 128 + n * 16 + 4 * fq;
                    const f32x4 sc = *(const f32x4*)(A.b_scale + d);
                    u32x2 o; o.x = cvt_pk_bf16(acc[n].x * sc.x, acc[n].y * sc.y); o.y = cvt_pk_bf16(acc[n].z * sc.z, acc[n].w * sc.w);
                    *(u32x2*)(Y + (size_t)row * D + 512 + d) = o;
                }
            }
        }
        __syncthreads();
    }
}

template <int S, int T> __device__ __forceinline__ void conv_t(f32x2 (&acc)[32], const f32x2 (&wt)[31], const f32x2 hv) {
    if constexpr (T < 32) { if constexpr (S - T >= 0 && S - T <= 30) acc[T] = acc[T] + wt[S - T] * hv; conv_t<S, T + 1>(acc, wt, hv); }
}
template <int S> __device__ __forceinline__ void conv_s(f32x2 (&acc)[32], const f32x2 (&wt)[31], const LAS unsigned char* hp) {
    if constexpr (S < 62) {
        const unsigned hr = *(const LAS unsigned*)(hp + S * 1024);
        conv_t<S, 0>(acc, wt, (f32x2){bf_lo(hr), bf_hi(hr)});
        conv_s<S + 1>(acc, wt, hp);
    }
}
__device__ __forceinline__ void mixer_odd(const Args& A, LAS unsigned char* lds, int vcu, int G) {
    int tid_ = threadIdx.x; asm volatile("" : "+v"(tid_));
    const int tid = tid_, lane = tid & 63, w = __builtin_amdgcn_readfirstlane(tid >> 6);
    const bf16_t* Z = (const bf16_t*)(A.ws + WS_Z); bf16_t* Y = (bf16_t*)(A.ws + WS_Y);
    constexpr int TT = 64, HALO = 30, HROWS = TT + HALO;
    for (int tile = vcu; tile < M_TOK / TT; tile += G) {
        const int t0 = tile * TT; const int pos0 = t0 & (SEQ - 1);
        for (int task = tid; task < HROWS * 64; task += NTHREADS) {
            const int r = task >> 6, c8 = task & 63; const int pos = pos0 + r - HALO;
            u32x4 o = (u32x4){0u, 0u, 0u, 0u};
            if (pos >= 0) {
                const bf16_t* zp = Z + (size_t)(t0 + r - HALO) * ODD_IN + 8 * c8;
                float a[8], g[8]; unpack8(*(const u32x4*)zp, a); unpack8(*(const u32x4*)(zp + 512), g);
#pragma unroll
                for (int j = 0; j < 8; ++j) a[j] = a[j] * sigmoid_f(g[j]);
                o = pack8(a);
            }
            *(LAS u32x4*)(lds + r * 1024 + c8 * 16) = o;
        }
        __syncthreads();
        const int cp = tid & 255, th = tid >> 8;
        f32x2 acc[32];
        {
            f32x2 wt[31];
            const float* wbase = A.c_w_dw + 2 * cp;
#pragma unroll
            for (int j = 0; j < 31; ++j) wt[j] = *(const f32x2*)(wbase + j * 512);
            const f32x2 bias = *(const f32x2*)(A.c_b_dw + 2 * cp);
#pragma unroll
            for (int t = 0; t < 32; ++t) acc[t] = bias;
            const LAS unsigned char* hp = lds + (32 * th) * 1024 + 4 * cp;
            conv_s<0>(acc, wt, hp);
        }
        __syncthreads();
#pragma unroll
        for (int t = 0; t < 32; ++t) *(LAS unsigned*)(lds + (32 * th + t) * 1024 + 4 * cp) = cvt_pk_bf16(acc[t].x, acc[t].y);
        __syncthreads();
        {
            float lg[8], lb[8];
            { const f32x4 g0 = *(const f32x4*)(A.c_ln_g + 8 * lane), g1 = *(const f32x4*)(A.c_ln_g + 8 * lane + 4), b0 = *(const f32x4*)(A.c_ln_b + 8 * lane), b1 = *(const f32x4*)(A.c_ln_b + 8 * lane + 4);
#pragma unroll
              for (int j = 0; j < 4; ++j) { lg[j] = g0[j]; lg[4 + j] = g1[j]; lb[j] = b0[j]; lb[4 + j] = b1[j]; } }
#pragma unroll 2
            for (int tt = 0; tt < 8; ++tt) {
                const int tok = 8 * w + tt;
                float v[8]; unpack8(*(const LAS u32x4*)(lds + tok * 1024 + lane * 16), v);
                float s = ((v[0] + v[1]) + (v[2] + v[3])) + ((v[4] + v[5]) + (v[6] + v[7]));
                const float mu = wave_sum(s) * (1.0f / 512.0f);
                float q = 0.f;
#pragma unroll
                for (int j = 0; j < 8; ++j) { v[j] -= mu; q += v[j] * v[j]; }
                const float rstd = rsqrtf(wave_sum(q) * (1.0f / 512.0f) + EPS);
#pragma unroll
                for (int j = 0; j < 8; ++j) v[j] = silu_f(v[j] * rstd * lg[j] + lb[j]);
                *(u32x4*)(Y + (size_t)(t0 + tok) * D + 8 * lane) = pack8(v);
            }
        }
        {
            const int c8 = tid & 63, tsub = tid >> 6;
            float w0[8], w1[8], w2[8];
            { const float* wp = A.d_w_dw + 8 * c8;
              const f32x4 a0 = *(const f32x4*)wp, a1 = *(const f32x4*)(wp + 4), b0 = *(const f32x4*)(wp + 512), b1 = *(const f32x4*)(wp + 516), c0 = *(const f32x4*)(wp + 1024), c1 = *(const f32x4*)(wp + 1028);
#pragma unroll
              for (int j = 0; j < 4; ++j) { w0[j] = a0[j]; w0[4 + j] = a1[j]; w1[j] = b0[j]; w1[4 + j] = b1[j]; w2[j] = c0[j]; w2[4 + j] = c1[j]; } }
#pragma unroll 2
            for (int it = 0; it < 8; ++it) {
                const int tok = it * 8 + tsub; const int row = t0 + tok; const int pos = pos0 + tok;
                const bf16_t* zp = Z + (size_t)row * ODD_IN + 1024 + 8 * c8;
                float bg[8], c[8], xi[8], p[8], o[8];
                unpack8(*(const u32x4*)zp, bg);
                unpack8(*(const u32x4*)(zp + 512), c); unpack8(*(const u32x4*)(zp + 1024), xi);
#pragma unroll
                for (int j = 0; j < 8; ++j) o[j] = w2[j] * (c[j] * xi[j]);
                if (pos >= 1) { unpack8(*(const u32x4*)(zp - ODD_IN + 512), c); unpack8(*(const u32x4*)(zp - ODD_IN + 1024), xi);
#pragma unroll
                    for (int j = 0; j < 8; ++j) o[j] += w1[j] * (c[j] * xi[j]); }
                if (pos >= 2) { unpack8(*(const u32x4*)(zp - 2 * ODD_IN + 512), c); unpack8(*(const u32x4*)(zp - 2 * ODD_IN + 1024), xi);
#pragma unroll
                    for (int j = 0; j < 8; ++j) o[j] += w0[j] * (c[j] * xi[j]); }
#pragma unroll
                for (int j = 0; j < 8; ++j) p[j] = bg[j] * o[j];
                *(u32x4*)(Y + (size_t)row * D + 512 + 8 * c8) = pack8(p);
            }
        }
        __syncthreads();
    }
}

__device__ __forceinline__ void final_norm(const Args& A, int vcu, int G) {
    int tid_ = threadIdx.x; asm volatile("" : "+v"(tid_));
    const int tid = tid_, lane = tid & 63, wave = __builtin_amdgcn_readfirstlane(tid >> 6);
    const int gw = vcu * NWAVES + wave, NGW = G * NWAVES;
    const float* ss = (const float*)(A.ws + WS_SS); const bf16_t* xb = (const bf16_t*)(A.ws + WS_XB);
    f32x4 gg[4];
#pragma unroll
    for (int j = 0; j < 4; ++j) gg[j] = *((const f32x4*)A.final_norm_g + 2 * lane + 128 * (j >> 1) + (j & 1));
    for (int m = gw; m < M_TOK; m += NGW) {
        const float rs = row_rstd(ss, m);
        const u32x4* xr = (const u32x4*)(xb + (size_t)m * D) + lane;
        f32x4* orow = (f32x4*)(A.out + (size_t)m * D);
#pragma unroll
        for (int hh = 0; hh < 2; ++hh) {
            float v[8]; unpack8(xr[64 * hh], v);
            orow[128 * hh + 2 * lane] = (f32x4){v[0], v[1], v[2], v[3]} * rs * gg[2 * hh];
            orow[128 * hh + 2 * lane + 1] = (f32x4){v[4], v[5], v[6], v[7]} * rs * gg[2 * hh + 1];
        }
    }
}

#ifndef PG8_SP2
#define PG8_SP2 true
#endif
#ifndef PG8_ALIGN
#define PG8_ALIGN true
#endif
__global__ void __launch_bounds__(NTHREADS, 2) trunk_fwd(Args args) {
    extern __shared__ __attribute__((aligned(16))) unsigned char lds_raw[];
    LAS unsigned char* lds = (LAS unsigned char*)lds_raw;
    const int G = gridDim.x, bx = blockIdx.x;
    const int vcu = (G % 8 == 0) ? (bx % 8) * (G / 8) + bx / 8 : bx;
    const int lo = args.ph_lo, hi = args.ph_hi;
    unsigned char* ws = args.ws;
    bf16_t* XB = (bf16_t*)(ws + WS_XB); bf16_t* Yb = (bf16_t*)(ws + WS_Y); bf16_t* Zb = (bf16_t*)(ws + WS_Z); float* SS = (float*)(ws + WS_SS);
#ifndef KIND_MASK
#define KIND_MASK 0xff
#endif
#define KIND(b) (((KIND_MASK) >> (b)) & 1)
#define IN(k) (lo <= (k) && (k) < hi)
#if USE_CG_SYNC
#define SEAM(k) do { if (IN(k) && IN((k) + 1)) { cg::this_grid().sync(); } } while (0)
#else
    if (threadIdx.x < 2) ((volatile LAS unsigned*)(lds + LDS_MISC_OFF))[threadIdx.x] = 0u;
    __syncthreads();
    XcdBarrier bar = xcd_barrier_post((unsigned*)(ws + WS_CTL) + CW_BAR, (volatile LAS unsigned*)(lds + LDS_MISC_OFF));
    if (args.ph_lo < 0) cg::this_grid().sync();
#define SEAM(k) do { if (IN(k) && IN((k) + 1)) { xcd_barrier(bar); } } while (0)
#endif

    if (KIND(0) && IN(0)) { p0_prologue(args, lds, vcu, G); }
    SEAM(0);
#pragma unroll 1
    for (int layer = 0; layer < 2; ++layer) {
        const int pb = 1 + 5 * layer;
        if (KIND(1) && IN(pb + 0)) {
            const int N = layer ? ODD_IN : EVEN_IN;
            pg8::Gemm g{XB, (const bf16_t*)(ws + (layer ? WS_WIN1 : WS_WIN0)), M_TOK, N, D}; pg8::StaticOrder S; S.init(M_TOK, N, G, bx);
            pg8::EpiScaleBf16 E{Zb, N, SS, layer ? 0 : 4};
            pg8::gemm_phase<pg8::EpiScaleBf16, PG8_ALIGN, PG8_SP2>(lds, g, S, E);
        }
        SEAM(pb + 0);
        if (IN(pb + 1)) { if (layer == 0) { if (KIND(2)) mixer_even(args, lds, vcu, G); } else { if (KIND(3)) mixer_odd(args, lds, vcu, G); } }
        SEAM(pb + 1);
        if (KIND(4) && IN(pb + 2)) {
            pg8::Gemm g{Yb, (const bf16_t*)(ws + (layer ? WS_WOUT1 : WS_WOUT0)), M_TOK, D, D}; pg8::StaticOrder S; S.init(M_TOK, D, G, bx);
            pg8::EpiResid E{XB, SS};
            pg8::gemm_phase<pg8::EpiResid, PG8_ALIGN, PG8_SP2>(lds, g, S, E);
        }
        SEAM(pb + 2);
        if (KIND(5) && IN(pb + 3)) {
            pg8::Gemm g{XB, (const bf16_t*)(ws + (layer ? WS_WGU1 : WS_WGU0)), M_TOK, GU, D}; pg8::StaticOrder S; S.init(M_TOK, GU, G, bx);
            pg8::EpiSwiGLU E{Zb, SS};
            pg8::gemm_phase<pg8::EpiSwiGLU, PG8_ALIGN, PG8_SP2>(lds, g, S, E);
        }
        SEAM(pb + 3);
        if (KIND(6) && IN(pb + 4)) {
            pg8::Gemm g{Zb, (const bf16_t*)(ws + (layer ? WS_WDN1 : WS_WDN0)), M_TOK, D, DFF}; pg8::StaticOrder S; S.init(M_TOK, D, G, bx);
            pg8::EpiResid E{XB, SS};
            pg8::gemm_phase<pg8::EpiResid, PG8_ALIGN, PG8_SP2>(lds, g, S, E);
        }
        SEAM(pb + 4);
    }
    if (KIND(7) && IN(11)) final_norm(args, vcu, G);
#undef IN
#undef SEAM
}

extern "C" void kernel_launch(void* const* d_in, const int* in_sizes, int n_in, void* d_out, int out_size, void* d_ws, size_t ws_size, hipStream_t stream) {
    static int grid = 0;
    if (grid == 0) {
        if (n_in != 22 || in_sizes[0] != M_TOK * D || out_size != M_TOK * D || ws_size < WS_END) {
            fprintf(stderr, "kernel_launch: unexpected shapes: n_in %d in0 %d out %d ws %zu (need %zu)\n", n_in, n_in > 0 ? in_sizes[0] : -1, out_size, ws_size, (size_t)WS_END); grid = -1; return; }
        int dev = 0, cus = 0, per_cu = 0;
        if (hipGetDevice(&dev) != hipSuccess || hipDeviceGetAttribute(&cus, hipDeviceAttributeMultiprocessorCount, dev) != hipSuccess) { fprintf(stderr, "kernel_launch: device query failed\n"); grid = -1; return; }
        if (hipFuncSetAttribute((const void*)trunk_fwd, hipFuncAttributeMaxDynamicSharedMemorySize, LDS_BYTES) != hipSuccess) { fprintf(stderr, "kernel_launch: hipFuncSetAttribute failed\n"); grid = -1; return; }
        if (hipOccupancyMaxActiveBlocksPerMultiprocessor(&per_cu, (const void*)trunk_fwd, NTHREADS, LDS_BYTES) != hipSuccess || per_cu < 1) { fprintf(stderr, "kernel_launch: occupancy query says %d blocks/CU\n", per_cu); per_cu = 1; }
        (void)hipGetLastError();
        grid = cus;
        fprintf(stderr, "kernel_launch: cus %d per_cu %d grid %d\n", cus, per_cu, grid);
    }
    if (grid < 0) return;
    Args a{};
    const float** f = (const float**)&a;
    for (int i = 0; i < 22; ++i) f[i] = (const float*)d_in[i];
    a.out = (float*)d_out; a.ws = (unsigned char*)d_ws;
#if MK_PER_PHASE
    for (int p = 0; p < 12; ++p) {
        a.ph_lo = p; a.ph_hi = p + 1;
        for (int rep = 0; rep < 1 + ((PROBE_DUP >> p) & 1); ++rep)
            hipLaunchKernelGGL(trunk_fwd, dim3(grid), dim3(NTHREADS), LDS_BYTES, stream, a);
    }
#else
    a.ph_lo = 0; a.ph_hi = 12;
    if (hipMemsetAsync((char*)d_ws + WS_CTL, 0, 65536, stream) != hipSuccess) { fprintf(stderr, "kernel_launch: memset failed\n"); return; }
    void* kargs[] = {&a};
    hipError_t e = hipLaunchCooperativeKernel((const void*)trunk_fwd, dim3(grid), dim3(NTHREADS), kargs, LDS_BYTES, stream);
    if (e != hipSuccess) fprintf(stderr, "kernel_launch: cooperative launch failed: %s (grid %d)\n", hipGetErrorString(e), grid);
#endif
}
```

```cpp
#include <hip/hip_runtime.h>
#include <hip/hip_cooperative_groups.h>
#include <cstdio>
#include <cstdint>
namespace cg = cooperative_groups;

#ifndef MK_PER_PHASE
#define MK_PER_PHASE 0
#endif

#ifndef PROBE_DUP
#define PROBE_DUP 0
#endif

#define LAS __attribute__((address_space(3)))
typedef unsigned short bf16_t;
typedef short bf16x8 __attribute__((ext_vector_type(8)));
typedef short s16x4 __attribute__((ext_vector_type(4)));
typedef float f32x4 __attribute__((ext_vector_type(4)));
typedef float f32x2 __attribute__((ext_vector_type(2)));
typedef unsigned u32x4 __attribute__((ext_vector_type(4)));
typedef unsigned u32x2 __attribute__((ext_vector_type(2)));

constexpr int M_TOK = 32768, D = 1024, SEQ = 8192;
constexpr int EVEN_IN = 1536, ODD_IN = 2560, DFF = 2816, GU = 2 * DFF;
constexpr float EPS = 1e-6f;
constexpr int NWAVES = 8, NTHREADS = 512;

constexpr size_t MiB = 1u << 20;
constexpr size_t WS_CTL = 0, CTL_BYTES = 1 * MiB;
constexpr size_t WS_WIN0 = 2 * MiB, WS_WOUT0 = 5 * MiB, WS_WGU0 = 7 * MiB, WS_WDN0 = 18 * MiB;
constexpr size_t WS_WIN1 = 24 * MiB, WS_WOUT1 = 29 * MiB, WS_WGU1 = 31 * MiB, WS_WDN1 = 42 * MiB;
constexpr size_t WS_WS = 48 * MiB, WS_WP = 49 * MiB;
constexpr size_t WS_SS = 50 * MiB;
constexpr size_t WS_XB = 64 * MiB;
constexpr size_t WS_Y = 128 * MiB;
constexpr size_t WS_Z = 192 * MiB;
constexpr size_t WS_END = 368 * MiB;

constexpr int LDS_BYTES = 147456;
constexpr int LDS_MISC_OFF = LDS_BYTES - 256;
constexpr int CW_BAR = 4096;
#ifndef USE_CG_SYNC
#define USE_CG_SYNC 0
#endif

__device__ __forceinline__ unsigned cvt_pk_bf16(float lo, float hi) { unsigned r; asm volatile("v_cvt_pk_bf16_f32 %0, %1, %2" : "=v"(r) : "v"(lo), "v"(hi)); return r; }
#define OPAQUE_S(p) asm volatile("" : "+s"(p))
__device__ __forceinline__ float bf_lo(unsigned u) { return __uint_as_float(u << 16); }
__device__ __forceinline__ float bf_hi(unsigned u) { return __uint_as_float(u & 0xffff0000u); }
__device__ __forceinline__ float wave_sum(float v) {
#pragma unroll
    for (int o = 1; o < 64; o <<= 1) v += __shfl_xor(v, o);
    return v;
}
__device__ __forceinline__ float sigmoid_f(float x) { return __builtin_amdgcn_rcpf(1.0f + __expf(-x)); }
__device__ __forceinline__ float silu_f(float x) { return x * sigmoid_f(x); }
__device__ __forceinline__ float gelu_tanh_f(float x) { const float u = 0.7978845608028654f * (x + 0.044715f * x * x * x); return x * sigmoid_f(2.0f * u); }
__device__ __forceinline__ void unpack8(const u32x4 r, float (&v)[8]) {
    v[0] = bf_lo(r.x); v[1] = bf_hi(r.x); v[2] = bf_lo(r.y); v[3] = bf_hi(r.y); v[4] = bf_lo(r.z); v[5] = bf_hi(r.z); v[6] = bf_lo(r.w); v[7] = bf_hi(r.w);
}
__device__ __forceinline__ u32x4 pack8(const float (&v)[8]) {
    u32x4 r; r.x = cvt_pk_bf16(v[0], v[1]); r.y = cvt_pk_bf16(v[2], v[3]); r.z = cvt_pk_bf16(v[4], v[5]); r.w = cvt_pk_bf16(v[6], v[7]); return r;
}
__device__ __forceinline__ float row_rstd(const float* ss, int row) {
    const f32x4* p = (const f32x4*)(ss + (size_t)row * 16);
    const f32x4 a = p[0], b = p[1], c = p[2], d = p[3];
    const f32x4 s = (a + b) + (c + d);
    return rsqrtf(((s.x + s.y) + (s.z + s.w)) * (1.0f / 1024.0f) + EPS);
}


typedef __attribute__((address_space(1))) unsigned gu32;
#define XB_TMO      128
#define XB_XCNT(j)  (256  + 64 * (j))
#define XB_XSUB(j)  (1280 + 64 * (j))
#define XB_XGEN(j)  (2304 + 64 * (j))
#define XB_TOP      3328
#define XB_TOPGEN   3392
#define XCD_BAR_WORDS 3456
#define XB_SPIN_CAP (1u << 18)
__device__ __forceinline__ unsigned xb_ld(unsigned* p)              { return __hip_atomic_load(p, __ATOMIC_RELAXED, __HIP_MEMORY_SCOPE_AGENT); }
__device__ __forceinline__ unsigned xb_add(unsigned* p, unsigned v) { return __hip_atomic_fetch_add(p, v, __ATOMIC_RELAXED, __HIP_MEMORY_SCOPE_AGENT); }
__device__ __forceinline__ unsigned xb_xcc_id() { return (unsigned)__builtin_amdgcn_s_getreg((3 << 11) | 20) & 0xFu; }
#define XB_SPIN(cond, bar) do { unsigned _sp = 0; while (cond) { __builtin_amdgcn_s_sleep(1); \
    if ((++_sp & 255u) == 0u) { if (xb_ld(&(bar)[XB_TMO])) break; if (_sp > XB_SPIN_CAP) { atomicAdd(&(bar)[XB_TMO], 1u); break; } } } } while (0)
struct XcdBarrier { unsigned* bar; unsigned x; volatile LAS unsigned* st; };
__device__ __forceinline__ XcdBarrier xcd_barrier_post(unsigned* bar, volatile LAS unsigned* st) {
    XcdBarrier b; b.bar = bar; b.x = xb_xcc_id(); b.st = st;
    if (threadIdx.x == 0) (void)xb_add(&bar[XB_XCNT(b.x)], 1u);
    return b;
}
__device__ __forceinline__ void xcd_barrier_complete(unsigned* bar, unsigned x, unsigned& nloc, unsigned& nx) {
    const unsigned G = gridDim.x * gridDim.y * gridDim.z;
    unsigned sum, cnt, mine, sp = 0u;
    for (;;) {
        sum = 0u; cnt = 0u; mine = 0u;
#pragma unroll
        for (unsigned j = 0; j < 16; ++j) { const unsigned c = xb_ld(&bar[XB_XCNT(j)]); sum += c; cnt += (c > 0u) ? 1u : 0u; mine = (j == x) ? c : mine; }
        if (sum == G) break;
        __builtin_amdgcn_s_sleep(1);
        if ((++sp & 255u) == 0u) { if (xb_ld(&bar[XB_TMO])) break; if (sp > XB_SPIN_CAP) { atomicAdd(&bar[XB_TMO], 1u); break; } }
    }
    nloc = mine > 0u ? mine : 1u; nx = cnt > 0u ? cnt : 1u;
}
__device__ __forceinline__ void xcd_barrier(const XcdBarrier& b) {
    asm volatile("s_waitcnt vmcnt(0)" ::: "memory");
    __syncthreads();
    if (threadIdx.x == 0) {
        unsigned* bar = b.bar;
        __builtin_amdgcn_s_waitcnt(0);
        unsigned nloc = b.st[0], nx = b.st[1];
        if (nloc == 0u) { xcd_barrier_complete(bar, b.x, nloc, nx); b.st[0] = nloc; b.st[1] = nx; }
        const unsigned old = xb_add(&bar[XB_XSUB(b.x)], 1u);
        const unsigned gen = old / nloc;
        if (old + 1u == (gen + 1u) * nloc) {
            __builtin_amdgcn_fence(__ATOMIC_RELEASE, "agent");
            asm volatile("s_waitcnt vmcnt(0)" ::: "memory");
            const unsigned og = xb_add(&bar[XB_TOP], 1u);
            const unsigned tg = og / nx;
            if (og + 1u == (tg + 1u) * nx) xb_add(&bar[XB_TOPGEN], 1u);
            else XB_SPIN(xb_ld(&bar[XB_TOPGEN]) == tg, bar);
            __builtin_amdgcn_fence(__ATOMIC_ACQUIRE, "agent");
            xb_add(&bar[XB_XGEN(b.x)], 1u);
            asm volatile("s_waitcnt vmcnt(0)" ::: "memory");
        } else {
            XB_SPIN(xb_ld(&bar[XB_XGEN(b.x)]) == gen, bar);
            __builtin_amdgcn_fence(__ATOMIC_ACQUIRE, "agent");
            asm volatile("s_waitcnt vmcnt(0)" ::: "memory");
        }
    }
    __syncthreads();
}

__device__ __forceinline__ float row_sumsq_part(const float* ss, int row, int fq) { const f32x4 a = *(const f32x4*)(ss + (size_t)row * 16 + 4 * fq); return (a.x + a.y) + (a.z + a.w); }
__device__ __forceinline__ float rstd_from_part(float p) { p += __shfl_xor(p, 16); p += __shfl_xor(p, 32); return rsqrtf(p * (1.0f / 1024.0f) + EPS); }

namespace pg8 {
constexpr int BM = 256, BK = 64, HALF = 128, HTB = HALF * BK * 2, STAGE_BYTES = 8 * HTB, NXCD = 8, WGM = 8;
__device__ __forceinline__ int lds_byte(int r, int c) { const int st = (r >> 4) * 2 + (c >> 5), rr = r & 15, cc = c & 31, ob = rr * 64 + cc * 2; return st * 1024 + (ob ^ (((ob >> 9) & 1) << 5)); }
__device__ __forceinline__ void stage_rc(int b, int& R, int& C) { const int st = b / 1024, sb = b % 1024, swz = sb ^ (((sb >> 9) & 1) << 5); R = (st >> 1) * 16 + swz / 64; C = (st & 1) * 32 + (swz % 64) / 2; }
__device__ __forceinline__ int perm32(int rho) { const int n = rho >> 4, i = rho & 15; return 8 * (i >> 2) + 4 * n + (i & 3); }

struct Unit { int pm, pn; };
struct Gemm { const bf16_t* A; const bf16_t* Bt; int M, N, K; };

struct StaticOrder {
    int nM, nN, nwg, G, c;
    __device__ void init(int M, int N, int G_, int c_) { nM = M / BM; nN = N / BM; nwg = nM * nN; G = G_; c = c_; }
    __device__ bool next(int i, Unit& u) const {
        const long L = (long)i * G + c; if (L >= nwg) return false;
        int wgid = (int)L; { const int q = nwg / NXCD, r = nwg % NXCD, xcd = wgid % NXCD, off = wgid / NXCD; wgid = (xcd < r ? xcd * (q + 1) : r * (q + 1) + (xcd - r) * q) + off; }
        const int nig = WGM * nN, gid = wgid / nig, fm = gid * WGM, gsz = (nM - fm) < WGM ? (nM - fm) : WGM;
        u.pm = fm + ((wgid % nig) % gsz); u.pn = (wgid % nig) / gsz; return true;
    }
};

struct EpiScaleBf16 {
    static constexpr bool PERM = true;
    bf16_t* O; int ldc; const float* ss; int gelu_tiles;
    __device__ __forceinline__ void operator()(const f32x4 (&acc)[2][2][4][2], const Unit& u, int wr, int wc, int fr, int fq) const {
        const int row0 = u.pm * BM + wr * 64 + fr, col0 = u.pn * BM + wc * 32 + 8 * fq;
        const bool act = u.pn < gelu_tiles;
        float part[2][4];
#pragma unroll
        for (int ai = 0; ai < 2; ++ai)
#pragma unroll
            for (int m = 0; m < 4; ++m) part[ai][m] = row_sumsq_part(ss, row0 + ai * HALF + m * 16, fq);
#pragma unroll
        for (int ai = 0; ai < 2; ++ai)
#pragma unroll
            for (int m = 0; m < 4; ++m) {
                const int row = row0 + ai * HALF + m * 16; const float rs = rstd_from_part(part[ai][m]);
                bf16_t* rowp = O + (size_t)row * ldc + col0;
#pragma unroll
                for (int bj = 0; bj < 2; ++bj) {
                    f32x4 v0 = acc[ai][bj][m][0] * rs, v1 = acc[ai][bj][m][1] * rs;
                    if (act) {
#pragma unroll
                        for (int j = 0; j < 4; ++j) { v0[j] = gelu_tanh_f(v0[j]); v1[j] = gelu_tanh_f(v1[j]); }
                    }
                    u32x4 w; w.x = cvt_pk_bf16(v0[0], v0[1]); w.y = cvt_pk_bf16(v0[2], v0[3]); w.z = cvt_pk_bf16(v1[0], v1[1]); w.w = cvt_pk_bf16(v1[2], v1[3]);
                    *(u32x4*)(rowp + bj * HALF) = w;
                }
            }
    }
};
struct EpiSwiGLU {
    static constexpr bool PERM = true;
    bf16_t* O; const float* ss;
    __device__ __forceinline__ void operator()(const f32x4 (&acc)[2][2][4][2], const Unit& u, int wr, int wc, int fr, int fq) const {
        const int row0 = u.pm * BM + wr * 64 + fr, f0 = u.pn * HALF + wc * 32 + 8 * fq;
        float part[2][4];
#pragma unroll
        for (int ai = 0; ai < 2; ++ai)
#pragma unroll
            for (int m = 0; m < 4; ++m) part[ai][m] = row_sumsq_part(ss, row0 + ai * HALF + m * 16, fq);
#pragma unroll
        for (int ai = 0; ai < 2; ++ai)
#pragma unroll
            for (int m = 0; m < 4; ++m) {
                const int row = row0 + ai * HALF + m * 16; const float rs = rstd_from_part(part[ai][m]);
                const f32x4 g0 = acc[ai][0][m][0] * rs, g1 = acc[ai][0][m][1] * rs, u0 = acc[ai][1][m][0] * rs, u1 = acc[ai][1][m][1] * rs;
                f32x4 a0, a1;
#pragma unroll
                for (int j = 0; j < 4; ++j) { a0[j] = silu_f(g0[j]) * u0[j]; a1[j] = silu_f(g1[j]) * u1[j]; }
                u32x4 w; w.x = cvt_pk_bf16(a0[0], a0[1]); w.y = cvt_pk_bf16(a0[2], a0[3]); w.z = cvt_pk_bf16(a1[0], a1[1]); w.w = cvt_pk_bf16(a1[2], a1[3]);
                *(u32x4*)(O + (size_t)row * DFF + f0) = w;
            }
    }
};
struct EpiResid {
    static constexpr bool PERM = true;
    bf16_t* xb; float* ss;
    __device__ __forceinline__ void operator()(const f32x4 (&acc)[2][2][4][2], const Unit& u, int wr, int wc, int fr, int fq) const {
        const int row0 = u.pm * BM + wr * 64 + fr, col0 = u.pn * BM + wc * 32 + 8 * fq;
#pragma unroll
        for (int ai = 0; ai < 2; ++ai) {
            u32x4 rv[4][2];
#pragma unroll
            for (int m = 0; m < 4; ++m)
#pragma unroll
                for (int bj = 0; bj < 2; ++bj) rv[m][bj] = *(const u32x4*)(xb + (size_t)(row0 + ai * HALF + m * 16) * D + col0 + bj * HALF);
#pragma unroll
            for (int m = 0; m < 4; ++m) {
                const int row = row0 + ai * HALF + m * 16; float q = 0.f;
#pragma unroll
                for (int bj = 0; bj < 2; ++bj) {
                    float r[8]; unpack8(rv[m][bj], r);
                    const f32x4 a0 = acc[ai][bj][m][0], a1 = acc[ai][bj][m][1];
                    float h[8];
#pragma unroll
                    for (int j = 0; j < 4; ++j) { h[j] = r[j] + a0[j]; h[4 + j] = r[4 + j] + a1[j]; }
#pragma unroll
                    for (int j = 0; j < 8; ++j) q += h[j] * h[j];
                    *(u32x4*)(xb + (size_t)row * D + col0 + bj * HALF) = pack8(h);
                }
                q += __shfl_xor(q, 16); q += __shfl_xor(q, 32);
                if (fq == 0) ss[(size_t)row * 16 + u.pn * 4 + wc] = q;
            }
            asm volatile("" ::: "memory");
        }
    }
};

template <class Epi, bool ALIGN_EPI, bool SP2>
__device__ __forceinline__ void gemm_phase(LAS unsigned char* lds, const Gemm g, const StaticOrder& S, const Epi& E) {
    int tid_ = threadIdx.x; asm volatile("" : "+v"(tid_));
    const int tid = tid_, wid = __builtin_amdgcn_readfirstlane(tid >> 6), lane = tid & 63, wr = wid >> 2, wc = wid & 3, fr = lane & 15, fq = lane >> 4;
    const int K = g.K, nt = K / BK;
    unsigned voffA[2], voffB[2];
#pragma unroll
    for (int i = 0; i < 2; ++i) { int R, C; stage_rc(tid * 16 + i * 8192, R, C); const int Rb = Epi::PERM ? ((R & ~31) + perm32(R & 31)) : R;
        voffA[i] = (unsigned)(R * K + C) * 2u; voffB[i] = (unsigned)(Rb * K + C) * 2u; }
    const size_t kstep = (size_t)(BK * 2);
    const size_t hstep = (size_t)HALF * K * 2;
    const size_t tstep = 2 * hstep;
    const unsigned ldsw = (unsigned)wid * 1024u;
    const int aoff = lds_byte(wr * 64 + fr, fq * 8), boff = lds_byte(wc * 32 + fr, fq * 8);
#define PG8_SA(b, h) (((b) * 2 + (h)) * HTB)
#define PG8_SB(b, h) ((4 + (b) * 2 + (h)) * HTB)
#define PG8_STAGE(bufoff, gbase, voff) do { _Pragma("unroll") for (int _i = 0; _i < 2; ++_i) \
        __builtin_amdgcn_global_load_lds((const unsigned*)((const char*)(gbase) + (voff)[_i]), (LAS unsigned*)(lds + (bufoff) + ldsw + _i * 8192), 16, 0, 0); } while (0)
#define PG8_LDA(dst, b, h) do { _Pragma("unroll") for (int m = 0; m < 4; ++m) _Pragma("unroll") for (int k = 0; k < 2; ++k) dst[m][k] = *(const LAS bf16x8*)(lds + PG8_SA(b, h) + aoff + m * 2048 + k * 1024); } while (0)
#define PG8_LDB(dst, b, h) do { _Pragma("unroll") for (int n = 0; n < 2; ++n) _Pragma("unroll") for (int k = 0; k < 2; ++k) dst[n][k] = *(const LAS bf16x8*)(lds + PG8_SB(b, h) + boff + n * 2048 + k * 1024); } while (0)
#define PG8_MMA(ai, bj, At, Bt) do { __builtin_amdgcn_s_setprio(1); _Pragma("unroll") for (int m = 0; m < 4; ++m) _Pragma("unroll") for (int n = 0; n < 2; ++n) _Pragma("unroll") for (int k = 0; k < 2; ++k) \
        acc[ai][bj][m][n] = __builtin_amdgcn_mfma_f32_16x16x32_bf16(Bt[n][k], At[m][k], acc[ai][bj][m][n], 0, 0, 0); __builtin_amdgcn_s_setprio(0); } while (0)
#define PG8_WAIT_V(n) asm volatile("s_waitcnt vmcnt(" #n ")" ::: "memory")
#define PG8_WAIT_L(n) asm volatile("s_waitcnt lgkmcnt(" #n ")" ::: "memory")
#define PG8_BAR __builtin_amdgcn_s_barrier()
#define PG8_SCHED __builtin_amdgcn_sched_barrier(0)
    Unit cur, nxt; int ui = 0;
    if (!S.next(0, cur)) return;
    f32x4 acc[2][2][4][2];
#pragma unroll
    for (int a = 0; a < 2; ++a)
#pragma unroll
        for (int b = 0; b < 2; ++b)
#pragma unroll
            for (int m = 0; m < 4; ++m)
#pragma unroll
                for (int n = 0; n < 2; ++n) acc[a][b][m][n] = (f32x4){0.f, 0.f, 0.f, 0.f};
    bf16x8 At[4][2], B0[2][2], B1[2][2];
    const char* cA = (const char*)g.A + (size_t)cur.pm * tstep; const char* cB = (const char*)g.Bt + (size_t)cur.pn * tstep;
    if constexpr (SP2) {
        PG8_STAGE(PG8_SB(0, 0), cB, voffB); PG8_STAGE(PG8_SB(0, 1), cB + hstep, voffB); PG8_STAGE(PG8_SA(0, 0), cA, voffA); PG8_STAGE(PG8_SA(0, 1), cA + hstep, voffA);
        if (wr == 1) PG8_BAR;
        PG8_WAIT_V(2); PG8_BAR;
        PG8_STAGE(PG8_SB(1, 0), cB + kstep, voffB); PG8_STAGE(PG8_SA(1, 0), cA + kstep, voffA); PG8_STAGE(PG8_SB(1, 1), cB + hstep + kstep, voffB);
        PG8_WAIT_V(6); PG8_BAR;
    } else {
        PG8_STAGE(PG8_SB(0, 0), cB, voffB); PG8_STAGE(PG8_SA(0, 0), cA, voffA); PG8_STAGE(PG8_SB(0, 1), cB + hstep, voffB); PG8_STAGE(PG8_SA(0, 1), cA + hstep, voffA);
        if (wr == 1) PG8_BAR;
        PG8_WAIT_V(4); PG8_BAR;
        PG8_STAGE(PG8_SB(1, 0), cB + kstep, voffB); PG8_STAGE(PG8_SA(1, 0), cA + kstep, voffA); PG8_STAGE(PG8_SB(1, 1), cB + hstep + kstep, voffB);
        PG8_WAIT_V(6); PG8_BAR;
    }
    for (;;) {
        const bool has_next = S.next(ui + 1, nxt);
        const char* nA = has_next ? (const char*)g.A + (size_t)nxt.pm * tstep : cA; const char* nB = has_next ? (const char*)g.Bt + (size_t)nxt.pn * tstep : cB;
        for (int t = 0; t < nt; t += 2) {
            const bool last = (t == nt - 2);
            const char* a1 = cA + (size_t)(t + 1) * kstep;
            const char* a2 = last ? nA : cA + (size_t)(t + 2) * kstep; const char* b2 = last ? nB : cB + (size_t)(t + 2) * kstep;
            const char* a3 = a2 + kstep; const char* b3 = b2 + kstep;
            if constexpr (SP2) {
            PG8_LDB(B0, 0, 0); PG8_LDB(B1, 0, 1); PG8_SCHED; PG8_LDA(At, 0, 0); PG8_STAGE(PG8_SA(1, 1), a1 + hstep, voffA);
            PG8_WAIT_V(8); PG8_WAIT_L(0); PG8_BAR; PG8_MMA(0, 0, At, B0); PG8_MMA(0, 1, At, B1); PG8_BAR; PG8_SCHED;
            PG8_LDA(At, 0, 1); PG8_STAGE(PG8_SB(0, 0), b2, voffB); PG8_STAGE(PG8_SB(0, 1), b2 + hstep, voffB); PG8_STAGE(PG8_SA(0, 0), a2, voffA);
            PG8_WAIT_V(8); PG8_WAIT_L(0); PG8_BAR; PG8_MMA(1, 0, At, B0); PG8_MMA(1, 1, At, B1); PG8_BAR; PG8_SCHED;
            PG8_LDB(B0, 1, 0); PG8_LDB(B1, 1, 1); PG8_SCHED; PG8_LDA(At, 1, 0); PG8_STAGE(PG8_SA(0, 1), a2 + hstep, voffA);
            PG8_WAIT_V(8); PG8_WAIT_L(0); PG8_BAR; PG8_MMA(0, 0, At, B0); PG8_MMA(0, 1, At, B1); PG8_BAR; PG8_SCHED;
            PG8_LDA(At, 1, 1); PG8_STAGE(PG8_SB(1, 0), b3, voffB); PG8_STAGE(PG8_SB(1, 1), b3 + hstep, voffB); PG8_STAGE(PG8_SA(1, 0), a3, voffA);
            PG8_WAIT_V(8); PG8_WAIT_L(0); PG8_BAR; PG8_MMA(1, 0, At, B0); PG8_MMA(1, 1, At, B1); PG8_BAR; PG8_SCHED;
            } else {
            PG8_LDB(B0, 0, 0); PG8_SCHED; PG8_LDA(At, 0, 0); PG8_STAGE(PG8_SA(1, 1), a1 + hstep, voffA);
            PG8_WAIT_L(8); PG8_BAR; PG8_WAIT_L(0); PG8_MMA(0, 0, At, B0); PG8_BAR; PG8_SCHED;
            PG8_LDB(B1, 0, 1); PG8_STAGE(PG8_SB(0, 0), b2, voffB);
            PG8_BAR; PG8_WAIT_L(0); PG8_MMA(0, 1, At, B1); PG8_BAR;
            PG8_LDA(At, 0, 1); PG8_STAGE(PG8_SA(0, 0), a2, voffA);
            PG8_BAR; PG8_WAIT_L(0); PG8_MMA(1, 0, At, B0); PG8_BAR; PG8_SCHED;
            PG8_STAGE(PG8_SB(0, 1), b2 + hstep, voffB);
            PG8_WAIT_V(6); PG8_BAR; PG8_MMA(1, 1, At, B1); PG8_BAR;
            PG8_LDB(B0, 1, 0); PG8_SCHED; PG8_LDA(At, 1, 0); PG8_STAGE(PG8_SA(0, 1), a2 + hstep, voffA);
            PG8_WAIT_L(8); PG8_BAR; PG8_WAIT_L(0); PG8_MMA(0, 0, At, B0); PG8_BAR; PG8_SCHED;
            PG8_LDB(B1, 1, 1); PG8_STAGE(PG8_SB(1, 0), b3, voffB);
            PG8_BAR; PG8_WAIT_L(0); PG8_MMA(0, 1, At, B1); PG8_BAR;
            PG8_LDA(At, 1, 1); PG8_STAGE(PG8_SA(1, 0), a3, voffA);
            PG8_BAR; PG8_WAIT_L(0); PG8_MMA(1, 0, At, B0); PG8_BAR; PG8_SCHED;
            PG8_STAGE(PG8_SB(1, 1), b3 + hstep, voffB);
            PG8_WAIT_V(6); PG8_BAR; PG8_MMA(1, 1, At, B1); PG8_BAR;
            }
        }
        if constexpr (ALIGN_EPI) { if (wr == 0) PG8_BAR; }
        E(acc, cur, wr, wc, fr, fq);
        if (!has_next) break;
#pragma unroll
        for (int a = 0; a < 2; ++a)
#pragma unroll
            for (int b = 0; b < 2; ++b)
#pragma unroll
                for (int m = 0; m < 4; ++m)
#pragma unroll
                    for (int n = 0; n < 2; ++n) acc[a][b][m][n] = (f32x4){0.f, 0.f, 0.f, 0.f};
        cur = nxt; cA = nA; cB = nB; ++ui;
        if constexpr (ALIGN_EPI) { if (wr == 1) PG8_BAR; }
    }
    PG8_WAIT_V(0);
    if constexpr (!ALIGN_EPI) { if (wr == 0) PG8_BAR; }
    PG8_BAR;
#undef PG8_SA
#undef PG8_SB
#undef PG8_STAGE
#undef PG8_LDA
#undef PG8_LDB
#undef PG8_MMA
#undef PG8_WAIT_V
#undef PG8_WAIT_L
#undef PG8_BAR
#undef PG8_SCHED
}
}

struct Args {
    const float* x; const float* even_w_in; const float* even_w_out; const float* a_w_s; const float* a_b_s; const float* a_ln_g; const float* a_ln_b;
    const float* b_w_pool; const float* b_scale; const float* odd_w_in; const float* odd_w_out; const float* c_w_dw; const float* c_b_dw; const float* c_ln_g; const float* c_ln_b;
    const float* d_w_dw; const float* norm_mix_g; const float* norm_ffn_g; const float* ffn_w_gate; const float* ffn_w_up; const float* ffn_w_down; const float* final_norm_g;
    float* out; unsigned char* ws; int ph_lo, ph_hi;
};

constexpr int P0_SCR_BYTES = 64 * 65 * 4;
__device__ __forceinline__ void p0_transpose_item(const float* W, int K, int N, bf16_t* WT, int grp, int gstride, int goff, const float* gk, LAS float* scr, int item, int lane) {
    const int nblk = N / 64, kb = item / nblk, nb = item % nblk, k0 = 64 * kb, n0 = 64 * nb;
    const int lr = lane >> 4, lc = 4 * (lane & 15);
    f32x4 v[16];
#pragma unroll
    for (int i = 0; i < 16; ++i) v[i] = *(const f32x4*)(W + (size_t)(k0 + 4 * i + lr) * N + n0 + lc);
#pragma unroll
    for (int i = 0; i < 16; ++i) { LAS float* p = scr + (4 * i + lr) * 65 + lc; p[0] = v[i].x; p[1] = v[i].y; p[2] = v[i].z; p[3] = v[i].w; }
    asm volatile("s_waitcnt lgkmcnt(0)" ::: "memory");
    const int c = lane & 7;
    float gv[8];
    if (gk) { const f32x4 g0 = *(const f32x4*)(gk + k0 + 8 * c), g1 = *(const f32x4*)(gk + k0 + 8 * c + 4);
#pragma unroll
        for (int j = 0; j < 4; ++j) { gv[j] = g0[j]; gv[4 + j] = g1[j]; } }
    else {
#pragma unroll
        for (int j = 0; j < 8; ++j) gv[j] = 1.0f; }
    const int drow0 = (n0 / grp) * gstride + goff + (n0 % grp);
#pragma unroll
    for (int j = 0; j < 8; ++j) { const int n = (lane >> 3) + 8 * j; const LAS float* s = scr + (8 * c) * 65 + n;
        float o[8];
#pragma unroll
        for (int e = 0; e < 8; ++e) o[e] = s[e * 65] * gv[e];
        *(u32x4*)(WT + (size_t)(drow0 + n) * K + k0 + 8 * c) = pack8(o); }
    asm volatile("s_waitcnt lgkmcnt(0)" ::: "memory");
}

__device__ __forceinline__ void p0_prologue(const Args& A, LAS unsigned char* lds, int vcu, int G) {
    int tid_ = threadIdx.x; asm volatile("" : "+v"(tid_));
    const int tid = tid_, lane = tid & 63, wave = __builtin_amdgcn_readfirstlane(tid >> 6);
    LAS float* scr = (LAS float*)(lds + wave * P0_SCR_BYTES);
    const int gw = vcu * NWAVES + wave, NGW = G * NWAVES;
    unsigned char* ws = A.ws;
    constexpr int I_IN0 = 16 * (EVEN_IN / 64), I_OUT = 16 * (D / 64), I_FF = 16 * (DFF / 64), I_DN = (DFF / 64) * (D / 64), I_IN1 = 16 * (ODD_IN / 64), I_WP = 2 * 2;
    constexpr int PER_LAYER_FFN = 2 * I_FF + I_DN;
    constexpr int NITEMS = I_IN0 + I_OUT + I_IN1 + I_OUT + 2 * PER_LAYER_FFN + 4 * I_WP;
    for (int it = gw; it < NITEMS; it += NGW) {
        int r = it;
        if (r < I_IN0) { p0_transpose_item(A.even_w_in, D, EVEN_IN, (bf16_t*)(ws + WS_WIN0), EVEN_IN, 0, 0, A.norm_mix_g, scr, r, lane); continue; } r -= I_IN0;
        if (r < I_OUT) { p0_transpose_item(A.even_w_out, D, D, (bf16_t*)(ws + WS_WOUT0), D, 0, 0, nullptr, scr, r, lane); continue; } r -= I_OUT;
        if (r < I_IN1) { p0_transpose_item(A.odd_w_in, D, ODD_IN, (bf16_t*)(ws + WS_WIN1), ODD_IN, 0, 0, A.norm_mix_g + D, scr, r, lane); continue; } r -= I_IN1;
        if (r < I_OUT) { p0_transpose_item(A.odd_w_out, D, D, (bf16_t*)(ws + WS_WOUT1), D, 0, 0, nullptr, scr, r, lane); continue; } r -= I_OUT;
        if (r < 2 * PER_LAYER_FFN) {
            const int layer = r / PER_LAYER_FFN; r -= layer * PER_LAYER_FFN;
            bf16_t* wgu = (bf16_t*)(ws + (layer ? WS_WGU1 : WS_WGU0)); bf16_t* wdn = (bf16_t*)(ws + (layer ? WS_WDN1 : WS_WDN0));
            const float* gk = A.norm_ffn_g + layer * D;
            if (r < I_FF) { p0_transpose_item(A.ffn_w_gate + (size_t)layer * D * DFF, D, DFF, wgu, 128, 256, 0, gk, scr, r, lane); continue; } r -= I_FF;
            if (r < I_FF) { p0_transpose_item(A.ffn_w_up + (size_t)layer * D * DFF, D, DFF, wgu, 128, 256, 128, gk, scr, r, lane); continue; } r -= I_FF;
            p0_transpose_item(A.ffn_w_down + (size_t)layer * DFF * D, DFF, D, wdn, D, 0, 0, nullptr, scr, r, lane); continue;
        }
        r -= 2 * PER_LAYER_FFN;
        { const int g = r / I_WP; r -= g * I_WP;
          p0_transpose_item(A.b_w_pool + (size_t)g * 128 * 128, 128, 128, (bf16_t*)(ws + WS_WP) + (size_t)g * 128 * 128, 128, 0, 0, nullptr, scr, r, lane); }
    }
    { bf16_t* wm = (bf16_t*)(ws + WS_WS);
      for (int e = (vcu * NTHREADS + tid) * 2; e < 4 * 128 * 128; e += G * NTHREADS * 2) {
          const int i = (e >> 7) & 127, j = e & 127; const bool keep = (i >> 6) >= (j >> 6);
          const float a = keep ? A.a_w_s[e] : 0.f, b = keep ? A.a_w_s[e + 1] : 0.f;
          *(unsigned*)(wm + e) = cvt_pk_bf16(a, b); } }
    { bf16_t* xb = (bf16_t*)(ws + WS_XB); float* ss = (float*)(ws + WS_SS);
      for (int m0 = gw * 4; m0 < M_TOK; m0 += NGW * 4) {
          f32x4 v[4][4];
#pragma unroll
          for (int r = 0; r < 4; ++r)
#pragma unroll
              for (int j = 0; j < 4; ++j) v[r][j] = *((const f32x4*)(A.x + (size_t)(m0 + r) * D) + lane + 64 * j);
#pragma unroll
          for (int r = 0; r < 4; ++r) {
              float s = 0.f;
#pragma unroll
              for (int j = 0; j < 4; ++j) s += (v[r][j].x * v[r][j].x + v[r][j].y * v[r][j].y) + (v[r][j].z * v[r][j].z + v[r][j].w * v[r][j].w);
              s = wave_sum(s);
              u32x2* o8 = (u32x2*)(xb + (size_t)(m0 + r) * D) + lane;
#pragma unroll
              for (int j = 0; j < 4; ++j) { u32x2 w; w.x = cvt_pk_bf16(v[r][j].x, v[r][j].y); w.y = cvt_pk_bf16(v[r][j].z, v[r][j].w); o8[64 * j] = w; }
              if (lane < 4) { f32x4 t = (f32x4){0.f, 0.f, 0.f, 0.f}; if (lane == 0) t.x = s; *((f32x4*)(ss + (size_t)(m0 + r) * 16) + lane) = t; }
          }
      } }
}

constexpr int VN_STRIDE = 1056;
constexpr int PL_STRIDE = 1040;
__device__ __forceinline__ float seg16_sum(float v) { v += __shfl_xor(v, 1); v += __shfl_xor(v, 2); v += __shfl_xor(v, 4); v += __shfl_xor(v, 8); return v; }

template <int NCH> struct PoolVec;
template <> struct PoolVec<8> { typedef u32x4 T; static __device__ __forceinline__ T zero() { return (u32x4){0u, 0u, 0u, 0u}; }
    static __device__ __forceinline__ void unpack(const T r, float (&v)[8]) { unpack8(r, v); }
    static __device__ __forceinline__ T pack(const float (&v)[8]) { return pack8(v); } };
template <> struct PoolVec<4> { typedef u32x2 T; static __device__ __forceinline__ T zero() { return (u32x2){0u, 0u}; }
    static __device__ __forceinline__ void unpack(const T r, float (&v)[4]) { v[0] = bf_lo(r.x); v[1] = bf_hi(r.x); v[2] = bf_lo(r.y); v[3] = bf_hi(r.y); }
    static __device__ __forceinline__ T pack(const float (&v)[4]) { T o; o.x = cvt_pk_bf16(v[0], v[1]); o.y = cvt_pk_bf16(v[2], v[3]); return o; } };
template <int WIN, int NCH> __device__ __forceinline__ void pool_segment(const bf16_t* zp  , int posb, LAS unsigned char* dst  ) {
    typedef PoolVec<NCH> PV; typedef typename PV::T VT;
    constexpr int NR = 16 + WIN - 1;
    VT raw[NR];
#pragma unroll
    for (int i = 0; i < NR; ++i) { const int rel = i - (WIN - 1); raw[i] = (posb + rel >= 0) ? *(const VT*)(zp + (long)rel * EVEN_IN) : PV::zero(); }
    float s[NCH];
#pragma unroll
    for (int j = 0; j < NCH; ++j) s[j] = 0.f;
#pragma unroll
    for (int i = 0; i < WIN - 1; ++i) { float x[NCH]; PV::unpack(raw[i], x);
#pragma unroll
        for (int j = 0; j < NCH; ++j) s[j] += x[j]; }
#pragma unroll
    for (int i = 0; i < 16; ++i) {
        float x[NCH]; PV::unpack(raw[i + WIN - 1], x);
        const int pos = posb + i; const int cnt = (pos + 1 < WIN) ? pos + 1 : WIN; const float inv = 1.0f / (float)cnt;
        float o[NCH];
#pragma unroll
        for (int j = 0; j < NCH; ++j) { s[j] += x[j]; o[j] = s[j] * inv - x[j]; }
        *(LAS VT*)(dst + i * PL_STRIDE) = PV::pack(o);
        float y[NCH]; PV::unpack(raw[i], y);
#pragma unroll
        for (int j = 0; j < NCH; ++j) s[j] -= y[j];
    }
}

__device__ __forceinline__ void mixer_even(const Args& A, LAS unsigned char* lds, int vcu, int G) {
    int tid_ = threadIdx.x; asm volatile("" : "+v"(tid_));
    const int tid = tid_, lane = tid & 63, w = __builtin_amdgcn_readfirstlane(tid >> 6), fr = lane & 15, fq = lane >> 4;
    const bf16_t* Z = (const bf16_t*)(A.ws + WS_Z); bf16_t* Y = (bf16_t*)(A.ws + WS_Y);
    const bf16_t* Wm = (const bf16_t*)(A.ws + WS_WS); const bf16_t* WpT = (const bf16_t*)(A.ws + WS_WP);
    const int hg = w >> 1, dh = w & 1;
    for (int blk = vcu; blk < M_TOK / 128; blk += G) {
        const int row_base = blk * 128; const int pos_base = row_base & (SEQ - 1);
        {
            const int c = hg * 128 + 8 * fr, sg = dh * 4 + fq, ts = 16 * sg;
            const bf16_t* zp = Z + (size_t)(row_base + ts) * EVEN_IN + 1024 + c;
            LAS unsigned char* dst = lds + ts * PL_STRIDE + c * 2;
            if (hg == 0) pool_segment<2, 8>(zp, pos_base + ts, dst);
            else if (hg == 1) pool_segment<4, 8>(zp, pos_base + ts, dst);
            else if (hg == 2) pool_segment<8, 8>(zp, pos_base + ts, dst);
            else { pool_segment<16, 4>(zp, pos_base + ts, dst); pool_segment<16, 4>(zp + 4, pos_base + ts, dst + 8); }
        }
        bf16x8 wpf[4][4];
        { const bf16_t* WpT_ = WpT; OPAQUE_S(WpT_);
#pragma unroll
        for (int n = 0; n < 4; ++n)
#pragma unroll
            for (int ks = 0; ks < 4; ++ks) wpf[n][ks] = *(const bf16x8*)(WpT_ + ((size_t)(hg * 128 + dh * 64 + n * 16 + fr) * 128 + ks * 32 + 8 * fq)); }
        __syncthreads();
        {
            f32x4 sc[4]; const float* bsc = A.b_scale; OPAQUE_S(bsc);
#pragma unroll
            for (int n = 0; n < 4; ++n) sc[n] = *(const f32x4*)(bsc + hg * 128 + dh * 64 + n * 16 + 4 * fq);
#pragma unroll 2
            for (int m = 0; m < 8; ++m) {
                f32x4 acc[4];
#pragma unroll
                for (int n = 0; n < 4; ++n) acc[n] = (f32x4){0.f, 0.f, 0.f, 0.f};
#pragma unroll
                for (int ks = 0; ks < 4; ++ks) {
                    const bf16x8 pf = *(const LAS bf16x8*)(lds + (m * 16 + fr) * PL_STRIDE + (hg * 128 + ks * 32 + 8 * fq) * 2);
#pragma unroll
                    for (int n = 0; n < 4; ++n) acc[n] = __builtin_amdgcn_mfma_f32_16x16x32_bf16(wpf[n][ks], pf, acc[n], 0, 0, 0);
                }
                const size_t row = (size_t)(row_base + m * 16 + fr);
#pragma unroll
                for (int n = 0; n < 4; ++n) {
                    u32x2 o; o.x = cvt_pk_bf16(acc[n].x * sc[n].x, acc[n].y * sc[n].y); o.y = cvt_pk_bf16(acc[n].z * sc[n].z, acc[n].w * sc[n].w);
                    *(u32x2*)(Y + row * D + 512 + hg * 128 + dh * 64 + n * 16 + 4 * fq) = o;
                }
            }
        }
        __syncthreads();
        {
            u32x4 raw[4][4];
#pragma unroll
            for (int r = 0; r < 4; ++r)
#pragma unroll
                for (int j = 0; j < 4; ++j) raw[r][j] = *(const u32x4*)(Z + (size_t)(row_base + 16 * w + 4 * r + fq) * EVEN_IN + 512 + 128 * j + 8 * fr);
            float mu[4], rstd[4];
#pragma unroll
            for (int r = 0; r < 4; ++r) {
                float s = 0.f, q = 0.f;
#pragma unroll
                for (int j = 0; j < 4; ++j) { float v[8]; unpack8(raw[r][j], v);
#pragma unroll
                    for (int e = 0; e < 8; ++e) { s += v[e]; q += v[e] * v[e]; } }
                s = seg16_sum(s); q = seg16_sum(q);
                mu[r] = s * (1.0f / 512.0f); const float var = fmaxf(q * (1.0f / 512.0f) - mu[r] * mu[r], 0.f); rstd[r] = rsqrtf(var + EPS);
            }
            const float* lgp = A.a_ln_g; const float* lbp = A.a_ln_b; OPAQUE_S(lgp); OPAQUE_S(lbp);
#pragma unroll
            for (int j = 0; j < 4; ++j) {
                const f32x4 g0 = *(const f32x4*)(lgp + 128 * j + 8 * fr), g1 = *(const f32x4*)(lgp + 128 * j + 8 * fr + 4), b0 = *(const f32x4*)(lbp + 128 * j + 8 * fr), b1 = *(const f32x4*)(lbp + 128 * j + 8 * fr + 4);
#pragma unroll
                for (int r = 0; r < 4; ++r) {
                    float v[8], o[8]; unpack8(raw[r][j], v);
#pragma unroll
                    for (int e = 0; e < 4; ++e) { o[e] = (v[e] - mu[r]) * rstd[r] * g0[e] + b0[e]; o[4 + e] = (v[4 + e] - mu[r]) * rstd[r] * g1[e] + b1[e]; }
                    *(LAS u32x4*)(lds + (16 * w + 4 * r + fq) * VN_STRIDE + (128 * j + 8 * fr) * 2) = pack8(o);
                }
            }
        }
        __syncthreads();
        {
            const int h = hg;
            const int q4 = (lane >> 2) & 3, p4 = lane & 3;
            const LAS unsigned char* vbase = lds + (4 * fq + q4) * VN_STRIDE + (h * 128 + dh * 64 + 4 * p4) * 2;
#pragma unroll
            for (int mh = 0; mh < 2; ++mh) {
                u32x2 wlo[4][4], whi[4][4]; const bf16_t* Wm_ = Wm; OPAQUE_S(Wm_);
#pragma unroll
                for (int m = 0; m < 4; ++m)
#pragma unroll
                    for (int ks = 0; ks < 4; ++ks) {
                        if (mh == 0 && ks >= 2) continue;
                        const bf16_t* wp = Wm_ + ((size_t)(h * 128 + (4 * mh + m) * 16 + fr) * 128 + ks * 32 + 4 * fq);
                        wlo[m][ks] = *(const u32x2*)wp; whi[m][ks] = *(const u32x2*)(wp + 16);
                    }
                u32x2 ur[4][4]; const float* abs_ = A.a_b_s; OPAQUE_S(abs_);
#pragma unroll
                for (int m = 0; m < 4; ++m)
#pragma unroll
                    for (int n = 0; n < 4; ++n) ur[m][n] = *(const u32x2*)(Z + (size_t)(row_base + (4 * mh + m) * 16 + fr) * EVEN_IN + h * 128 + dh * 64 + n * 16 + 4 * fq);
                f32x4 acc[4][4];
#pragma unroll
                for (int m = 0; m < 4; ++m)
#pragma unroll
                    for (int n = 0; n < 4; ++n) acc[m][n] = (f32x4){0.f, 0.f, 0.f, 0.f};
#pragma unroll
                for (int ks = 0; ks < 4; ++ks) {
                    if (mh == 0 && ks >= 2) continue;
                    bf16x8 vf[4];
#pragma unroll
                    for (int n = 0; n < 4; ++n) {
                        const s16x4 lo = __builtin_amdgcn_ds_read_tr16_b64_v4i16((LAS s16x4*)(vbase + (ks * 32) * VN_STRIDE + n * 32));
                        const s16x4 hi = __builtin_amdgcn_ds_read_tr16_b64_v4i16((LAS s16x4*)(vbase + (ks * 32 + 16) * VN_STRIDE + n * 32));
                        vf[n] = (bf16x8){lo.x, lo.y, lo.z, lo.w, hi.x, hi.y, hi.z, hi.w};
                    }
#pragma unroll
                    for (int m = 0; m < 4; ++m) {
                        union { u32x4 u; bf16x8 b; } wf; wf.u = (u32x4){wlo[m][ks].x, wlo[m][ks].y, whi[m][ks].x, whi[m][ks].y};
#pragma unroll
                        for (int n = 0; n < 4; ++n) acc[m][n] = __builtin_amdgcn_mfma_f32_16x16x32_bf16(vf[n], wf.b, acc[m][n], 0, 0, 0);
                    }
                }
#pragma unroll
                for (int m = 0; m < 4; ++m) {
                    const int i = (4 * mh + m) * 16 + fr; const float bs = abs_[h * 128 + i]; const size_t row = (size_t)(row_base + i);
#pragma unroll
                    for (int n = 0; n < 4; ++n) {
                        const int d = h * 128 + dh * 64 + n * 16 + 4 * fq;
                        const f32x4 sv = acc[m][n];
                        u32x2 o; o.x = cvt_pk_bf16(bf_lo(ur[m][n].x) * (sv.x + bs), bf_hi(ur[m][n].x) * (sv.y + bs)); o.y = cvt_pk_bf16(bf_lo(ur[m][n].y) * (sv.z + bs), bf_hi(ur[m][n].y) * (sv.w + bs));
                        *(u32x2*)(Y + row * D + d) = o;
                    }
                }
            }
        }
        __syncthreads();
    }
}

template <int S, int T> __device__ __forceinline__ void conv_t(f32x2 (&acc)[32], const f32x2 (&wt)[31], const f32x2 hv) {
    if constexpr (T < 32) { if constexpr (S - T >= 0 && S - T <= 30) acc[T] = acc[T] + wt[S - T] * hv; conv_t<S, T + 1>(acc, wt, hv); }
}
template <int S> __device__ __forceinline__ void conv_s(f32x2 (&acc)[32], const f32x2 (&wt)[31], const LAS unsigned char* hp) {
    if constexpr (S < 62) {
        const unsigned hr = *(const LAS unsigned*)(hp + S * 1024);
        conv_t<S, 0>(acc, wt, (f32x2){bf_lo(hr), bf_hi(hr)});
        conv_s<S + 1>(acc, wt, hp);
    }
}
__device__ __forceinline__ void mixer_odd(const Args& A, LAS unsigned char* lds, int vcu, int G) {
    int tid_ = threadIdx.x; asm volatile("" : "+v"(tid_));
    const int tid = tid_, lane = tid & 63, w = __builtin_amdgcn_readfirstlane(tid >> 6), fr = lane & 15, fq = lane >> 4;
    const bf16_t* Z = (const bf16_t*)(A.ws + WS_Z); bf16_t* Y = (bf16_t*)(A.ws + WS_Y);
    constexpr int TT = 64, HALO = 30, HROWS = TT + HALO;
    for (int tile = vcu; tile < M_TOK / TT; tile += G) {
        const int t0 = tile * TT; const int pos0 = t0 & (SEQ - 1);
#pragma unroll 1
        for (int b = 0; b < 3; ++b) {
            u32x4 ra[4], rg[4];
#pragma unroll
            for (int k = 0; k < 4; ++k) {
                const int task = tid + (4 * b + k) * NTHREADS; const int r = task >> 6, c8 = task & 63; const int pos = pos0 + r - HALO;
                ra[k] = (u32x4){0u, 0u, 0u, 0u}; rg[k] = (u32x4){0u, 0u, 0u, 0u};
                if (r < HROWS && pos >= 0) { const bf16_t* zp = Z + (size_t)(t0 + r - HALO) * ODD_IN + 8 * c8; ra[k] = *(const u32x4*)zp; rg[k] = *(const u32x4*)(zp + 512); }
            }
#pragma unroll
            for (int k = 0; k < 4; ++k) {
                const int task = tid + (4 * b + k) * NTHREADS; const int r = task >> 6, c8 = task & 63;
                float a[8], g[8]; unpack8(ra[k], a); unpack8(rg[k], g);
#pragma unroll
                for (int j = 0; j < 8; ++j) a[j] = a[j] * sigmoid_f(g[j]);
                if (r < HROWS) *(LAS u32x4*)(lds + r * 1024 + c8 * 16) = pack8(a);
            }
        }
        __syncthreads();
        const int cp = tid & 255, th = tid >> 8;
        f32x2 acc[32];
        {
            f32x2 wt[31];
            const float* cw = A.c_w_dw; OPAQUE_S(cw); const float* cb = A.c_b_dw; OPAQUE_S(cb);
            const float* wbase = cw + 2 * cp;
#pragma unroll
            for (int j = 0; j < 31; ++j) wt[j] = *(const f32x2*)(wbase + j * 512);
            const f32x2 bias = *(const f32x2*)(cb + 2 * cp);
#pragma unroll
            for (int t = 0; t < 32; ++t) acc[t] = bias;
            const LAS unsigned char* hp = lds + (32 * th) * 1024 + 4 * cp;
            conv_s<0>(acc, wt, hp);
        }
        __syncthreads();
#pragma unroll
        for (int t = 0; t < 32; ++t) *(LAS unsigned*)(lds + (32 * th + t) * 1024 + 4 * cp) = cvt_pk_bf16(acc[t].x, acc[t].y);
        {
            const int c8 = tid & 63, tg = tid >> 6;
            float w0[8], w1[8], w2[8];
            { const float* dw = A.d_w_dw; OPAQUE_S(dw); const float* wp = dw + 8 * c8;
              const f32x4 a0 = *(const f32x4*)wp, a1 = *(const f32x4*)(wp + 4), b0 = *(const f32x4*)(wp + 512), b1 = *(const f32x4*)(wp + 516), c0 = *(const f32x4*)(wp + 1024), c1 = *(const f32x4*)(wp + 1028);
#pragma unroll
              for (int j = 0; j < 4; ++j) { w0[j] = a0[j]; w0[4 + j] = a1[j]; w1[j] = b0[j]; w1[4 + j] = b1[j]; w2[j] = c0[j]; w2[4 + j] = c1[j]; } }
#pragma unroll 1
            for (int rd = 0; rd < 2; ++rd) {
                const int tk0 = 8 * tg + 4 * rd;
                const bf16_t* zp = Z + (size_t)(t0 + tk0) * ODD_IN + 1024 + 8 * c8;
                u32x4 rc[6], rx[6], rb[4];
#pragma unroll
                for (int i = 0; i < 6; ++i) { const int rel = i - 2; rc[i] = (u32x4){0u, 0u, 0u, 0u}; rx[i] = (u32x4){0u, 0u, 0u, 0u};
                    if (pos0 + tk0 + rel >= 0) { rc[i] = *(const u32x4*)(zp + (long)rel * ODD_IN + 512); rx[i] = *(const u32x4*)(zp + (long)rel * ODD_IN + 1024); } }
#pragma unroll
                for (int i = 0; i < 4; ++i) rb[i] = *(const u32x4*)(zp + (long)i * ODD_IN);
                float p[6][8];
#pragma unroll
                for (int i = 0; i < 6; ++i) { float c[8], x[8]; unpack8(rc[i], c); unpack8(rx[i], x);
#pragma unroll
                    for (int j = 0; j < 8; ++j) p[i][j] = c[j] * x[j]; }
#pragma unroll
                for (int i = 0; i < 4; ++i) {
                    float bg[8], o[8]; unpack8(rb[i], bg);
#pragma unroll
                    for (int j = 0; j < 8; ++j) o[j] = bg[j] * (w0[j] * p[i][j] + w1[j] * p[i + 1][j] + w2[j] * p[i + 2][j]);
                    *(u32x4*)(Y + (size_t)(t0 + tk0 + i) * D + 512 + 8 * c8) = pack8(o);
                }
            }
        }
        __syncthreads();
        {
            f32x4 lg[4][2], lb[4][2]; const float* lgp = A.c_ln_g; const float* lbp = A.c_ln_b; OPAQUE_S(lgp); OPAQUE_S(lbp);
#pragma unroll
            for (int j = 0; j < 4; ++j) { lg[j][0] = *(const f32x4*)(lgp + 128 * j + 8 * fr); lg[j][1] = *(const f32x4*)(lgp + 128 * j + 8 * fr + 4);
                                          lb[j][0] = *(const f32x4*)(lbp + 128 * j + 8 * fr); lb[j][1] = *(const f32x4*)(lbp + 128 * j + 8 * fr + 4); }
#pragma unroll
            for (int r = 0; r < 2; ++r) {
                const int tok = 8 * w + 4 * r + fq;
                float v[4][8]; float s = 0.f, q = 0.f;
#pragma unroll
                for (int j = 0; j < 4; ++j) { unpack8(*(const LAS u32x4*)(lds + tok * 1024 + (128 * j + 8 * fr) * 2), v[j]);
#pragma unroll
                    for (int e = 0; e < 8; ++e) { s += v[j][e]; q += v[j][e] * v[j][e]; } }
                s = seg16_sum(s); q = seg16_sum(q);
                const float mu = s * (1.0f / 512.0f); const float var = fmaxf(q * (1.0f / 512.0f) - mu * mu, 0.f); const float rstd = rsqrtf(var + EPS);
#pragma unroll
                for (int j = 0; j < 4; ++j) {
                    float o[8];
#pragma unroll
                    for (int e = 0; e < 4; ++e) { o[e] = silu_f((v[j][e] - mu) * rstd * lg[j][0][e] + lb[j][0][e]); o[4 + e] = silu_f((v[j][4 + e] - mu) * rstd * lg[j][1][e] + lb[j][1][e]); }
                    *(u32x4*)(Y + (size_t)(t0 + tok) * D + 128 * j + 8 * fr) = pack8(o);
                }
            }
        }
        __syncthreads();
    }
}

__device__ __forceinline__ void final_norm(const Args& A, int vcu, int G) {
    int tid_ = threadIdx.x; asm volatile("" : "+v"(tid_));
    const int tid = tid_, lane = tid & 63, wave = __builtin_amdgcn_readfirstlane(tid >> 6);
    const int gw = vcu * NWAVES + wave, NGW = G * NWAVES;
    const float* ss = (const float*)(A.ws + WS_SS); const bf16_t* xb = (const bf16_t*)(A.ws + WS_XB);
    f32x4 gg[4];
#pragma unroll
    for (int j = 0; j < 4; ++j) gg[j] = *((const f32x4*)A.final_norm_g + 2 * lane + 128 * (j >> 1) + (j & 1));
    for (int m0 = gw * 4; m0 < M_TOK; m0 += NGW * 4) {
        float part[4]; u32x4 raw[4][2];
#pragma unroll
        for (int r = 0; r < 4; ++r) { part[r] = ss[(size_t)(m0 + r) * 16 + (lane & 15)];
            raw[r][0] = *((const u32x4*)(xb + (size_t)(m0 + r) * D) + lane); raw[r][1] = *((const u32x4*)(xb + (size_t)(m0 + r) * D) + lane + 64); }
#pragma unroll
        for (int r = 0; r < 4; ++r) {
            const float rs = rsqrtf(seg16_sum(part[r]) * (1.0f / 1024.0f) + EPS);
            f32x4* orow = (f32x4*)(A.out + (size_t)(m0 + r) * D);
#pragma unroll
            for (int hh = 0; hh < 2; ++hh) {
                float v[8]; unpack8(raw[r][hh], v);
                orow[128 * hh + 2 * lane] = (f32x4){v[0], v[1], v[2], v[3]} * rs * gg[2 * hh];
                orow[128 * hh + 2 * lane + 1] = (f32x4){v[4], v[5], v[6], v[7]} * rs * gg[2 * hh + 1];
            }
        }
    }
}

#ifndef PG8_SP2
#define PG8_SP2 true
#endif
#ifndef PG8_ALIGN
#define PG8_ALIGN true
#endif
__global__ void __launch_bounds__(NTHREADS, 2) trunk_fwd(Args args) {
    extern __shared__ __attribute__((aligned(16))) unsigned char lds_raw[];
    LAS unsigned char* lds = (LAS unsigned char*)lds_raw;
    const int G = gridDim.x, bx = blockIdx.x;
    const int vcu = (G % 8 == 0) ? (bx % 8) * (G / 8) + bx / 8 : bx;
    const int lo = args.ph_lo, hi = args.ph_hi;
    unsigned char* ws = args.ws;
    bf16_t* XB = (bf16_t*)(ws + WS_XB); bf16_t* Yb = (bf16_t*)(ws + WS_Y); bf16_t* Zb = (bf16_t*)(ws + WS_Z); float* SS = (float*)(ws + WS_SS);
#ifndef KIND_MASK
#define KIND_MASK 0xff
#endif
#define KIND(b) (((KIND_MASK) >> (b)) & 1)
#define IN(k) (lo <= (k) && (k) < hi)
#if USE_CG_SYNC
#define SEAM(k) do { if (IN(k) && IN((k) + 1)) { cg::this_grid().sync(); } } while (0)
#else
    if (threadIdx.x < 2) ((volatile LAS unsigned*)(lds + LDS_MISC_OFF))[threadIdx.x] = 0u;
    __syncthreads();
    XcdBarrier bar = xcd_barrier_post((unsigned*)(ws + WS_CTL) + CW_BAR, (volatile LAS unsigned*)(lds + LDS_MISC_OFF));
    if (args.ph_lo < 0) cg::this_grid().sync();
#define SEAM(k) do { if (IN(k) && IN((k) + 1)) { xcd_barrier(bar); } } while (0)
#endif

    if (KIND(0) && IN(0)) { p0_prologue(args, lds, vcu, G); }
    SEAM(0);
#pragma unroll 1
    for (int layer = 0; layer < 2; ++layer) {
        const int pb = 1 + 5 * layer;
        if (KIND(1) && IN(pb + 0)) {
            const int N = layer ? ODD_IN : EVEN_IN;
            pg8::Gemm g{XB, (const bf16_t*)(ws + (layer ? WS_WIN1 : WS_WIN0)), M_TOK, N, D}; pg8::StaticOrder S; S.init(M_TOK, N, G, bx);
            pg8::EpiScaleBf16 E{Zb, N, SS, layer ? 0 : 4};
            pg8::gemm_phase<pg8::EpiScaleBf16, PG8_ALIGN, PG8_SP2>(lds, g, S, E);
        }
        SEAM(pb + 0);
        if (IN(pb + 1)) { if (layer == 0) { if (KIND(2)) mixer_even(args, lds, vcu, G); } else { if (KIND(3)) mixer_odd(args, lds, vcu, G); } }
        SEAM(pb + 1);
        if (KIND(4) && IN(pb + 2)) {
            pg8::Gemm g{Yb, (const bf16_t*)(ws + (layer ? WS_WOUT1 : WS_WOUT0)), M_TOK, D, D}; pg8::StaticOrder S; S.init(M_TOK, D, G, bx);
            pg8::EpiResid E{XB, SS};
            pg8::gemm_phase<pg8::EpiResid, PG8_ALIGN, PG8_SP2>(lds, g, S, E);
        }
        SEAM(pb + 2);
        if (KIND(5) && IN(pb + 3)) {
            pg8::Gemm g{XB, (const bf16_t*)(ws + (layer ? WS_WGU1 : WS_WGU0)), M_TOK, GU, D}; pg8::StaticOrder S; S.init(M_TOK, GU, G, bx);
            pg8::EpiSwiGLU E{Zb, SS};
            pg8::gemm_phase<pg8::EpiSwiGLU, PG8_ALIGN, PG8_SP2>(lds, g, S, E);
        }
        SEAM(pb + 3);
        if (KIND(6) && IN(pb + 4)) {
            pg8::Gemm g{Zb, (const bf16_t*)(ws + (layer ? WS_WDN1 : WS_WDN0)), M_TOK, D, DFF}; pg8::StaticOrder S; S.init(M_TOK, D, G, bx);
            pg8::EpiResid E{XB, SS};
            pg8::gemm_phase<pg8::EpiResid, PG8_ALIGN, PG8_SP2>(lds, g, S, E);
        }
        SEAM(pb + 4);
    }
    if (KIND(7) && IN(11)) final_norm(args, vcu, G);
#undef IN
#undef SEAM
}

extern "C" void kernel_launch(void* const* d_in, const int* in_sizes, int n_in, void* d_out, int out_size, void* d_ws, size_t ws_size, hipStream_t stream) {
    static int grid = 0;
    if (grid == 0) {
        if (n_in != 22 || in_sizes[0] != M_TOK * D || out_size != M_TOK * D || ws_size < WS_END) {
            fprintf(stderr, "kernel_launch: unexpected shapes: n_in %d in0 %d out %d ws %zu (need %zu)\n", n_in, n_in > 0 ? in_sizes[0] : -1, out_size, ws_size, (size_t)WS_END); grid = -1; return; }
        int dev = 0, cus = 0, per_cu = 0;
        if (hipGetDevice(&dev) != hipSuccess || hipDeviceGetAttribute(&cus, hipDeviceAttributeMultiprocessorCount, dev) != hipSuccess) { fprintf(stderr, "kernel_launch: device query failed\n"); grid = -1; return; }
        if (hipFuncSetAttribute((const void*)trunk_fwd, hipFuncAttributeMaxDynamicSharedMemorySize, LDS_BYTES) != hipSuccess) { fprintf(stderr, "kernel_launch: hipFuncSetAttribute failed\n"); grid = -1; return; }
        if (hipOccupancyMaxActiveBlocksPerMultiprocessor(&per_cu, (const void*)trunk_fwd, NTHREADS, LDS_BYTES) != hipSuccess || per_cu < 1) { fprintf(stderr, "kernel_launch: occupancy query says %d blocks/CU\n", per_cu); per_cu = 1; }
        (void)hipGetLastError();
        grid = cus;
        fprintf(stderr, "kernel_launch: cus %d per_cu %d grid %d\n", cus, per_cu, grid);
    }
    if (grid < 0) return;
    Args a{};
    const float** f = (const float**)&a;
    for (int i = 0; i < 22; ++i) f[i] = (const float*)d_in[i];
    a.out = (float*)d_out; a.ws = (unsigned char*)d_ws;
#if MK_PER_PHASE
    for (int p = 0; p < 12; ++p) {
        a.ph_lo = p; a.ph_hi = p + 1;
        for (int rep = 0; rep < 1 + ((PROBE_DUP >> p) & 1); ++rep)
            hipLaunchKernelGGL(trunk_fwd, dim3(grid), dim3(NTHREADS), LDS_BYTES, stream, a);
    }
#else
    a.ph_lo = 0; a.ph_hi = 12;
    if (hipMemsetAsync((char*)d_ws + WS_CTL, 0, 65536, stream) != hipSuccess) { fprintf(stderr, "kernel_launch: memset failed\n"); return; }
    void* kargs[] = {&a};
    hipError_t e = hipLaunchCooperativeKernel((const void*)trunk_fwd, dim3(grid), dim3(NTHREADS), kargs, LDS_BYTES, stream);
    if (e != hipSuccess) fprintf(stderr, "kernel_launch: cooperative launch failed: %s (grid %d)\n", hipGetErrorString(e), grid);
#endif
}
```

```cpp
#include <hip/hip_runtime.h>
#include <hip/hip_cooperative_groups.h>
#include <cstdio>
#include <cstdint>
namespace cg = cooperative_groups;

#ifndef MK_PER_PHASE
#define MK_PER_PHASE 0
#endif

#ifndef PROBE_DUPK
#define PROBE_DUPK 0
#endif
#define NREP(k) (1 + (((PROBE_DUPK) >> (k)) & 1))
#ifndef PROBE_DUP
#define PROBE_DUP 0
#endif

#define LAS __attribute__((address_space(3)))
typedef unsigned short bf16_t;
typedef short bf16x8 __attribute__((ext_vector_type(8)));
typedef short s16x4 __attribute__((ext_vector_type(4)));
typedef float f32x4 __attribute__((ext_vector_type(4)));
typedef float f32x2 __attribute__((ext_vector_type(2)));
typedef unsigned u32x4 __attribute__((ext_vector_type(4)));
typedef unsigned u32x2 __attribute__((ext_vector_type(2)));

constexpr int M_TOK = 32768, D = 1024, SEQ = 8192;
constexpr int EVEN_IN = 1536, ODD_IN = 2560, DFF = 2816, GU = 2 * DFF;
constexpr float EPS = 1e-6f;
constexpr int NWAVES = 8, NTHREADS = 512;

constexpr size_t MiB = 1u << 20;
constexpr size_t WS_Z = 0 * MiB;
constexpr size_t WS_ACT = 0 * MiB;
constexpr size_t WS_Y = 96 * MiB;
constexpr size_t WS_XB = 176 * MiB;
constexpr size_t WS_CTL = 240 * MiB, CTL_BYTES = 1 * MiB;
constexpr size_t WS_WIN0 = 242 * MiB, WS_WOUT0 = 245 * MiB, WS_WGU0 = 247 * MiB, WS_WDN0 = 258 * MiB;
constexpr size_t WS_WIN1 = 264 * MiB, WS_WOUT1 = 269 * MiB, WS_WGU1 = 271 * MiB, WS_WDN1 = 282 * MiB;
constexpr size_t WS_WS = 288 * MiB, WS_WP = 289 * MiB;
constexpr size_t WS_SS = 290 * MiB;
constexpr size_t WS_END = 304 * MiB;

constexpr int LDS_BYTES = 155648;
constexpr int LDS_MISC_OFF = LDS_BYTES - 256;
constexpr int CW_BAR = 4096;
#ifndef USE_CG_SYNC
#define USE_CG_SYNC 0
#endif

__device__ __forceinline__ unsigned cvt_pk_bf16(float lo, float hi) { unsigned r; asm volatile("v_cvt_pk_bf16_f32 %0, %1, %2" : "=v"(r) : "v"(lo), "v"(hi)); return r; }
__device__ __forceinline__ unsigned long long opaque_uniform_u64(unsigned long long v) {
    unsigned lo = __builtin_amdgcn_readfirstlane((unsigned)v), hi = __builtin_amdgcn_readfirstlane((unsigned)(v >> 32));
    asm volatile("" : "+s"(lo), "+s"(hi));
    return ((unsigned long long)hi << 32) | lo;
}
template <class T> __device__ __forceinline__ T* opaque_uniform(T* p) { return (T*)opaque_uniform_u64((unsigned long long)p); }
#define OPAQUE_S(p) p = opaque_uniform(p)
__device__ __forceinline__ float bf_lo(unsigned u) { return __uint_as_float(u << 16); }
__device__ __forceinline__ float bf_hi(unsigned u) { return __uint_as_float(u & 0xffff0000u); }
__device__ __forceinline__ float wave_sum(float v) {
#pragma unroll
    for (int o = 1; o < 64; o <<= 1) v += __shfl_xor(v, o);
    return v;
}
__device__ __forceinline__ float sigmoid_f(float x) { return __builtin_amdgcn_rcpf(1.0f + __expf(-x)); }
__device__ __forceinline__ float silu_f(float x) { return x * sigmoid_f(x); }
__device__ __forceinline__ float gelu_tanh_f(float x) { const float u = 0.7978845608028654f * (x + 0.044715f * x * x * x); return x * sigmoid_f(2.0f * u); }
__device__ __forceinline__ f32x4 exp2_v4(const f32x4 t) { f32x4 e; e.x = __builtin_amdgcn_exp2f(t.x); e.y = __builtin_amdgcn_exp2f(t.y); e.z = __builtin_amdgcn_exp2f(t.z); e.w = __builtin_amdgcn_exp2f(t.w); return e; }
__device__ __forceinline__ f32x4 rcp_v4(const f32x4 d) { f32x4 r; r.x = __builtin_amdgcn_rcpf(d.x); r.y = __builtin_amdgcn_rcpf(d.y); r.z = __builtin_amdgcn_rcpf(d.z); r.w = __builtin_amdgcn_rcpf(d.w); return r; }
__device__ __forceinline__ f32x4 sigmoid_scaled_v4(const f32x4 x, const float c) { return rcp_v4(exp2_v4(x * c) + 1.0f); }
__device__ __forceinline__ f32x4 gelu_tanh_v4(const f32x4 x) {
    const f32x4 w = x * (x * x * 0.044715f + 1.0f);
    return x * rcp_v4(exp2_v4(w * -2.3022081986f) + 1.0f);
}
__device__ __forceinline__ void unpack8(const u32x4 r, float (&v)[8]) {
    v[0] = bf_lo(r.x); v[1] = bf_hi(r.x); v[2] = bf_lo(r.y); v[3] = bf_hi(r.y); v[4] = bf_lo(r.z); v[5] = bf_hi(r.z); v[6] = bf_lo(r.w); v[7] = bf_hi(r.w);
}
__device__ __forceinline__ u32x4 pack8(const float (&v)[8]) {
    u32x4 r; r.x = cvt_pk_bf16(v[0], v[1]); r.y = cvt_pk_bf16(v[2], v[3]); r.z = cvt_pk_bf16(v[4], v[5]); r.w = cvt_pk_bf16(v[6], v[7]); return r;
}
__device__ __forceinline__ float row_rstd(const float* ss, int row) {
    const f32x4* p = (const f32x4*)(ss + (size_t)row * 16);
    const f32x4 a = p[0], b = p[1], c = p[2], d = p[3];
    const f32x4 s = (a + b) + (c + d);
    return rsqrtf(((s.x + s.y) + (s.z + s.w)) * (1.0f / 1024.0f) + EPS);
}


__device__ __forceinline__ int phase_tid(int wave_id) {
    unsigned ones = ~0u; asm volatile("" : "+s"(ones));
    int t = wave_id * 64 + (int)__builtin_amdgcn_mbcnt_hi(ones, __builtin_amdgcn_mbcnt_lo(ones, 0u));
    asm volatile("" : "+v"(t)); return t;
}

typedef __attribute__((address_space(1))) unsigned gu32;
#define XB_TMO      128
#define XB_XCNT(j)  (256  + 64 * (j))
#define XB_XSUB(j)  (1280 + 64 * (j))
#define XB_XGEN(j)  (2304 + 64 * (j))
#define XB_TOP      3328
#define XB_TOPGEN   3392
#define XB_DONE_A   3456
#define XB_DONE_B   3520
#define XCD_BAR_WORDS 3584
#define XB_SPIN_CAP (1u << 18)
__device__ __forceinline__ unsigned xb_ld(unsigned* p)              { return __hip_atomic_load(p, __ATOMIC_RELAXED, __HIP_MEMORY_SCOPE_AGENT); }
__device__ __forceinline__ unsigned xb_add(unsigned* p, unsigned v) { return __hip_atomic_fetch_add(p, v, __ATOMIC_RELAXED, __HIP_MEMORY_SCOPE_AGENT); }
__device__ __forceinline__ unsigned xb_xcc_id() { return (unsigned)__builtin_amdgcn_s_getreg((3 << 11) | 20) & 0xFu; }
#define XB_SPIN(cond, bar) do { unsigned _sp = 0; while (cond) { __builtin_amdgcn_s_sleep(1); \
    if ((++_sp & 255u) == 0u) { if (xb_ld(&(bar)[XB_TMO])) break; if (_sp > XB_SPIN_CAP) { atomicAdd(&(bar)[XB_TMO], 1u); break; } } } } while (0)
struct XcdBarrier { unsigned* bar; unsigned x; volatile LAS unsigned* st; };
__device__ __forceinline__ XcdBarrier xcd_barrier_post(unsigned* bar, volatile LAS unsigned* st) {
    XcdBarrier b; b.bar = bar; b.x = xb_xcc_id(); b.st = st;
    if (threadIdx.x == 0) st[2] = xb_add(&bar[XB_XCNT(b.x)], 1u);
    return b;
}
__device__ __forceinline__ void xcd_barrier_complete(unsigned* bar, unsigned x, unsigned& nloc, unsigned& nx, unsigned& uni) {
    const unsigned G = gridDim.x * gridDim.y * gridDim.z;
    unsigned sum, cnt, mine, bad, sp = 0u;
    for (;;) {
        sum = 0u; cnt = 0u; mine = 0u; bad = 0u;
#pragma unroll
        for (unsigned j = 0; j < 16; ++j) { const unsigned c = xb_ld(&bar[XB_XCNT(j)]); sum += c; cnt += (c > 0u) ? 1u : 0u; mine = (j == x) ? c : mine; bad |= (c != 0u && c * 8u != G) ? 1u : 0u; }
        if (sum == G) break;
        __builtin_amdgcn_s_sleep(1);
        if ((++sp & 255u) == 0u) { if (xb_ld(&bar[XB_TMO])) break; if (sp > XB_SPIN_CAP) { atomicAdd(&bar[XB_TMO], 1u); break; } }
    }
    nloc = mine > 0u ? mine : 1u; nx = cnt > 0u ? cnt : 1u;
    uni = (sum == G && cnt == 8u && bad == 0u && x < 8u) ? 1u : 0u;
}
__device__ __forceinline__ void xcd_barrier(const XcdBarrier& b, int wave_id, unsigned local = 0u, unsigned arrive = 0u) {
    asm volatile("s_waitcnt vmcnt(0)" ::: "memory");
    __syncthreads();
    unsigned ones = ~0u; asm volatile("" : "+s"(ones));
    if (wave_id == 0 && __builtin_amdgcn_mbcnt_hi(ones, __builtin_amdgcn_mbcnt_lo(ones, 0u)) == 0u) {
        unsigned* bar = b.bar;
        __builtin_amdgcn_s_waitcnt(0);
        unsigned nloc = b.st[0], nx = b.st[1];
        if (nloc == 0u) { unsigned uni; xcd_barrier_complete(bar, b.x, nloc, nx, uni); b.st[0] = nloc; b.st[1] = nx; b.st[3] = uni; }
        if (arrive) (void)xb_add(&bar[arrive], 1u);
        const unsigned old = xb_add(&bar[XB_XSUB(b.x)], 1u);
        const unsigned gen = old / nloc;
        if (old + 1u == (gen + 1u) * nloc) {
            if (!local) {
                __builtin_amdgcn_fence(__ATOMIC_RELEASE, "agent");
                asm volatile("s_waitcnt vmcnt(0)" ::: "memory");
                const unsigned og = xb_add(&bar[XB_TOP], 1u);
                const unsigned tg = og / nx;
                if (og + 1u == (tg + 1u) * nx) xb_add(&bar[XB_TOPGEN], 1u);
                else XB_SPIN(xb_ld(&bar[XB_TOPGEN]) == tg, bar);
            }
            __builtin_amdgcn_fence(__ATOMIC_ACQUIRE, "agent");
            xb_add(&bar[XB_XGEN(b.x)], 1u);
            asm volatile("s_waitcnt vmcnt(0)" ::: "memory");
        } else {
            XB_SPIN(xb_ld(&bar[XB_XGEN(b.x)]) == gen, bar);
            __builtin_amdgcn_fence(__ATOMIC_ACQUIRE, "agent");
            asm volatile("s_waitcnt vmcnt(0)" ::: "memory");
        }
    }
    __syncthreads();
}

__device__ __forceinline__ float row_sumsq_part(const float* ss, int row, int fq) { const f32x4 a = *(const f32x4*)(ss + (size_t)row * 16 + 4 * fq); return (a.x + a.y) + (a.z + a.w); }
__device__ __forceinline__ float rstd_from_part(float p) { p += __shfl_xor(p, 16); p += __shfl_xor(p, 32); return rsqrtf(p * (1.0f / 1024.0f) + EPS); }

namespace pg8 {
constexpr int BM = 256, BK = 64, HALF = 128, HTB = HALF * BK * 2, STAGE_BYTES = 8 * HTB, NXCD = 8, WGM = 4;
__device__ __forceinline__ int lds_byte(int r, int c) { const int st = (r >> 4) * 2 + (c >> 5), rr = r & 15, cc = c & 31, ob = rr * 64 + cc * 2; return st * 1024 + (ob ^ (((ob >> 9) & 1) << 5)); }
__device__ __forceinline__ void stage_rc(int b, int& R, int& C) { const int st = b / 1024, sb = b % 1024, swz = sb ^ (((sb >> 9) & 1) << 5); R = (st >> 1) * 16 + swz / 64; C = (st & 1) * 32 + (swz % 64) / 2; }
__device__ __forceinline__ int perm32(int rho) { const int n = rho >> 4, i = rho & 15; return 8 * (i >> 2) + 4 * n + (i & 3); }

struct Unit { int pm, pn; };
struct Gemm { const bf16_t* A; const bf16_t* Bt; int M, N, K; };

struct StaticOrder {
    int nM, nN, nwg, G, c;
    __device__ void init(int M, int N, int G_, int c_) { nM = M / BM; nN = N / BM; nwg = nM * nN; G = G_; c = c_; }
    __device__ bool next(int i, Unit& u) const {
        const long L = (long)i * G + c; if (L >= nwg) return false;
        int wgid = (int)L; { const int q = nwg / NXCD, r = nwg % NXCD, xcd = wgid % NXCD, off = wgid / NXCD; wgid = (xcd < r ? xcd * (q + 1) : r * (q + 1) + (xcd - r) * q) + off; }
        const int nig = WGM * nN, gid = wgid / nig, fm = gid * WGM, gsz = (nM - fm) < WGM ? (nM - fm) : WGM;
        u.pm = fm + ((wgid % nig) % gsz); u.pn = (wgid % nig) / gsz; return true;
    }
};

struct EpiScaleBf16 {
    static constexpr bool PERM = true, USES_RSTD = true;
    bf16_t* O; int odd; const float* ss;
    __device__ __forceinline__ void operator()(const f32x4 (&acc)[2][2][4][2], const Unit& u, int wr, int wc, int fr, int fq, const LAS float* rl) const {
        const int row0 = u.pm * BM + wr * 64 + fr;
        if (odd && u.pn < 8) {
            const bool glu = u.pn < 4;
            const int col0 = (glu ? 128 * u.pn : 512 + 128 * (u.pn - 4)) + wc * 32 + 8 * fq;
#pragma unroll
            for (int ai = 0; ai < 2; ++ai)
#pragma unroll
                for (int m = 0; m < 4; ++m) {
                    const int row = row0 + ai * HALF + m * 16; const float rs = rl[ai * HALF + wr * 64 + m * 16 + fr];
                    f32x4 o0, o1;
                    if (glu) {
                        const float c1 = -1.4426950408889634f * rs;
                        o0 = acc[ai][0][m][0] * (sigmoid_scaled_v4(acc[ai][1][m][0], c1) * rs); o1 = acc[ai][0][m][1] * (sigmoid_scaled_v4(acc[ai][1][m][1], c1) * rs);
                    } else {
                        const float rs2 = rs * rs;
                        o0 = (acc[ai][0][m][0] * acc[ai][1][m][0]) * rs2; o1 = (acc[ai][0][m][1] * acc[ai][1][m][1]) * rs2;
                    }
                    u32x4 w; w.x = cvt_pk_bf16(o0[0], o0[1]); w.y = cvt_pk_bf16(o0[2], o0[3]); w.z = cvt_pk_bf16(o1[0], o1[1]); w.w = cvt_pk_bf16(o1[2], o1[3]);
                    *(u32x4*)(O + (size_t)row * EVEN_IN + col0) = w;
                }
            return;
        }
        const int col0 = (odd ? 1024 + 256 * (u.pn - 8) : u.pn * BM) + wc * 32 + 8 * fq;
        const bool act = !odd && u.pn < 4;
#pragma unroll
        for (int ai = 0; ai < 2; ++ai)
#pragma unroll
            for (int m = 0; m < 4; ++m) {
                const int row = row0 + ai * HALF + m * 16; const float rs = rl[ai * HALF + wr * 64 + m * 16 + fr];
                bf16_t* rowp = O + (size_t)row * EVEN_IN + col0;
#pragma unroll
                for (int bj = 0; bj < 2; ++bj) {
                    f32x4 v0 = acc[ai][bj][m][0] * rs, v1 = acc[ai][bj][m][1] * rs;
                    if (act) { v0 = gelu_tanh_v4(v0); v1 = gelu_tanh_v4(v1); }
                    u32x4 w; w.x = cvt_pk_bf16(v0[0], v0[1]); w.y = cvt_pk_bf16(v0[2], v0[3]); w.z = cvt_pk_bf16(v1[0], v1[1]); w.w = cvt_pk_bf16(v1[2], v1[3]);
                    *(u32x4*)(rowp + bj * HALF) = w;
                }
            }
    }
};
struct EpiSwiGLU {
    static constexpr bool PERM = true, USES_RSTD = true;
    bf16_t* O; const float* ss;
    __device__ __forceinline__ void operator()(const f32x4 (&acc)[2][2][4][2], const Unit& u, int wr, int wc, int fr, int fq, const LAS float* rl) const {
        const int row0 = u.pm * BM + wr * 64 + fr, f0 = u.pn * HALF + wc * 32 + 8 * fq;
#pragma unroll
        for (int ai = 0; ai < 2; ++ai)
#pragma unroll
            for (int m = 0; m < 4; ++m) {
                const int row = row0 + ai * HALF + m * 16; const float rs = rl[ai * HALF + wr * 64 + m * 16 + fr];
                const float c1 = -1.4426950408889634f * rs, rs2 = rs * rs;
                const f32x4 a0 = (acc[ai][0][m][0] * acc[ai][1][m][0]) * (sigmoid_scaled_v4(acc[ai][0][m][0], c1) * rs2);
                const f32x4 a1 = (acc[ai][0][m][1] * acc[ai][1][m][1]) * (sigmoid_scaled_v4(acc[ai][0][m][1], c1) * rs2);
                u32x4 w; w.x = cvt_pk_bf16(a0[0], a0[1]); w.y = cvt_pk_bf16(a0[2], a0[3]); w.z = cvt_pk_bf16(a1[0], a1[1]); w.w = cvt_pk_bf16(a1[2], a1[3]);
                __builtin_nontemporal_store(w, (u32x4*)(O + (size_t)row * DFF + f0));
            }
    }
};
struct EpiResid {
    static constexpr bool PERM = true, USES_RSTD = false, OVERLAP = false;
    bf16_t* xb; float* ss;
    __device__ __forceinline__ void operator()(const f32x4 (&acc)[2][2][4][2], const Unit& u, int wr, int wc, int fr, int fq, const LAS float*) const {
        int lrow = wr * 64 + fr; asm volatile("" : "+v"(lrow));
        const int row0 = u.pm * BM + lrow, col0 = u.pn * BM + wc * 32 + 8 * fq;
        bf16_t* base = xb + (size_t)row0 * D + col0;
        u32x4 rv[2][4][2];
#pragma unroll
        for (int ai = 0; ai < 2; ++ai)
#pragma unroll
            for (int m = 0; m < 4; ++m)
#pragma unroll
                for (int bj = 0; bj < 2; ++bj) rv[ai][m][bj] = *(const u32x4*)(base + (size_t)(ai * HALF + m * 16) * D + bj * HALF);
#pragma unroll
        for (int ai = 0; ai < 2; ++ai)
#pragma unroll
            for (int m = 0; m < 4; ++m) {
                f32x4 q4 = (f32x4){0.f, 0.f, 0.f, 0.f};
#pragma unroll
                for (int bj = 0; bj < 2; ++bj) {
                    const u32x4 rw = rv[ai][m][bj];
                    const f32x4 h0 = (f32x4){bf_lo(rw.x), bf_hi(rw.x), bf_lo(rw.y), bf_hi(rw.y)} + acc[ai][bj][m][0];
                    const f32x4 h1 = (f32x4){bf_lo(rw.z), bf_hi(rw.z), bf_lo(rw.w), bf_hi(rw.w)} + acc[ai][bj][m][1];
                    q4 += h0 * h0 + h1 * h1;
                    u32x4 w; w.x = cvt_pk_bf16(h0.x, h0.y); w.y = cvt_pk_bf16(h0.z, h0.w); w.z = cvt_pk_bf16(h1.x, h1.y); w.w = cvt_pk_bf16(h1.z, h1.w);
                    *(u32x4*)(base + (size_t)(ai * HALF + m * 16) * D + bj * HALF) = w;
                }
                float q = (q4.x + q4.y) + (q4.z + q4.w);
                q += __shfl_xor(q, 16); q += __shfl_xor(q, 32);
                if (fq == 0) ss[(size_t)(row0 + ai * HALF + m * 16) * 16 + u.pn * 4 + wc] = q;
            }
    }
};

template <class Epi, bool ALIGN_EPI, bool SP2>
__device__ __forceinline__ void gemm_phase(LAS unsigned char* lds, const Gemm g, const StaticOrder& S, const Epi& E, int wave_id, unsigned* wait_ctr = nullptr, unsigned wait_val = 0u) {
    int tid_ = phase_tid(wave_id);
    const int tid = tid_, wid = __builtin_amdgcn_readfirstlane(tid >> 6), lane = tid & 63, wr = wid >> 2, wc = wid & 3, fr = lane & 15, fq = lane >> 4;
    const int K = g.K, nt = K / BK;
    unsigned voffA[2], voffB[2];
#pragma unroll
    for (int i = 0; i < 2; ++i) { int R, C; stage_rc(tid * 16 + i * 8192, R, C); const int Rb = Epi::PERM ? ((R & ~31) + perm32(R & 31)) : R;
        voffA[i] = (unsigned)(R * K + C) * 2u; voffB[i] = (unsigned)(Rb * K + C) * 2u; }
    const size_t kstep = (size_t)(BK * 2);
    const size_t hstep = (size_t)HALF * K * 2;
    const size_t tstep = 2 * hstep;
    const unsigned ldsw = (unsigned)wid * 1024u;
    const int aoff = lds_byte(wr * 64 + fr, fq * 8), boff = lds_byte(wc * 32 + fr, fq * 8);
#define PG8_SA(b, h) (((b) * 2 + (h)) * HTB)
#define PG8_SB(b, h) ((4 + (b) * 2 + (h)) * HTB)
#define PG8_STAGE(bufoff, gbase, voff) do { _Pragma("unroll") for (int _i = 0; _i < 2; ++_i) \
        __builtin_amdgcn_global_load_lds((const unsigned*)((const char*)(gbase) + (voff)[_i]), (LAS unsigned*)(lds + (bufoff) + ldsw + _i * 8192), 16, 0, 0); } while (0)
#define PG8_LDA(dst, b, h) do { _Pragma("unroll") for (int m = 0; m < 4; ++m) _Pragma("unroll") for (int k = 0; k < 2; ++k) dst[m][k] = *(const LAS bf16x8*)(lds + PG8_SA(b, h) + aoff + m * 2048 + k * 1024); } while (0)
#define PG8_LDB(dst, b, h) do { _Pragma("unroll") for (int n = 0; n < 2; ++n) _Pragma("unroll") for (int k = 0; k < 2; ++k) dst[n][k] = *(const LAS bf16x8*)(lds + PG8_SB(b, h) + boff + n * 2048 + k * 1024); } while (0)
#define PG8_MMA(ai, bj, At, Bt) do { __builtin_amdgcn_s_setprio(1); _Pragma("unroll") for (int m = 0; m < 4; ++m) _Pragma("unroll") for (int n = 0; n < 2; ++n) _Pragma("unroll") for (int k = 0; k < 2; ++k) \
        acc[ai][bj][m][n] = __builtin_amdgcn_mfma_f32_16x16x32_bf16(Bt[n][k], At[m][k], acc[ai][bj][m][n], 0, 0, 0); __builtin_amdgcn_s_setprio(0); } while (0)
#define PG8_WAIT_V(n) asm volatile("s_waitcnt vmcnt(" #n ")" ::: "memory")
#define PG8_WAIT_L(n) asm volatile("s_waitcnt lgkmcnt(" #n ")" ::: "memory")
#define PG8_BAR __builtin_amdgcn_s_barrier()
#define PG8_SCHED __builtin_amdgcn_sched_barrier(0)
    Unit cur, nxt; int ui = 0;
    if (!S.next(0, cur)) return;
#ifdef PROBE_STAGGER
    if (blockIdx.x & 8) { const unsigned long long t0 = __builtin_amdgcn_s_memrealtime(); while (__builtin_amdgcn_s_memrealtime() - t0 < PROBE_STAGGER) __builtin_amdgcn_s_sleep(8); }
#endif
    f32x4 acc[2][2][4][2];
#pragma unroll
    for (int a = 0; a < 2; ++a)
#pragma unroll
        for (int b = 0; b < 2; ++b)
#pragma unroll
            for (int m = 0; m < 4; ++m)
#pragma unroll
                for (int n = 0; n < 2; ++n) acc[a][b][m][n] = (f32x4){0.f, 0.f, 0.f, 0.f};
    bf16x8 At[4][2], B0[2][2], B1[2][2];
    const char* cA = (const char*)g.A + (size_t)cur.pm * tstep; const char* cB = (const char*)g.Bt + (size_t)cur.pn * tstep;
    if constexpr (SP2) {
        PG8_STAGE(PG8_SB(0, 0), cB, voffB); PG8_STAGE(PG8_SB(0, 1), cB + hstep, voffB); PG8_STAGE(PG8_SA(0, 0), cA, voffA); PG8_STAGE(PG8_SA(0, 1), cA + hstep, voffA);
        if (wr == 1) PG8_BAR;
        PG8_WAIT_V(2); PG8_BAR;
        PG8_STAGE(PG8_SB(1, 0), cB + kstep, voffB); PG8_STAGE(PG8_SA(1, 0), cA + kstep, voffA); PG8_STAGE(PG8_SB(1, 1), cB + hstep + kstep, voffB);
        PG8_WAIT_V(6); PG8_BAR;
    } else {
        PG8_STAGE(PG8_SB(0, 0), cB, voffB); PG8_STAGE(PG8_SA(0, 0), cA, voffA); PG8_STAGE(PG8_SB(0, 1), cB + hstep, voffB); PG8_STAGE(PG8_SA(0, 1), cA + hstep, voffA);
        if (wr == 1) PG8_BAR;
        PG8_WAIT_V(4); PG8_BAR;
        PG8_STAGE(PG8_SB(1, 0), cB + kstep, voffB); PG8_STAGE(PG8_SA(1, 0), cA + kstep, voffA); PG8_STAGE(PG8_SB(1, 1), cB + hstep + kstep, voffB);
        PG8_WAIT_V(6); PG8_BAR;
    }
    LAS unsigned char* ssimg = lds + STAGE_BYTES;
    const LAS float* rstd_tab = (const LAS float*)(lds + STAGE_BYTES + 16384);
    for (;;) {
        const bool has_next = S.next(ui + 1, nxt);
        const char* nA = has_next ? (const char*)g.A + (size_t)nxt.pm * tstep : cA; const char* nB = has_next ? (const char*)g.Bt + (size_t)nxt.pn * tstep : cB;
        for (int t = 0; t < nt; t += 2) {
            const bool last = (t == nt - 2);
            const char* a1 = cA + (size_t)(t + 1) * kstep;
            const char* a2 = last ? nA : cA + (size_t)(t + 2) * kstep; const char* b2 = last ? nB : cB + (size_t)(t + 2) * kstep;
            const char* a3 = a2 + kstep; const char* b3 = b2 + kstep;
            if constexpr (Epi::USES_RSTD) { if (last) {
                unsigned loff = lane * 16; asm volatile("" : "+v"(loff));
                const char* sp = (const char*)E.ss + (size_t)cur.pm * 16384 + wid * 2048 + loff;
                __builtin_amdgcn_global_load_lds((const unsigned*)sp, (LAS unsigned*)(ssimg + wid * 2048), 16, 0, 0);
                __builtin_amdgcn_global_load_lds((const unsigned*)(sp + 1024), (LAS unsigned*)(ssimg + wid * 2048 + 1024), 16, 0, 0); } }
            if constexpr (SP2) {
            PG8_LDB(B0, 0, 0); PG8_LDB(B1, 0, 1); PG8_SCHED; PG8_LDA(At, 0, 0); PG8_STAGE(PG8_SA(1, 1), a1 + hstep, voffA);
            PG8_WAIT_V(8); PG8_WAIT_L(0); PG8_BAR; PG8_MMA(0, 0, At, B0); PG8_MMA(0, 1, At, B1); PG8_BAR; PG8_SCHED;
            PG8_LDA(At, 0, 1); PG8_STAGE(PG8_SB(0, 0), b2, voffB); PG8_STAGE(PG8_SB(0, 1), b2 + hstep, voffB); PG8_STAGE(PG8_SA(0, 0), a2, voffA);
            PG8_WAIT_V(8); PG8_WAIT_L(0); PG8_BAR; PG8_MMA(1, 0, At, B0); PG8_MMA(1, 1, At, B1); PG8_BAR; PG8_SCHED;
            PG8_LDB(B0, 1, 0); PG8_LDB(B1, 1, 1); PG8_SCHED; PG8_LDA(At, 1, 0); PG8_STAGE(PG8_SA(0, 1), a2 + hstep, voffA);
            PG8_WAIT_V(8); PG8_WAIT_L(0); PG8_BAR; PG8_MMA(0, 0, At, B0); PG8_MMA(0, 1, At, B1); PG8_BAR; PG8_SCHED;
            PG8_LDA(At, 1, 1); PG8_STAGE(PG8_SB(1, 0), b3, voffB); PG8_STAGE(PG8_SB(1, 1), b3 + hstep, voffB); PG8_STAGE(PG8_SA(1, 0), a3, voffA);
            PG8_WAIT_V(8); PG8_WAIT_L(0); PG8_BAR; PG8_MMA(1, 0, At, B0); PG8_MMA(1, 1, At, B1); PG8_BAR; PG8_SCHED;
            } else {
            PG8_LDB(B0, 0, 0); PG8_SCHED; PG8_LDA(At, 0, 0); PG8_STAGE(PG8_SA(1, 1), a1 + hstep, voffA);
            PG8_WAIT_L(8); PG8_BAR; PG8_WAIT_L(0); PG8_MMA(0, 0, At, B0); PG8_BAR; PG8_SCHED;
            PG8_LDB(B1, 0, 1); PG8_STAGE(PG8_SB(0, 0), b2, voffB);
            PG8_BAR; PG8_WAIT_L(0); PG8_MMA(0, 1, At, B1); PG8_BAR;
            PG8_LDA(At, 0, 1); PG8_STAGE(PG8_SA(0, 0), a2, voffA);
            PG8_BAR; PG8_WAIT_L(0); PG8_MMA(1, 0, At, B0); PG8_BAR; PG8_SCHED;
            PG8_STAGE(PG8_SB(0, 1), b2 + hstep, voffB);
            PG8_WAIT_V(6); PG8_BAR; PG8_MMA(1, 1, At, B1); PG8_BAR;
            PG8_LDB(B0, 1, 0); PG8_SCHED; PG8_LDA(At, 1, 0); PG8_STAGE(PG8_SA(0, 1), a2 + hstep, voffA);
            PG8_WAIT_L(8); PG8_BAR; PG8_WAIT_L(0); PG8_MMA(0, 0, At, B0); PG8_BAR; PG8_SCHED;
            PG8_LDB(B1, 1, 1); PG8_STAGE(PG8_SB(1, 0), b3, voffB);
            PG8_BAR; PG8_WAIT_L(0); PG8_MMA(0, 1, At, B1); PG8_BAR;
            PG8_LDA(At, 1, 1); PG8_STAGE(PG8_SA(1, 0), a3, voffA);
            PG8_BAR; PG8_WAIT_L(0); PG8_MMA(1, 0, At, B0); PG8_BAR; PG8_SCHED;
            PG8_STAGE(PG8_SB(1, 1), b3 + hstep, voffB);
            PG8_WAIT_V(6); PG8_BAR; PG8_MMA(1, 1, At, B1); PG8_BAR;
            }
        }
        if constexpr (Epi::USES_RSTD) {
            const LAS f32x4* sp = (const LAS f32x4*)(ssimg + tid * 32);
            const f32x4 sv = sp[0] + sp[1]; float p = (sv.x + sv.y) + (sv.z + sv.w); p += __shfl_xor(p, 1);
            if (!(tid & 1)) ((LAS float*)(lds + STAGE_BYTES + 16384))[tid >> 1] = rsqrtf(p * (1.0f / 1024.0f) + EPS);
        }
        if constexpr (ALIGN_EPI) { if (wr == 0) PG8_BAR; }
        if constexpr (Epi::USES_RSTD) {
            if (ui == 0 && wait_ctr != nullptr && tid == 0) {
                unsigned sp_ = 0u; while (xb_ld(wait_ctr) < wait_val) { __builtin_amdgcn_s_sleep(1); if (++sp_ > (XB_SPIN_CAP << 8)) break; } }
            PG8_WAIT_L(0); PG8_BAR; }
        E(acc, cur, wr, wc, fr, fq, rstd_tab);
        if (!has_next) break;
#pragma unroll
        for (int a = 0; a < 2; ++a)
#pragma unroll
            for (int b = 0; b < 2; ++b)
#pragma unroll
                for (int m = 0; m < 4; ++m)
#pragma unroll
                    for (int n = 0; n < 2; ++n) acc[a][b][m][n] = (f32x4){0.f, 0.f, 0.f, 0.f};
        cur = nxt; cA = nA; cB = nB; ++ui;
        if constexpr (ALIGN_EPI) { if (wr == 1) PG8_BAR; }
    }
    PG8_WAIT_V(0);
    if constexpr (!ALIGN_EPI) { if (wr == 0) PG8_BAR; }
    PG8_BAR;
#undef PG8_SA
#undef PG8_SB
#undef PG8_STAGE
#undef PG8_LDA
#undef PG8_LDB
#undef PG8_MMA
#undef PG8_WAIT_V
#undef PG8_WAIT_L
#undef PG8_BAR
#undef PG8_SCHED
}
}

struct Args {
    const float* x; const float* even_w_in; const float* even_w_out; const float* a_w_s; const float* a_b_s; const float* a_ln_g; const float* a_ln_b;
    const float* b_w_pool; const float* b_scale; const float* odd_w_in; const float* odd_w_out; const float* c_w_dw; const float* c_b_dw; const float* c_ln_g; const float* c_ln_b;
    const float* d_w_dw; const float* norm_mix_g; const float* norm_ffn_g; const float* ffn_w_gate; const float* ffn_w_up; const float* ffn_w_down; const float* final_norm_g;
    float* out; unsigned char* ws; int ph_lo, ph_hi;
};

typedef const __attribute__((address_space(4))) Args* KArgsPtr;
__device__ __forceinline__ KArgsPtr fresh_args() { return (KArgsPtr)opaque_uniform_u64((unsigned long long)__builtin_amdgcn_kernarg_segment_ptr()); }

constexpr int P0_SCR_BYTES = 64 * 65 * 4;
__device__ __forceinline__ void p0_transpose_item(const float* W, int K, int N, bf16_t* WT, int grp, int gstride, int goff, const float* gk, LAS float* scr, int item, int lane, int oddmap = 0) {
    const int nblk = N / 64, kb = item / nblk, nb = item % nblk, k0 = 64 * kb, n0 = 64 * nb;
    const int lr = lane >> 4, lc = 4 * (lane & 15);
    f32x4 v[16];
#pragma unroll
    for (int i = 0; i < 16; ++i) v[i] = __builtin_nontemporal_load((const f32x4*)(W + (size_t)(k0 + 4 * i + lr) * N + n0 + lc));
#pragma unroll
    for (int i = 0; i < 16; ++i) { LAS float* p = scr + (4 * i + lr) * 65 + lc; p[0] = v[i].x; p[1] = v[i].y; p[2] = v[i].z; p[3] = v[i].w; }
    asm volatile("s_waitcnt lgkmcnt(0)" ::: "memory");
    const int c = lane & 7;
    float gv[8];
    if (gk) { const f32x4 g0 = *(const f32x4*)(gk + k0 + 8 * c), g1 = *(const f32x4*)(gk + k0 + 8 * c + 4);
#pragma unroll
        for (int j = 0; j < 4; ++j) { gv[j] = g0[j]; gv[4 + j] = g1[j]; } }
    else {
#pragma unroll
        for (int j = 0; j < 8; ++j) gv[j] = 1.0f; }
    int drow0 = (n0 / grp) * gstride + goff + (n0 % grp);
    if (oddmap) {
        const int seg = n0 >> 9, c0 = n0 & 511, pr = (c0 >> 7) * 256 + (c0 & 127);
        drow0 = seg == 0 ? pr : seg == 1 ? pr + 128 : seg == 2 ? 2048 + c0 : seg == 3 ? 1024 + pr : 1024 + pr + 128;
    }
#pragma unroll
    for (int j = 0; j < 8; ++j) { const int n = (lane >> 3) + 8 * j; const LAS float* s = scr + (8 * c) * 65 + n;
        float o[8];
#pragma unroll
        for (int e = 0; e < 8; ++e) o[e] = s[e * 65] * gv[e];
        __builtin_nontemporal_store(pack8(o), (u32x4*)(WT + (size_t)(drow0 + n) * K + k0 + 8 * c)); }
    asm volatile("s_waitcnt lgkmcnt(0)" ::: "memory");
}

__device__ __forceinline__ void p0_prologue(LAS unsigned char* lds, int vcu, int G, int wave_id) {
    const __attribute__((address_space(4))) Args& A = *fresh_args();
    int tid_ = phase_tid(wave_id);
    const int tid = tid_, lane = tid & 63, wave = __builtin_amdgcn_readfirstlane(tid >> 6);
    LAS float* scr = (LAS float*)(lds + wave * P0_SCR_BYTES);
    const int gw = vcu * NWAVES + wave, NGW = G * NWAVES;
    unsigned char* ws = A.ws;
    constexpr int I_IN0 = 16 * (EVEN_IN / 64), I_OUT = 16 * (D / 64), I_FF = 16 * (DFF / 64), I_DN = (DFF / 64) * (D / 64), I_IN1 = 16 * (ODD_IN / 64), I_WP = 2 * 2;
    constexpr int PER_LAYER_FFN = 2 * I_FF + I_DN;
    constexpr int NITEMS = I_IN0 + I_OUT + I_IN1 + I_OUT + 2 * PER_LAYER_FFN + 4 * I_WP;
    for (int it = gw; it < NITEMS; it += NGW) {
        int r = it;
        if (r < I_IN0) { p0_transpose_item(A.even_w_in, D, EVEN_IN, (bf16_t*)(ws + WS_WIN0), EVEN_IN, 0, 0, A.norm_mix_g, scr, r, lane); continue; } r -= I_IN0;
        if (r < I_OUT) { p0_transpose_item(A.even_w_out, D, D, (bf16_t*)(ws + WS_WOUT0), D, 0, 0, nullptr, scr, r, lane); continue; } r -= I_OUT;
        if (r < I_IN1) { p0_transpose_item(A.odd_w_in, D, ODD_IN, (bf16_t*)(ws + WS_WIN1), ODD_IN, 0, 0, A.norm_mix_g + D, scr, r, lane, 1); continue; } r -= I_IN1;
        if (r < I_OUT) { p0_transpose_item(A.odd_w_out, D, D, (bf16_t*)(ws + WS_WOUT1), D, 0, 0, nullptr, scr, r, lane); continue; } r -= I_OUT;
        if (r < 2 * PER_LAYER_FFN) {
            const int layer = r / PER_LAYER_FFN; r -= layer * PER_LAYER_FFN;
            bf16_t* wgu = (bf16_t*)(ws + (layer ? WS_WGU1 : WS_WGU0)); bf16_t* wdn = (bf16_t*)(ws + (layer ? WS_WDN1 : WS_WDN0));
            const float* gk = A.norm_ffn_g + layer * D;
            if (r < I_FF) { p0_transpose_item(A.ffn_w_gate + (size_t)layer * D * DFF, D, DFF, wgu, 128, 256, 0, gk, scr, r, lane); continue; } r -= I_FF;
            if (r < I_FF) { p0_transpose_item(A.ffn_w_up + (size_t)layer * D * DFF, D, DFF, wgu, 128, 256, 128, gk, scr, r, lane); continue; } r -= I_FF;
            p0_transpose_item(A.ffn_w_down + (size_t)layer * DFF * D, DFF, D, wdn, D, 0, 0, nullptr, scr, r, lane); continue;
        }
        r -= 2 * PER_LAYER_FFN;
        { const int g = r / I_WP; r -= g * I_WP;
          p0_transpose_item(A.b_w_pool + (size_t)g * 128 * 128, 128, 128, (bf16_t*)(ws + WS_WP) + (size_t)g * 128 * 128, 128, 0, 0, nullptr, scr, r, lane); }
    }
    { bf16_t* wm = (bf16_t*)(ws + WS_WS);
      for (int e = (vcu * NTHREADS + tid) * 2; e < 4 * 128 * 128; e += G * NTHREADS * 2) {
          const int i = (e >> 7) & 127, j = e & 127; const bool keep = (i >> 6) >= (j >> 6);
          const float a = keep ? A.a_w_s[e] : 0.f, b = keep ? A.a_w_s[e + 1] : 0.f;
          *(unsigned*)(wm + e) = cvt_pk_bf16(a, b); } }
    { bf16_t* xb = (bf16_t*)(ws + WS_XB); float* ss = (float*)(ws + WS_SS);
      for (int m0 = gw * 4; m0 < M_TOK; m0 += NGW * 4) {
          f32x4 v[4][4];
#pragma unroll
          for (int r = 0; r < 4; ++r)
#pragma unroll
              for (int j = 0; j < 4; ++j) v[r][j] = __builtin_nontemporal_load((const f32x4*)(A.x + (size_t)(m0 + r) * D) + lane + 64 * j);
#pragma unroll
          for (int r = 0; r < 4; ++r) {
              float s = 0.f;
#pragma unroll
              for (int j = 0; j < 4; ++j) s += (v[r][j].x * v[r][j].x + v[r][j].y * v[r][j].y) + (v[r][j].z * v[r][j].z + v[r][j].w * v[r][j].w);
              s = wave_sum(s);
              u32x2* o8 = (u32x2*)(xb + (size_t)(m0 + r) * D) + lane;
#pragma unroll
              for (int j = 0; j < 4; ++j) { u32x2 w; w.x = cvt_pk_bf16(v[r][j].x, v[r][j].y); w.y = cvt_pk_bf16(v[r][j].z, v[r][j].w); o8[64 * j] = w; }
              if (lane < 4) { f32x4 t = (f32x4){0.f, 0.f, 0.f, 0.f}; if (lane == 0) t.x = s; *((f32x4*)(ss + (size_t)(m0 + r) * 16) + lane) = t; }
          }
      } }
}

constexpr int VN_STRIDE = 1056;
constexpr int PL_STRIDE = 1040;
__device__ __forceinline__ float seg16_sum(float v) { v += __shfl_xor(v, 1); v += __shfl_xor(v, 2); v += __shfl_xor(v, 4); v += __shfl_xor(v, 8); return v; }

template <int NCH> struct PoolVec;
template <> struct PoolVec<8> { typedef u32x4 T; static __device__ __forceinline__ T zero() { return (u32x4){0u, 0u, 0u, 0u}; }
    static __device__ __forceinline__ void unpack(const T r, float (&v)[8]) { unpack8(r, v); }
    static __device__ __forceinline__ T pack(const float (&v)[8]) { return pack8(v); } };
template <> struct PoolVec<4> { typedef u32x2 T; static __device__ __forceinline__ T zero() { return (u32x2){0u, 0u}; }
    static __device__ __forceinline__ void unpack(const T r, float (&v)[4]) { v[0] = bf_lo(r.x); v[1] = bf_hi(r.x); v[2] = bf_lo(r.y); v[3] = bf_hi(r.y); }
    static __device__ __forceinline__ T pack(const float (&v)[4]) { T o; o.x = cvt_pk_bf16(v[0], v[1]); o.y = cvt_pk_bf16(v[2], v[3]); return o; } };
template <int WIN, int NCH> __device__ __forceinline__ void pool_segment(const bf16_t* zp  , int posb, LAS unsigned char* dst  ) {
    typedef PoolVec<NCH> PV; typedef typename PV::T VT;
    constexpr int NR = 16 + WIN - 1;
    VT raw[NR];
#pragma unroll
    for (int i = 0; i < NR; ++i) { const int rel = i - (WIN - 1); const int relc = (posb + rel >= 0) ? rel : -posb;
        raw[i] = *(const VT*)(zp + (long)relc * EVEN_IN); }
#pragma unroll
    for (int i = 0; i < WIN - 1; ++i) { const int rel = i - (WIN - 1); if (posb + rel < 0) raw[i] = PV::zero(); }
    float s[NCH];
#pragma unroll
    for (int j = 0; j < NCH; ++j) s[j] = 0.f;
#pragma unroll
    for (int i = 0; i < WIN - 1; ++i) { float x[NCH]; PV::unpack(raw[i], x);
#pragma unroll
        for (int j = 0; j < NCH; ++j) s[j] += x[j]; }
#pragma unroll
    for (int i = 0; i < 16; ++i) {
        float x[NCH]; PV::unpack(raw[i + WIN - 1], x);
        const int pos = posb + i; const int cnt = (pos + 1 < WIN) ? pos + 1 : WIN; const float inv = 1.0f / (float)cnt;
        float o[NCH];
#pragma unroll
        for (int j = 0; j < NCH; ++j) { s[j] += x[j]; o[j] = s[j] * inv - x[j]; }
        *(LAS VT*)(dst + i * PL_STRIDE) = PV::pack(o);
        float y[NCH]; PV::unpack(raw[i], y);
#pragma unroll
        for (int j = 0; j < NCH; ++j) s[j] -= y[j];
    }
}

__device__ __forceinline__ void mixer_even(LAS unsigned char* lds, int vcu, int G, int wave_id) {
    const __attribute__((address_space(4))) Args& A = *fresh_args();
    int tid_ = phase_tid(wave_id);
    const int tid = tid_, lane = tid & 63, w = __builtin_amdgcn_readfirstlane(tid >> 6), fr = lane & 15, fq = lane >> 4;
    const bf16_t* Z = (const bf16_t*)(A.ws + WS_Z); bf16_t* Y = (bf16_t*)(A.ws + WS_Y);
    const bf16_t* Wm = (const bf16_t*)(A.ws + WS_WS); const bf16_t* WpT = (const bf16_t*)(A.ws + WS_WP);
    const int hg = w >> 1, dh = w & 1;
    for (int blk = vcu; blk < M_TOK / 128; blk += G) {
        const int row_base = blk * 128; const int pos_base = row_base & (SEQ - 1);
        {
            const int c = hg * 128 + 8 * fr, sg = dh * 4 + fq, ts = 16 * sg;
            const bf16_t* zp = Z + (size_t)(row_base + ts) * EVEN_IN + 1024 + c;
            LAS unsigned char* dst = lds + ts * PL_STRIDE + c * 2;
            if (hg == 0) pool_segment<2, 8>(zp, pos_base + ts, dst);
            else if (hg == 1) pool_segment<4, 8>(zp, pos_base + ts, dst);
            else if (hg == 2) pool_segment<8, 8>(zp, pos_base + ts, dst);
            else { pool_segment<16, 4>(zp, pos_base + ts, dst); pool_segment<16, 4>(zp + 4, pos_base + ts, dst + 8); }
        }
        bf16x8 wpf[4][4];
        { const bf16_t* WpT_ = WpT; OPAQUE_S(WpT_);
#pragma unroll
        for (int n = 0; n < 4; ++n)
#pragma unroll
            for (int ks = 0; ks < 4; ++ks) wpf[n][ks] = *(const bf16x8*)(WpT_ + ((size_t)(hg * 128 + dh * 64 + n * 16 + fr) * 128 + ks * 32 + 8 * fq)); }
        __syncthreads();
        {
            f32x4 sc[4]; const float* bsc = A.b_scale; OPAQUE_S(bsc);
#pragma unroll
            for (int n = 0; n < 4; ++n) sc[n] = *(const f32x4*)(bsc + hg * 128 + dh * 64 + n * 16 + 4 * fq);
#pragma unroll 2
            for (int m = 0; m < 8; ++m) {
                f32x4 acc[4];
#pragma unroll
                for (int n = 0; n < 4; ++n) acc[n] = (f32x4){0.f, 0.f, 0.f, 0.f};
#pragma unroll
                for (int ks = 0; ks < 4; ++ks) {
                    const bf16x8 pf = *(const LAS bf16x8*)(lds + (m * 16 + fr) * PL_STRIDE + (hg * 128 + ks * 32 + 8 * fq) * 2);
#pragma unroll
                    for (int n = 0; n < 4; ++n) acc[n] = __builtin_amdgcn_mfma_f32_16x16x32_bf16(wpf[n][ks], pf, acc[n], 0, 0, 0);
                }
                const size_t row = (size_t)(row_base + m * 16 + fr);
#pragma unroll
                for (int n = 0; n < 4; ++n) {
                    u32x2 o; o.x = cvt_pk_bf16(acc[n].x * sc[n].x, acc[n].y * sc[n].y); o.y = cvt_pk_bf16(acc[n].z * sc[n].z, acc[n].w * sc[n].w);
                    *(u32x2*)(Y + row * D + 512 + hg * 128 + dh * 64 + n * 16 + 4 * fq) = o;
                }
            }
        }
        __syncthreads();
        {
            u32x4 raw[4][4];
#pragma unroll
            for (int r = 0; r < 4; ++r)
#pragma unroll
                for (int j = 0; j < 4; ++j) raw[r][j] = *(const u32x4*)(Z + (size_t)(row_base + 16 * w + 4 * r + fq) * EVEN_IN + 512 + 128 * j + 8 * fr);
            float mu[4], rstd[4];
#pragma unroll
            for (int r = 0; r < 4; ++r) {
                float s = 0.f, q = 0.f;
#pragma unroll
                for (int j = 0; j < 4; ++j) { float v[8]; unpack8(raw[r][j], v);
#pragma unroll
                    for (int e = 0; e < 8; ++e) { s += v[e]; q += v[e] * v[e]; } }
                s = seg16_sum(s); q = seg16_sum(q);
                mu[r] = s * (1.0f / 512.0f); const float var = fmaxf(q * (1.0f / 512.0f) - mu[r] * mu[r], 0.f); rstd[r] = rsqrtf(var + EPS);
            }
            const float* lgp = A.a_ln_g; const float* lbp = A.a_ln_b; OPAQUE_S(lgp); OPAQUE_S(lbp);
#pragma unroll
            for (int j = 0; j < 4; ++j) {
                const f32x4 g0 = *(const f32x4*)(lgp + 128 * j + 8 * fr), g1 = *(const f32x4*)(lgp + 128 * j + 8 * fr + 4), b0 = *(const f32x4*)(lbp + 128 * j + 8 * fr), b1 = *(const f32x4*)(lbp + 128 * j + 8 * fr + 4);
#pragma unroll
                for (int r = 0; r < 4; ++r) {
                    float v[8], o[8]; unpack8(raw[r][j], v);
#pragma unroll
                    for (int e = 0; e < 4; ++e) { o[e] = (v[e] - mu[r]) * rstd[r] * g0[e] + b0[e]; o[4 + e] = (v[4 + e] - mu[r]) * rstd[r] * g1[e] + b1[e]; }
                    *(LAS u32x4*)(lds + (16 * w + 4 * r + fq) * VN_STRIDE + (128 * j + 8 * fr) * 2) = pack8(o);
                }
            }
        }
        __syncthreads();
        {
            const int h = hg;
            const int q4 = (lane >> 2) & 3, p4 = lane & 3;
            const LAS unsigned char* vbase = lds + (4 * fq + q4) * VN_STRIDE + (h * 128 + dh * 64 + 4 * p4) * 2;
#pragma unroll
            for (int mh = 0; mh < 2; ++mh) {
                u32x2 wlo[4][4], whi[4][4]; const bf16_t* Wm_ = Wm; OPAQUE_S(Wm_);
#pragma unroll
                for (int m = 0; m < 4; ++m)
#pragma unroll
                    for (int ks = 0; ks < 4; ++ks) {
                        if (mh == 0 && ks >= 2) continue;
                        const bf16_t* wp = Wm_ + ((size_t)(h * 128 + (4 * mh + m) * 16 + fr) * 128 + ks * 32 + 4 * fq);
                        wlo[m][ks] = *(const u32x2*)wp; whi[m][ks] = *(const u32x2*)(wp + 16);
                    }
                u32x2 ur[4][4]; const float* abs_ = A.a_b_s; OPAQUE_S(abs_);
#pragma unroll
                for (int m = 0; m < 4; ++m)
#pragma unroll
                    for (int n = 0; n < 4; ++n) ur[m][n] = *(const u32x2*)(Z + (size_t)(row_base + (4 * mh + m) * 16 + fr) * EVEN_IN + h * 128 + dh * 64 + n * 16 + 4 * fq);
                f32x4 acc[4][4];
#pragma unroll
                for (int m = 0; m < 4; ++m)
#pragma unroll
                    for (int n = 0; n < 4; ++n) acc[m][n] = (f32x4){0.f, 0.f, 0.f, 0.f};
#pragma unroll
                for (int ks = 0; ks < 4; ++ks) {
                    if (mh == 0 && ks >= 2) continue;
                    bf16x8 vf[4];
#pragma unroll
                    for (int n = 0; n < 4; ++n) {
                        const s16x4 lo = __builtin_amdgcn_ds_read_tr16_b64_v4i16((LAS s16x4*)(vbase + (ks * 32) * VN_STRIDE + n * 32));
                        const s16x4 hi = __builtin_amdgcn_ds_read_tr16_b64_v4i16((LAS s16x4*)(vbase + (ks * 32 + 16) * VN_STRIDE + n * 32));
                        vf[n] = (bf16x8){lo.x, lo.y, lo.z, lo.w, hi.x, hi.y, hi.z, hi.w};
                    }
#pragma unroll
                    for (int m = 0; m < 4; ++m) {
                        union { u32x4 u; bf16x8 b; } wf; wf.u = (u32x4){wlo[m][ks].x, wlo[m][ks].y, whi[m][ks].x, whi[m][ks].y};
#pragma unroll
                        for (int n = 0; n < 4; ++n) acc[m][n] = __builtin_amdgcn_mfma_f32_16x16x32_bf16(vf[n], wf.b, acc[m][n], 0, 0, 0);
                    }
                }
#pragma unroll
                for (int m = 0; m < 4; ++m) {
                    const int i = (4 * mh + m) * 16 + fr; const float bs = abs_[h * 128 + i]; const size_t row = (size_t)(row_base + i);
#pragma unroll
                    for (int n = 0; n < 4; ++n) {
                        const int d = h * 128 + dh * 64 + n * 16 + 4 * fq;
                        const f32x4 sv = acc[m][n];
                        u32x2 o; o.x = cvt_pk_bf16(bf_lo(ur[m][n].x) * (sv.x + bs), bf_hi(ur[m][n].x) * (sv.y + bs)); o.y = cvt_pk_bf16(bf_lo(ur[m][n].y) * (sv.z + bs), bf_hi(ur[m][n].y) * (sv.w + bs));
                        *(u32x2*)(Y + row * D + d) = o;
                    }
                }
            }
        }
        __syncthreads();
    }
}

template <int S, int T> __device__ __forceinline__ void conv_t(f32x2 (&acc)[32], const f32x2 (&wt)[31], const f32x2 hv) {
    if constexpr (T < 32) { if constexpr (S - T >= 0 && S - T <= 30) acc[T] = acc[T] + wt[S - T] * hv; conv_t<S, T + 1>(acc, wt, hv); }
}
template <int S> __device__ __forceinline__ void conv_s(f32x2 (&acc)[32], const f32x2 (&wt)[31], const LAS unsigned char* hp) {
    if constexpr (S < 62) {
        const unsigned hr = *(const LAS unsigned*)(hp + S * 1024);
        conv_t<S, 0>(acc, wt, (f32x2){bf_lo(hr), bf_hi(hr)});
        conv_s<S + 1>(acc, wt, hp);
    }
}
__device__ __forceinline__ void mixer_odd(LAS unsigned char* lds, int vcu, int G, int wave_id) {
    const __attribute__((address_space(4))) Args& A = *fresh_args();
    int tid_ = phase_tid(wave_id);
    const int tid = tid_, lane = tid & 63, w = __builtin_amdgcn_readfirstlane(tid >> 6), fr = lane & 15, fq = lane >> 4;
    const bf16_t* Z = (const bf16_t*)(A.ws + WS_Z); bf16_t* Y = (bf16_t*)(A.ws + WS_Y);
    constexpr int TT = 64, HALO = 30, HROWS = TT + HALO;
    const int tpv = (M_TOK / TT) / G, contig = (tpv * G == M_TOK / TT);
    for (int ti = 0; ti * G + vcu < M_TOK / TT; ++ti) {
        const int tile = contig ? vcu * tpv + ti : ti * G + vcu;
        const int t0 = tile * TT; const int pos0 = t0 & (SEQ - 1);
        for (int r = w; r < HROWS; r += NWAVES) {
            if (pos0 + r - HALO >= 0) __builtin_amdgcn_global_load_lds((const unsigned*)(Z + (size_t)(t0 + r - HALO) * EVEN_IN + 8 * lane), (LAS unsigned*)(lds + r * 1024), 16, 0, 0);
            else *(LAS u32x4*)(lds + r * 1024 + lane * 16) = (u32x4){0u, 0u, 0u, 0u};
        }
        asm volatile("s_waitcnt vmcnt(0)" ::: "memory");
        __syncthreads();
        const int cp = tid & 255, th = tid >> 8;
        f32x2 acc[32];
        {
            f32x2 wt[31];
            const float* cw = A.c_w_dw; OPAQUE_S(cw); const float* cb = A.c_b_dw; OPAQUE_S(cb);
            const float* wbase = cw + 2 * cp;
#pragma unroll
            for (int j = 0; j < 31; ++j) wt[j] = *(const f32x2*)(wbase + j * 512);
            const f32x2 bias = *(const f32x2*)(cb + 2 * cp);
#pragma unroll
            for (int t = 0; t < 32; ++t) acc[t] = bias;
            const LAS unsigned char* hp = lds + (32 * th) * 1024 + 4 * cp;
            conv_s<0>(acc, wt, hp);
        }
        __syncthreads();
#pragma unroll
        for (int t = 0; t < 32; ++t) *(LAS unsigned*)(lds + (32 * th + t) * 1024 + 4 * cp) = cvt_pk_bf16(acc[t].x, acc[t].y);
        {
            const int c8 = tid & 63, tg = tid >> 6;
            float w0[8], w1[8], w2[8];
            { const float* dw = A.d_w_dw; OPAQUE_S(dw); const float* wp = dw + 8 * c8;
              const f32x4 a0 = *(const f32x4*)wp, a1 = *(const f32x4*)(wp + 4), b0 = *(const f32x4*)(wp + 512), b1 = *(const f32x4*)(wp + 516), c0 = *(const f32x4*)(wp + 1024), c1 = *(const f32x4*)(wp + 1028);
#pragma unroll
              for (int j = 0; j < 4; ++j) { w0[j] = a0[j]; w0[4 + j] = a1[j]; w1[j] = b0[j]; w1[4 + j] = b1[j]; w2[j] = c0[j]; w2[4 + j] = c1[j]; } }
#pragma unroll 1
            for (int rd = 0; rd < 2; ++rd) {
                const int tk0 = 8 * tg + 4 * rd;
                const bf16_t* zp = Z + (size_t)(t0 + tk0) * EVEN_IN + 512 + 8 * c8;
                u32x4 rp[6], rb[4];
#pragma unroll
                for (int i = 0; i < 6; ++i) { const int rel = i - 2; const int relc = (pos0 + tk0 + rel >= 0) ? rel : 0;
                    rp[i] = *(const u32x4*)(zp + (long)relc * EVEN_IN);
                    if (pos0 + tk0 + rel < 0) rp[i] = (u32x4){0u, 0u, 0u, 0u}; }
#pragma unroll
                for (int i = 0; i < 4; ++i) rb[i] = *(const u32x4*)(zp + (long)i * EVEN_IN + 512);
                float p[6][8];
#pragma unroll
                for (int i = 0; i < 6; ++i) unpack8(rp[i], p[i]);
#pragma unroll
                for (int i = 0; i < 4; ++i) {
                    float bg[8], o[8]; unpack8(rb[i], bg);
#pragma unroll
                    for (int j = 0; j < 8; ++j) o[j] = bg[j] * (w0[j] * p[i][j] + w1[j] * p[i + 1][j] + w2[j] * p[i + 2][j]);
                    *(u32x4*)(Y + (size_t)(t0 + tk0 + i) * D + 512 + 8 * c8) = pack8(o);
                }
            }
        }
        __syncthreads();
        {
            f32x4 lg[4][2], lb[4][2]; const float* lgp = A.c_ln_g; const float* lbp = A.c_ln_b; OPAQUE_S(lgp); OPAQUE_S(lbp);
#pragma unroll
            for (int j = 0; j < 4; ++j) { lg[j][0] = *(const f32x4*)(lgp + 128 * j + 8 * fr); lg[j][1] = *(const f32x4*)(lgp + 128 * j + 8 * fr + 4);
                                          lb[j][0] = *(const f32x4*)(lbp + 128 * j + 8 * fr); lb[j][1] = *(const f32x4*)(lbp + 128 * j + 8 * fr + 4); }
#pragma unroll
            for (int r = 0; r < 2; ++r) {
                const int tok = 8 * w + 4 * r + fq;
                float v[4][8]; float s = 0.f, q = 0.f;
#pragma unroll
                for (int j = 0; j < 4; ++j) { unpack8(*(const LAS u32x4*)(lds + tok * 1024 + (128 * j + 8 * fr) * 2), v[j]);
#pragma unroll
                    for (int e = 0; e < 8; ++e) { s += v[j][e]; q += v[j][e] * v[j][e]; } }
                s = seg16_sum(s); q = seg16_sum(q);
                const float mu = s * (1.0f / 512.0f); const float var = fmaxf(q * (1.0f / 512.0f) - mu * mu, 0.f); const float rstd = rsqrtf(var + EPS);
#pragma unroll
                for (int j = 0; j < 4; ++j) {
                    float o[8];
#pragma unroll
                    for (int e = 0; e < 4; ++e) { o[e] = silu_f((v[j][e] - mu) * rstd * lg[j][0][e] + lb[j][0][e]); o[4 + e] = silu_f((v[j][4 + e] - mu) * rstd * lg[j][1][e] + lb[j][1][e]); }
                    *(u32x4*)(Y + (size_t)(t0 + tok) * D + 128 * j + 8 * fr) = pack8(o);
                }
            }
        }
        __syncthreads();
    }
}

__device__ __forceinline__ void final_norm(int vcu, int G, int wave_id) {
    const __attribute__((address_space(4))) Args& A = *fresh_args();
    int tid_ = phase_tid(wave_id);
    const int tid = tid_, lane = tid & 63, wave = __builtin_amdgcn_readfirstlane(tid >> 6);
    const int gw = vcu * NWAVES + wave, NGW = G * NWAVES;
    const float* ss = (const float*)(A.ws + WS_SS); const bf16_t* xb = (const bf16_t*)(A.ws + WS_XB);
    f32x4 gg[4];
#pragma unroll
    for (int j = 0; j < 4; ++j) gg[j] = *((const f32x4*)A.final_norm_g + 2 * lane + 128 * (j >> 1) + (j & 1));
    const int gpv = (M_TOK / 4) / G, contig = (gpv * G == M_TOK / 4) && (gpv % NWAVES == 0);
    for (int gi = 0; (gi * NGW + gw) * 4 < M_TOK; ++gi) {
        const int m0 = contig ? (vcu * gpv + gi * NWAVES + wave) * 4 : (gi * NGW + gw) * 4;
        float part[4]; u32x4 raw[4][2];
#pragma unroll
        for (int r = 0; r < 4; ++r) { part[r] = ss[(size_t)(m0 + r) * 16 + (lane & 15)];
            raw[r][0] = __builtin_nontemporal_load((const u32x4*)(xb + (size_t)(m0 + r) * D) + lane); raw[r][1] = __builtin_nontemporal_load((const u32x4*)(xb + (size_t)(m0 + r) * D) + lane + 64); }
#pragma unroll
        for (int r = 0; r < 4; ++r) {
            const float rs = rsqrtf(seg16_sum(part[r]) * (1.0f / 1024.0f) + EPS);
            f32x4* orow = (f32x4*)(A.out + (size_t)(m0 + r) * D);
#pragma unroll
            for (int hh = 0; hh < 2; ++hh) {
                float v[8]; unpack8(raw[r][hh], v);
                orow[128 * hh + 2 * lane] = (f32x4){v[0], v[1], v[2], v[3]} * rs * gg[2 * hh];
                orow[128 * hh + 2 * lane + 1] = (f32x4){v[4], v[5], v[6], v[7]} * rs * gg[2 * hh + 1];
            }
        }
    }
}

#ifndef PG8_SP2
#define PG8_SP2 true
#endif
#ifndef PG8_ALIGN
#define PG8_ALIGN true
#endif
__global__ void __launch_bounds__(NTHREADS, 2) trunk_fwd(Args args) {
    extern __shared__ __attribute__((aligned(16))) unsigned char lds_raw[];
    LAS unsigned char* lds = (LAS unsigned char*)lds_raw;
    const int G = gridDim.x, bx = blockIdx.x;
    const int wave_id = __builtin_amdgcn_readfirstlane(threadIdx.x >> 6);
    const int vcu = (G % 8 == 0) ? (bx % 8) * (G / 8) + bx / 8 : bx;
    const int lo = fresh_args()->ph_lo, hi = fresh_args()->ph_hi;
#define WSP(off) (fresh_args()->ws + (off))
#ifndef KIND_MASK
#define KIND_MASK 0xff
#endif
#define KIND(b) (((KIND_MASK) >> (b)) & 1)
#define IN(k) (lo <= (k) && (k) < hi)
#if USE_CG_SYNC
#define SEAM(k, loc, arr) do { if (IN(k) && IN((k) + 1)) { cg::this_grid().sync(); } } while (0)
#else
    if (threadIdx.x < 4) ((volatile LAS unsigned*)(lds + LDS_MISC_OFF))[threadIdx.x] = 0u;
    __syncthreads();
    XcdBarrier bar = xcd_barrier_post((unsigned*)WSP(WS_CTL) + CW_BAR, (volatile LAS unsigned*)(lds + LDS_MISC_OFF));
    if (lo < 0) cg::this_grid().sync();
#define SEAM(k, loc, arr) do { if (IN(k) && IN((k) + 1)) { xcd_barrier(bar, wave_id, (loc) ? lmode : 0u, (arr)); } } while (0)
#endif

    unsigned lmode = 0u; int bxv = bx, vcv = vcu;
    if (KIND(0) && IN(0)) { for (int rep = 0; rep < NREP(0); ++rep) p0_prologue(lds, vcu, G, wave_id); }
    SEAM(0, 0, 0u);
#if !USE_CG_SYNC
    if (IN(0) && IN(1)) {
        volatile LAS unsigned* st = (volatile LAS unsigned*)(lds + LDS_MISC_OFF);
        lmode = __builtin_amdgcn_readfirstlane(st[3]);
        if (lmode) { bxv = (int)__builtin_amdgcn_readfirstlane(st[2]) * 8 + (int)bar.x; vcv = (bxv % 8) * (G / 8) + bxv / 8; }
    }
#endif
#pragma unroll 1
    for (int layer = 0; layer < 2; ++layer) {
        const int pb = 1 + 5 * layer;
        if (KIND(1) && IN(pb + 0)) {
            const int N = layer ? ODD_IN : EVEN_IN;
            unsigned char* ws = WSP(0); pg8::Gemm g{(const bf16_t*)(ws + WS_XB), (const bf16_t*)(ws + (layer ? WS_WIN1 : WS_WIN0)), M_TOK, N, D}; pg8::StaticOrder S; S.init(M_TOK, N, G, bxv);
            pg8::EpiScaleBf16 E{(bf16_t*)(ws + WS_Z), layer, (const float*)(ws + WS_SS)};
            pg8::gemm_phase<pg8::EpiScaleBf16, PG8_ALIGN, PG8_SP2>(lds, g, S, E, wave_id, (lmode && layer) ? (unsigned*)ws + (WS_CTL / 4 + CW_BAR + XB_DONE_B) : nullptr, (unsigned)G);
        }
        SEAM(pb + 0, 0, 0u);
        if (IN(pb + 1)) { if (layer == 0) { if (KIND(2)) for (int rep = 0; rep < NREP(2); ++rep) mixer_even(lds, vcv, G, wave_id); } else { if (KIND(3)) for (int rep = 0; rep < NREP(3); ++rep) mixer_odd(lds, vcv, G, wave_id); } }
        SEAM(pb + 1, 1, 0u);
        if (KIND(4) && IN(pb + 2)) {
            unsigned char* ws = WSP(0); pg8::Gemm g{(const bf16_t*)(ws + WS_Y), (const bf16_t*)(ws + (layer ? WS_WOUT1 : WS_WOUT0)), M_TOK, D, D}; pg8::StaticOrder S; S.init(M_TOK, D, G, bxv);
            pg8::EpiResid E{(bf16_t*)(ws + WS_XB), (float*)(ws + WS_SS)};
            pg8::gemm_phase<pg8::EpiResid, PG8_ALIGN, PG8_SP2>(lds, g, S, E, wave_id);
        }
        SEAM(pb + 2, 1, XB_DONE_A);
        if (KIND(5) && IN(pb + 3)) {
            unsigned char* ws = WSP(0); pg8::Gemm g{(const bf16_t*)(ws + WS_XB), (const bf16_t*)(ws + (layer ? WS_WGU1 : WS_WGU0)), M_TOK, GU, D}; pg8::StaticOrder S; S.init(M_TOK, GU, G, bxv);
            pg8::EpiSwiGLU E{(bf16_t*)(ws + WS_ACT), (const float*)(ws + WS_SS)};
            pg8::gemm_phase<pg8::EpiSwiGLU, PG8_ALIGN, PG8_SP2>(lds, g, S, E, wave_id, lmode ? (unsigned*)ws + (WS_CTL / 4 + CW_BAR + XB_DONE_A) : nullptr, (unsigned)G * (unsigned)(layer + 1));
        }
        SEAM(pb + 3, 1, 0u);
        if (KIND(6) && IN(pb + 4)) {
            unsigned char* ws = WSP(0); pg8::Gemm g{(const bf16_t*)(ws + WS_ACT), (const bf16_t*)(ws + (layer ? WS_WDN1 : WS_WDN0)), M_TOK, D, DFF}; pg8::StaticOrder S; S.init(M_TOK, D, G, bxv);
            pg8::EpiResid E{(bf16_t*)(ws + WS_XB), (float*)(ws + WS_SS)};
            pg8::gemm_phase<pg8::EpiResid, PG8_ALIGN, PG8_SP2>(lds, g, S, E, wave_id);
        }
        SEAM(pb + 4, 1, layer ? 0u : XB_DONE_B);
    }
    if (KIND(7) && IN(11)) for (int rep = 0; rep < NREP(7); ++rep) final_norm(vcv, G, wave_id);
#undef IN
#undef SEAM
}

extern "C" void kernel_launch(void* const* d_in, const int* in_sizes, int n_in, void* d_out, int out_size, void* d_ws, size_t ws_size, hipStream_t stream) {
    static int grid = 0;
    if (grid == 0) {
        if (n_in != 22 || in_sizes[0] != M_TOK * D || out_size != M_TOK * D || ws_size < WS_END) {
            fprintf(stderr, "kernel_launch: unexpected shapes: n_in %d in0 %d out %d ws %zu (need %zu)\n", n_in, n_in > 0 ? in_sizes[0] : -1, out_size, ws_size, (size_t)WS_END); grid = -1; return; }
        int dev = 0, cus = 0, per_cu = 0;
        if (hipGetDevice(&dev) != hipSuccess || hipDeviceGetAttribute(&cus, hipDeviceAttributeMultiprocessorCount, dev) != hipSuccess) { fprintf(stderr, "kernel_launch: device query failed\n"); grid = -1; return; }
        if (hipFuncSetAttribute((const void*)trunk_fwd, hipFuncAttributeMaxDynamicSharedMemorySize, LDS_BYTES) != hipSuccess) { fprintf(stderr, "kernel_launch: hipFuncSetAttribute failed\n"); grid = -1; return; }
        if (hipOccupancyMaxActiveBlocksPerMultiprocessor(&per_cu, (const void*)trunk_fwd, NTHREADS, LDS_BYTES) != hipSuccess || per_cu < 1) { fprintf(stderr, "kernel_launch: occupancy query says %d blocks/CU\n", per_cu); per_cu = 1; }
        (void)hipGetLastError();
        grid = cus;
        fprintf(stderr, "kernel_launch: cus %d per_cu %d grid %d\n", cus, per_cu, grid);
    }
    if (grid < 0) return;
    Args a{};
    const float** f = (const float**)&a;
    for (int i = 0; i < 22; ++i) f[i] = (const float*)d_in[i];
    const size_t ws_off = ((ws_size - WS_END) / (2 * MiB)) * (2 * MiB);
    a.out = (float*)d_out; a.ws = (unsigned char*)d_ws + ws_off;
#if MK_PER_PHASE
    for (int p = 0; p < 12; ++p) {
        a.ph_lo = p; a.ph_hi = p + 1;
        for (int rep = 0; rep < 1 + ((PROBE_DUP >> p) & 1); ++rep)
            hipLaunchKernelGGL(trunk_fwd, dim3(grid), dim3(NTHREADS), LDS_BYTES, stream, a);
    }
#else
    a.ph_lo = 0; a.ph_hi = 12;
    if (hipMemsetAsync((char*)a.ws + WS_CTL, 0, 65536, stream) != hipSuccess) { fprintf(stderr, "kernel_launch: memset failed\n"); return; }
    void* kargs[] = {&a};
    hipError_t e = hipLaunchCooperativeKernel((const void*)trunk_fwd, dim3(grid), dim3(NTHREADS), kargs, LDS_BYTES, stream);
    if (e != hipSuccess) fprintf(stderr, "kernel_launch: cooperative launch failed: %s (grid %d)\n", hipGetErrorString(e), grid);
#endif
}
```

```cpp
#include <hip/hip_runtime.h>
#include <hip/hip_cooperative_groups.h>
#include <cstdio>
#include <cstdint>
namespace cg = cooperative_groups;

#ifndef MK_PER_PHASE
#define MK_PER_PHASE 0
#endif

#ifndef PROBE_DUPK
#define PROBE_DUPK 0
#endif
#define NREP(k) (1 + (((PROBE_DUPK) >> (k)) & 1))
#ifndef PROBE_DUP
#define PROBE_DUP 0
#endif

#define LAS __attribute__((address_space(3)))
typedef unsigned short bf16_t;
typedef short bf16x8 __attribute__((ext_vector_type(8)));
typedef short s16x4 __attribute__((ext_vector_type(4)));
typedef float f32x4 __attribute__((ext_vector_type(4)));
typedef float f32x2 __attribute__((ext_vector_type(2)));
typedef unsigned u32x4 __attribute__((ext_vector_type(4)));
typedef unsigned u32x2 __attribute__((ext_vector_type(2)));

constexpr int M_TOK = 32768, D = 1024, SEQ = 8192;
constexpr int EVEN_IN = 1536, ODD_IN = 2560, DFF = 2816, GU = 2 * DFF;
constexpr float EPS = 1e-6f;
constexpr int NWAVES = 8, NTHREADS = 512;

constexpr size_t MiB = 1u << 20;
constexpr size_t WS_CTL = 0, CTL_BYTES = 1 * MiB;
constexpr size_t WS_WIN0 = 2 * MiB, WS_WOUT0 = 5 * MiB, WS_WGU0 = 7 * MiB, WS_WDN0 = 18 * MiB;
constexpr size_t WS_WIN1 = 24 * MiB, WS_WOUT1 = 29 * MiB, WS_WGU1 = 31 * MiB, WS_WDN1 = 42 * MiB;
constexpr size_t WS_WS = 48 * MiB, WS_WP = 49 * MiB;
constexpr size_t WS_SS = 50 * MiB;
constexpr size_t WS_XB = 64 * MiB;
constexpr size_t WS_Z = 128 * MiB;
constexpr size_t WS_ACT = 128 * MiB;
constexpr size_t WS_Y = 224 * MiB;
constexpr size_t WS_END = 304 * MiB;

constexpr int LDS_BYTES = 155648;
constexpr int LDS_MISC_OFF = LDS_BYTES - 256;
constexpr int CW_BAR = 4096;
#ifndef USE_CG_SYNC
#define USE_CG_SYNC 0
#endif

__device__ __forceinline__ unsigned cvt_pk_bf16(float lo, float hi) { unsigned r; asm volatile("v_cvt_pk_bf16_f32 %0, %1, %2" : "=v"(r) : "v"(lo), "v"(hi)); return r; }
__device__ __forceinline__ unsigned long long opaque_uniform_u64(unsigned long long v) {
    unsigned lo = __builtin_amdgcn_readfirstlane((unsigned)v), hi = __builtin_amdgcn_readfirstlane((unsigned)(v >> 32));
    asm volatile("" : "+s"(lo), "+s"(hi));
    return ((unsigned long long)hi << 32) | lo;
}
template <class T> __device__ __forceinline__ T* opaque_uniform(T* p) { return (T*)opaque_uniform_u64((unsigned long long)p); }
#define OPAQUE_S(p) p = opaque_uniform(p)
__device__ __forceinline__ float bf_lo(unsigned u) { return __uint_as_float(u << 16); }
__device__ __forceinline__ float bf_hi(unsigned u) { return __uint_as_float(u & 0xffff0000u); }
__device__ __forceinline__ float wave_sum(float v) {
#pragma unroll
    for (int o = 1; o < 64; o <<= 1) v += __shfl_xor(v, o);
    return v;
}
__device__ __forceinline__ float sigmoid_f(float x) { return __builtin_amdgcn_rcpf(1.0f + __expf(-x)); }
__device__ __forceinline__ float silu_f(float x) { return x * sigmoid_f(x); }
__device__ __forceinline__ float gelu_tanh_f(float x) { const float u = 0.7978845608028654f * (x + 0.044715f * x * x * x); return x * sigmoid_f(2.0f * u); }
__device__ __forceinline__ f32x4 exp2_v4(const f32x4 t) { f32x4 e; e.x = __builtin_amdgcn_exp2f(t.x); e.y = __builtin_amdgcn_exp2f(t.y); e.z = __builtin_amdgcn_exp2f(t.z); e.w = __builtin_amdgcn_exp2f(t.w); return e; }
__device__ __forceinline__ f32x4 rcp_v4(const f32x4 d) { f32x4 r; r.x = __builtin_amdgcn_rcpf(d.x); r.y = __builtin_amdgcn_rcpf(d.y); r.z = __builtin_amdgcn_rcpf(d.z); r.w = __builtin_amdgcn_rcpf(d.w); return r; }
__device__ __forceinline__ f32x4 sigmoid_scaled_v4(const f32x4 x, const float c) { return rcp_v4(exp2_v4(x * c) + 1.0f); }
__device__ __forceinline__ f32x4 gelu_tanh_v4(const f32x4 x) {
    const f32x4 w = x * (x * x * 0.044715f + 1.0f);
    return x * rcp_v4(exp2_v4(w * -2.3022081986f) + 1.0f);
}
__device__ __forceinline__ void unpack8(const u32x4 r, float (&v)[8]) {
    v[0] = bf_lo(r.x); v[1] = bf_hi(r.x); v[2] = bf_lo(r.y); v[3] = bf_hi(r.y); v[4] = bf_lo(r.z); v[5] = bf_hi(r.z); v[6] = bf_lo(r.w); v[7] = bf_hi(r.w);
}
__device__ __forceinline__ u32x4 pack8(const float (&v)[8]) {
    u32x4 r; r.x = cvt_pk_bf16(v[0], v[1]); r.y = cvt_pk_bf16(v[2], v[3]); r.z = cvt_pk_bf16(v[4], v[5]); r.w = cvt_pk_bf16(v[6], v[7]); return r;
}
__device__ __forceinline__ float row_rstd(const float* ss, int row) {
    const f32x4* p = (const f32x4*)(ss + (size_t)row * 16);
    const f32x4 a = p[0], b = p[1], c = p[2], d = p[3];
    const f32x4 s = (a + b) + (c + d);
    return rsqrtf(((s.x + s.y) + (s.z + s.w)) * (1.0f / 1024.0f) + EPS);
}


__device__ __forceinline__ int phase_tid(int wave_id) {
    unsigned ones = ~0u; asm volatile("" : "+s"(ones));
    int t = wave_id * 64 + (int)__builtin_amdgcn_mbcnt_hi(ones, __builtin_amdgcn_mbcnt_lo(ones, 0u));
    asm volatile("" : "+v"(t)); return t;
}

typedef __attribute__((address_space(1))) unsigned gu32;
#define XB_TMO      128
#define XB_XCNT(j)  (256  + 64 * (j))
#define XB_XSUB(j)  (1280 + 64 * (j))
#define XB_XGEN(j)  (2304 + 64 * (j))
#define XB_TOP      3328
#define XB_TOPGEN   3392
#define XB_DONE_A   3456
#define XB_DONE_B   3520
#define XCD_BAR_WORDS 3584
#define XB_SPIN_CAP (1u << 18)
__device__ __forceinline__ unsigned xb_ld(unsigned* p)              { return __hip_atomic_load(p, __ATOMIC_RELAXED, __HIP_MEMORY_SCOPE_AGENT); }
__device__ __forceinline__ unsigned xb_add(unsigned* p, unsigned v) { return __hip_atomic_fetch_add(p, v, __ATOMIC_RELAXED, __HIP_MEMORY_SCOPE_AGENT); }
__device__ __forceinline__ unsigned xb_xcc_id() { return (unsigned)__builtin_amdgcn_s_getreg((3 << 11) | 20) & 0xFu; }
#define XB_SPIN(cond, bar) do { unsigned _sp = 0; while (cond) { __builtin_amdgcn_s_sleep(1); \
    if ((++_sp & 255u) == 0u) { if (xb_ld(&(bar)[XB_TMO])) break; if (_sp > XB_SPIN_CAP) { atomicAdd(&(bar)[XB_TMO], 1u); break; } } } } while (0)
struct XcdBarrier { unsigned* bar; unsigned x; volatile LAS unsigned* st; };
__device__ __forceinline__ XcdBarrier xcd_barrier_post(unsigned* bar, volatile LAS unsigned* st) {
    XcdBarrier b; b.bar = bar; b.x = xb_xcc_id(); b.st = st;
    if (threadIdx.x == 0) st[2] = xb_add(&bar[XB_XCNT(b.x)], 1u);
    return b;
}
__device__ __forceinline__ void xcd_barrier_complete(unsigned* bar, unsigned x, unsigned& nloc, unsigned& nx, unsigned& uni) {
    const unsigned G = gridDim.x * gridDim.y * gridDim.z;
    unsigned sum, cnt, mine, bad, sp = 0u;
    for (;;) {
        sum = 0u; cnt = 0u; mine = 0u; bad = 0u;
#pragma unroll
        for (unsigned j = 0; j < 16; ++j) { const unsigned c = xb_ld(&bar[XB_XCNT(j)]); sum += c; cnt += (c > 0u) ? 1u : 0u; mine = (j == x) ? c : mine; bad |= (c != 0u && c * 8u != G) ? 1u : 0u; }
        if (sum == G) break;
        __builtin_amdgcn_s_sleep(1);
        if ((++sp & 255u) == 0u) { if (xb_ld(&bar[XB_TMO])) break; if (sp > XB_SPIN_CAP) { atomicAdd(&bar[XB_TMO], 1u); break; } }
    }
    nloc = mine > 0u ? mine : 1u; nx = cnt > 0u ? cnt : 1u;
    uni = (sum == G && cnt == 8u && bad == 0u && x < 8u) ? 1u : 0u;
}
__device__ __forceinline__ void xcd_barrier_enter() { asm volatile("s_waitcnt vmcnt(0)" ::: "memory"); __syncthreads(); }
__device__ __forceinline__ void xcd_barrier_finish(const XcdBarrier& b, int wave_id, unsigned local = 0u, unsigned arrive = 0u) {
    unsigned ones = ~0u; asm volatile("" : "+s"(ones));
    if (wave_id == 0 && __builtin_amdgcn_mbcnt_hi(ones, __builtin_amdgcn_mbcnt_lo(ones, 0u)) == 0u) {
        unsigned* bar = b.bar;
        __builtin_amdgcn_s_waitcnt(0);
        unsigned nloc = b.st[0], nx = b.st[1];
        if (nloc == 0u) { unsigned uni; xcd_barrier_complete(bar, b.x, nloc, nx, uni); b.st[0] = nloc; b.st[1] = nx; b.st[3] = uni; }
        if (arrive) (void)xb_add(&bar[arrive], 1u);
        const unsigned old = xb_add(&bar[XB_XSUB(b.x)], 1u);
        const unsigned gen = old / nloc;
        if (old + 1u == (gen + 1u) * nloc) {
            if (!local) {
                __builtin_amdgcn_fence(__ATOMIC_RELEASE, "agent");
                asm volatile("s_waitcnt vmcnt(0)" ::: "memory");
                const unsigned og = xb_add(&bar[XB_TOP], 1u);
                const unsigned tg = og / nx;
                if (og + 1u == (tg + 1u) * nx) xb_add(&bar[XB_TOPGEN], 1u);
                else XB_SPIN(xb_ld(&bar[XB_TOPGEN]) == tg, bar);
            }
            __builtin_amdgcn_fence(__ATOMIC_ACQUIRE, "agent");
            xb_add(&bar[XB_XGEN(b.x)], 1u);
            asm volatile("s_waitcnt vmcnt(0)" ::: "memory");
        } else {
            XB_SPIN(xb_ld(&bar[XB_XGEN(b.x)]) == gen, bar);
            __builtin_amdgcn_fence(__ATOMIC_ACQUIRE, "agent");
            asm volatile("s_waitcnt vmcnt(0)" ::: "memory");
        }
    }
    __syncthreads();
}

__device__ __forceinline__ float row_sumsq_part(const float* ss, int row, int fq) { const f32x4 a = *(const f32x4*)(ss + (size_t)row * 16 + 4 * fq); return (a.x + a.y) + (a.z + a.w); }
__device__ __forceinline__ float rstd_from_part(float p) { p += __shfl_xor(p, 16); p += __shfl_xor(p, 32); return rsqrtf(p * (1.0f / 1024.0f) + EPS); }

namespace pg8 {
constexpr int BM = 256, BK = 64, HALF = 128, HTB = HALF * BK * 2, STAGE_BYTES = 8 * HTB, NXCD = 8, WGM = 4;
__device__ __forceinline__ int lds_byte(int r, int c) { const int st = (r >> 4) * 2 + (c >> 5), rr = r & 15, cc = c & 31, ob = rr * 64 + cc * 2; return st * 1024 + (ob ^ (((ob >> 9) & 1) << 5)); }
__device__ __forceinline__ void stage_rc(int b, int& R, int& C) { const int st = b / 1024, sb = b % 1024, swz = sb ^ (((sb >> 9) & 1) << 5); R = (st >> 1) * 16 + swz / 64; C = (st & 1) * 32 + (swz % 64) / 2; }
__device__ __forceinline__ int perm32(int rho) { const int n = rho >> 4, i = rho & 15; return 8 * (i >> 2) + 4 * n + (i & 3); }

struct Unit { int pm, pn; };
struct Gemm { const bf16_t* A; const bf16_t* Bt; int M, N, K; };

struct StaticOrder {
    int nM, nN, nwg, G, c;
    __device__ void init(int M, int N, int G_, int c_) { nM = M / BM; nN = N / BM; nwg = nM * nN; G = G_; c = c_; }
    __device__ bool next(int i, Unit& u) const {
        const long L = (long)i * G + c; if (L >= nwg) return false;
        int wgid = (int)L; { const int q = nwg / NXCD, r = nwg % NXCD, xcd = wgid % NXCD, off = wgid / NXCD; wgid = (xcd < r ? xcd * (q + 1) : r * (q + 1) + (xcd - r) * q) + off; }
        const int nig = WGM * nN, gid = wgid / nig, fm = gid * WGM, gsz = (nM - fm) < WGM ? (nM - fm) : WGM;
        u.pm = fm + ((wgid % nig) % gsz); u.pn = (wgid % nig) / gsz; return true;
    }
};

struct EpiScaleBf16 {
    static constexpr bool PERM = true, USES_RSTD = true;
    bf16_t* O; int odd; const float* ss;
    __device__ __forceinline__ void operator()(const f32x4 (&acc)[2][2][4][2], const Unit& u, int wr, int wc, int fr, int fq, const LAS float* rl) const {
        const int row0 = u.pm * BM + wr * 64 + fr;
        if (odd && u.pn < 8) {
            const bool glu = u.pn < 4;
            const int col0 = (glu ? 128 * u.pn : 512 + 128 * (u.pn - 4)) + wc * 32 + 8 * fq;
#pragma unroll
            for (int ai = 0; ai < 2; ++ai)
#pragma unroll
                for (int m = 0; m < 4; ++m) {
                    const int row = row0 + ai * HALF + m * 16; const float rs = rl[ai * HALF + wr * 64 + m * 16 + fr];
                    f32x4 o0, o1;
                    if (glu) {
                        const float c1 = -1.4426950408889634f * rs;
                        o0 = acc[ai][0][m][0] * (sigmoid_scaled_v4(acc[ai][1][m][0], c1) * rs); o1 = acc[ai][0][m][1] * (sigmoid_scaled_v4(acc[ai][1][m][1], c1) * rs);
                    } else {
                        const float rs2 = rs * rs;
                        o0 = (acc[ai][0][m][0] * acc[ai][1][m][0]) * rs2; o1 = (acc[ai][0][m][1] * acc[ai][1][m][1]) * rs2;
                    }
                    u32x4 w; w.x = cvt_pk_bf16(o0[0], o0[1]); w.y = cvt_pk_bf16(o0[2], o0[3]); w.z = cvt_pk_bf16(o1[0], o1[1]); w.w = cvt_pk_bf16(o1[2], o1[3]);
                    *(u32x4*)(O + (size_t)row * EVEN_IN + col0) = w;
                }
            return;
        }
        const int col0 = (odd ? 1024 + 256 * (u.pn - 8) : u.pn * BM) + wc * 32 + 8 * fq;
        const bool act = !odd && u.pn < 4;
#pragma unroll
        for (int ai = 0; ai < 2; ++ai)
#pragma unroll
            for (int m = 0; m < 4; ++m) {
                const int row = row0 + ai * HALF + m * 16; const float rs = rl[ai * HALF + wr * 64 + m * 16 + fr];
                bf16_t* rowp = O + (size_t)row * EVEN_IN + col0;
#pragma unroll
                for (int bj = 0; bj < 2; ++bj) {
                    f32x4 v0 = acc[ai][bj][m][0] * rs, v1 = acc[ai][bj][m][1] * rs;
                    if (act) { v0 = gelu_tanh_v4(v0); v1 = gelu_tanh_v4(v1); }
                    u32x4 w; w.x = cvt_pk_bf16(v0[0], v0[1]); w.y = cvt_pk_bf16(v0[2], v0[3]); w.z = cvt_pk_bf16(v1[0], v1[1]); w.w = cvt_pk_bf16(v1[2], v1[3]);
                    *(u32x4*)(rowp + bj * HALF) = w;
                }
            }
    }
};
struct EpiSwiGLU {
    static constexpr bool PERM = true, USES_RSTD = true;
    bf16_t* O; const float* ss;
    __device__ __forceinline__ void operator()(const f32x4 (&acc)[2][2][4][2], const Unit& u, int wr, int wc, int fr, int fq, const LAS float* rl) const {
        const int row0 = u.pm * BM + wr * 64 + fr, f0 = u.pn * HALF + wc * 32 + 8 * fq;
#pragma unroll
        for (int ai = 0; ai < 2; ++ai)
#pragma unroll
            for (int m = 0; m < 4; ++m) {
                const int row = row0 + ai * HALF + m * 16; const float rs = rl[ai * HALF + wr * 64 + m * 16 + fr];
                const float c1 = -1.4426950408889634f * rs, rs2 = rs * rs;
                const f32x4 a0 = (acc[ai][0][m][0] * acc[ai][1][m][0]) * (sigmoid_scaled_v4(acc[ai][0][m][0], c1) * rs2);
                const f32x4 a1 = (acc[ai][0][m][1] * acc[ai][1][m][1]) * (sigmoid_scaled_v4(acc[ai][0][m][1], c1) * rs2);
                u32x4 w; w.x = cvt_pk_bf16(a0[0], a0[1]); w.y = cvt_pk_bf16(a0[2], a0[3]); w.z = cvt_pk_bf16(a1[0], a1[1]); w.w = cvt_pk_bf16(a1[2], a1[3]);
                __builtin_nontemporal_store(w, (u32x4*)(O + (size_t)row * DFF + f0));
            }
    }
};
struct EpiResid {
    static constexpr bool PERM = true, USES_RSTD = false, OVERLAP = false;
    bf16_t* xb; float* ss;
    __device__ __forceinline__ void operator()(const f32x4 (&acc)[2][2][4][2], const Unit& u, int wr, int wc, int fr, int fq, const LAS float*) const {
        int lrow = wr * 64 + fr; asm volatile("" : "+v"(lrow));
        const int row0 = u.pm * BM + lrow, col0 = u.pn * BM + wc * 32 + 8 * fq;
        bf16_t* base = xb + (size_t)row0 * D + col0;
        u32x4 rv[2][4][2];
#pragma unroll
        for (int ai = 0; ai < 2; ++ai)
#pragma unroll
            for (int m = 0; m < 4; ++m)
#pragma unroll
                for (int bj = 0; bj < 2; ++bj) rv[ai][m][bj] = *(const u32x4*)(base + (size_t)(ai * HALF + m * 16) * D + bj * HALF);
#pragma unroll
        for (int ai = 0; ai < 2; ++ai)
#pragma unroll
            for (int m = 0; m < 4; ++m) {
                f32x4 q4 = (f32x4){0.f, 0.f, 0.f, 0.f};
#pragma unroll
                for (int bj = 0; bj < 2; ++bj) {
                    const u32x4 rw = rv[ai][m][bj];
                    const f32x4 h0 = (f32x4){bf_lo(rw.x), bf_hi(rw.x), bf_lo(rw.y), bf_hi(rw.y)} + acc[ai][bj][m][0];
                    const f32x4 h1 = (f32x4){bf_lo(rw.z), bf_hi(rw.z), bf_lo(rw.w), bf_hi(rw.w)} + acc[ai][bj][m][1];
                    q4 += h0 * h0 + h1 * h1;
                    u32x4 w; w.x = cvt_pk_bf16(h0.x, h0.y); w.y = cvt_pk_bf16(h0.z, h0.w); w.z = cvt_pk_bf16(h1.x, h1.y); w.w = cvt_pk_bf16(h1.z, h1.w);
                    *(u32x4*)(base + (size_t)(ai * HALF + m * 16) * D + bj * HALF) = w;
                }
                float q = (q4.x + q4.y) + (q4.z + q4.w);
                q += __shfl_xor(q, 16); q += __shfl_xor(q, 32);
                if (fq == 0) ss[(size_t)(row0 + ai * HALF + m * 16) * 16 + u.pn * 4 + wc] = q;
            }
    }
};

template <class Epi, bool ALIGN_EPI, bool SP2>
__device__ __forceinline__ void gemm_phase(LAS unsigned char* lds, const Gemm g, const StaticOrder& S, const Epi& E, int wave_id, unsigned* wait_ctr = nullptr, unsigned wait_val = 0u, bool bpre = false) {
    int tid_ = phase_tid(wave_id);
    const int tid = tid_, wid = __builtin_amdgcn_readfirstlane(tid >> 6), lane = tid & 63, wr = wid >> 2, wc = wid & 3, fr = lane & 15, fq = lane >> 4;
    const int K = g.K, nt = K / BK;
    unsigned voffA[2], voffB[2];
#pragma unroll
    for (int i = 0; i < 2; ++i) { int R, C; stage_rc(tid * 16 + i * 8192, R, C); const int Rb = Epi::PERM ? ((R & ~31) + perm32(R & 31)) : R;
        voffA[i] = (unsigned)(R * K + C) * 2u; voffB[i] = (unsigned)(Rb * K + C) * 2u; }
    const size_t kstep = (size_t)(BK * 2);
    const size_t hstep = (size_t)HALF * K * 2;
    const size_t tstep = 2 * hstep;
    const unsigned ldsw = (unsigned)wid * 1024u;
    const int aoff = lds_byte(wr * 64 + fr, fq * 8), boff = lds_byte(wc * 32 + fr, fq * 8);
#define PG8_SA(b, h) (((b) * 2 + (h)) * HTB)
#define PG8_SB(b, h) ((4 + (b) * 2 + (h)) * HTB)
#define PG8_STAGE(bufoff, gbase, voff) do { _Pragma("unroll") for (int _i = 0; _i < 2; ++_i) \
        __builtin_amdgcn_global_load_lds((const unsigned*)((const char*)(gbase) + (voff)[_i]), (LAS unsigned*)(lds + (bufoff) + ldsw + _i * 8192), 16, 0, 0); } while (0)
#define PG8_LDA(dst, b, h) do { _Pragma("unroll") for (int m = 0; m < 4; ++m) _Pragma("unroll") for (int k = 0; k < 2; ++k) dst[m][k] = *(const LAS bf16x8*)(lds + PG8_SA(b, h) + aoff + m * 2048 + k * 1024); } while (0)
#define PG8_LDB(dst, b, h) do { _Pragma("unroll") for (int n = 0; n < 2; ++n) _Pragma("unroll") for (int k = 0; k < 2; ++k) dst[n][k] = *(const LAS bf16x8*)(lds + PG8_SB(b, h) + boff + n * 2048 + k * 1024); } while (0)
#define PG8_MMA(ai, bj, At, Bt) do { __builtin_amdgcn_s_setprio(1); _Pragma("unroll") for (int m = 0; m < 4; ++m) _Pragma("unroll") for (int n = 0; n < 2; ++n) _Pragma("unroll") for (int k = 0; k < 2; ++k) \
        acc[ai][bj][m][n] = __builtin_amdgcn_mfma_f32_16x16x32_bf16(Bt[n][k], At[m][k], acc[ai][bj][m][n], 0, 0, 0); __builtin_amdgcn_s_setprio(0); } while (0)
#define PG8_WAIT_V(n) asm volatile("s_waitcnt vmcnt(" #n ")" ::: "memory")
#define PG8_WAIT_L(n) asm volatile("s_waitcnt lgkmcnt(" #n ")" ::: "memory")
#define PG8_BAR __builtin_amdgcn_s_barrier()
#define PG8_SCHED __builtin_amdgcn_sched_barrier(0)
    Unit cur, nxt; int ui = 0;
    if (!S.next(0, cur)) return;
#ifdef PROBE_STAGGER
    if (blockIdx.x & 8) { const unsigned long long t0 = __builtin_amdgcn_s_memrealtime(); while (__builtin_amdgcn_s_memrealtime() - t0 < PROBE_STAGGER) __builtin_amdgcn_s_sleep(8); }
#endif
    f32x4 acc[2][2][4][2];
#pragma unroll
    for (int a = 0; a < 2; ++a)
#pragma unroll
        for (int b = 0; b < 2; ++b)
#pragma unroll
            for (int m = 0; m < 4; ++m)
#pragma unroll
                for (int n = 0; n < 2; ++n) acc[a][b][m][n] = (f32x4){0.f, 0.f, 0.f, 0.f};
    bf16x8 At[4][2], B0[2][2], B1[2][2];
    const char* cA = (const char*)g.A + (size_t)cur.pm * tstep; const char* cB = (const char*)g.Bt + (size_t)cur.pn * tstep;
    if constexpr (SP2) {
        if (bpre) {
            PG8_STAGE(PG8_SA(0, 0), cA, voffA); PG8_STAGE(PG8_SA(0, 1), cA + hstep, voffA);
            if (wr == 1) PG8_BAR;
            PG8_WAIT_V(2); PG8_BAR;
            PG8_STAGE(PG8_SA(1, 0), cA + kstep, voffA);
            PG8_WAIT_V(2); PG8_BAR;
        } else {
        PG8_STAGE(PG8_SB(0, 0), cB, voffB); PG8_STAGE(PG8_SB(0, 1), cB + hstep, voffB); PG8_STAGE(PG8_SA(0, 0), cA, voffA); PG8_STAGE(PG8_SA(0, 1), cA + hstep, voffA);
        if (wr == 1) PG8_BAR;
        PG8_WAIT_V(2); PG8_BAR;
        PG8_STAGE(PG8_SB(1, 0), cB + kstep, voffB); PG8_STAGE(PG8_SA(1, 0), cA + kstep, voffA); PG8_STAGE(PG8_SB(1, 1), cB + hstep + kstep, voffB);
        PG8_WAIT_V(6); PG8_BAR;
        }
    } else {
        PG8_STAGE(PG8_SB(0, 0), cB, voffB); PG8_STAGE(PG8_SA(0, 0), cA, voffA); PG8_STAGE(PG8_SB(0, 1), cB + hstep, voffB); PG8_STAGE(PG8_SA(0, 1), cA + hstep, voffA);
        if (wr == 1) PG8_BAR;
        PG8_WAIT_V(4); PG8_BAR;
        PG8_STAGE(PG8_SB(1, 0), cB + kstep, voffB); PG8_STAGE(PG8_SA(1, 0), cA + kstep, voffA); PG8_STAGE(PG8_SB(1, 1), cB + hstep + kstep, voffB);
        PG8_WAIT_V(6); PG8_BAR;
    }
    LAS unsigned char* ssimg = lds + STAGE_BYTES;
    const LAS float* rstd_tab = (const LAS float*)(lds + STAGE_BYTES + 16384);
    for (;;) {
        const bool has_next = S.next(ui + 1, nxt);
        const char* nA = has_next ? (const char*)g.A + (size_t)nxt.pm * tstep : cA; const char* nB = has_next ? (const char*)g.Bt + (size_t)nxt.pn * tstep : cB;
        for (int t = 0; t < nt; t += 2) {
            const bool last = (t == nt - 2);
            const char* a1 = cA + (size_t)(t + 1) * kstep;
            const char* a2 = last ? nA : cA + (size_t)(t + 2) * kstep; const char* b2 = last ? nB : cB + (size_t)(t + 2) * kstep;
            const char* a3 = a2 + kstep; const char* b3 = b2 + kstep;
            if constexpr (Epi::USES_RSTD) { if (last) {
                unsigned loff = lane * 16; asm volatile("" : "+v"(loff));
                const char* sp = (const char*)E.ss + (size_t)cur.pm * 16384 + wid * 2048 + loff;
                __builtin_amdgcn_global_load_lds((const unsigned*)sp, (LAS unsigned*)(ssimg + wid * 2048), 16, 0, 0);
                __builtin_amdgcn_global_load_lds((const unsigned*)(sp + 1024), (LAS unsigned*)(ssimg + wid * 2048 + 1024), 16, 0, 0); } }
            if constexpr (SP2) {
            PG8_LDB(B0, 0, 0); PG8_LDB(B1, 0, 1); PG8_SCHED; PG8_LDA(At, 0, 0); PG8_STAGE(PG8_SA(1, 1), a1 + hstep, voffA);
            PG8_WAIT_V(8); PG8_WAIT_L(0); PG8_BAR; PG8_MMA(0, 0, At, B0); PG8_MMA(0, 1, At, B1); PG8_BAR; PG8_SCHED;
            PG8_LDA(At, 0, 1); PG8_STAGE(PG8_SB(0, 0), b2, voffB); PG8_STAGE(PG8_SB(0, 1), b2 + hstep, voffB); PG8_STAGE(PG8_SA(0, 0), a2, voffA);
            PG8_WAIT_V(8); PG8_WAIT_L(0); PG8_BAR; PG8_MMA(1, 0, At, B0); PG8_MMA(1, 1, At, B1); PG8_BAR; PG8_SCHED;
            PG8_LDB(B0, 1, 0); PG8_LDB(B1, 1, 1); PG8_SCHED; PG8_LDA(At, 1, 0); PG8_STAGE(PG8_SA(0, 1), a2 + hstep, voffA);
            PG8_WAIT_V(8); PG8_WAIT_L(0); PG8_BAR; PG8_MMA(0, 0, At, B0); PG8_MMA(0, 1, At, B1); PG8_BAR; PG8_SCHED;
            PG8_LDA(At, 1, 1); PG8_STAGE(PG8_SB(1, 0), b3, voffB); PG8_STAGE(PG8_SB(1, 1), b3 + hstep, voffB); PG8_STAGE(PG8_SA(1, 0), a3, voffA);
            PG8_WAIT_V(8); PG8_WAIT_L(0); PG8_BAR; PG8_MMA(1, 0, At, B0); PG8_MMA(1, 1, At, B1); PG8_BAR; PG8_SCHED;
            } else {
            PG8_LDB(B0, 0, 0); PG8_SCHED; PG8_LDA(At, 0, 0); PG8_STAGE(PG8_SA(1, 1), a1 + hstep, voffA);
            PG8_WAIT_L(8); PG8_BAR; PG8_WAIT_L(0); PG8_MMA(0, 0, At, B0); PG8_BAR; PG8_SCHED;
            PG8_LDB(B1, 0, 1); PG8_STAGE(PG8_SB(0, 0), b2, voffB);
            PG8_BAR; PG8_WAIT_L(0); PG8_MMA(0, 1, At, B1); PG8_BAR;
            PG8_LDA(At, 0, 1); PG8_STAGE(PG8_SA(0, 0), a2, voffA);
            PG8_BAR; PG8_WAIT_L(0); PG8_MMA(1, 0, At, B0); PG8_BAR; PG8_SCHED;
            PG8_STAGE(PG8_SB(0, 1), b2 + hstep, voffB);
            PG8_WAIT_V(6); PG8_BAR; PG8_MMA(1, 1, At, B1); PG8_BAR;
            PG8_LDB(B0, 1, 0); PG8_SCHED; PG8_LDA(At, 1, 0); PG8_STAGE(PG8_SA(0, 1), a2 + hstep, voffA);
            PG8_WAIT_L(8); PG8_BAR; PG8_WAIT_L(0); PG8_MMA(0, 0, At, B0); PG8_BAR; PG8_SCHED;
            PG8_LDB(B1, 1, 1); PG8_STAGE(PG8_SB(1, 0), b3, voffB);
            PG8_BAR; PG8_WAIT_L(0); PG8_MMA(0, 1, At, B1); PG8_BAR;
            PG8_LDA(At, 1, 1); PG8_STAGE(PG8_SA(1, 0), a3, voffA);
            PG8_BAR; PG8_WAIT_L(0); PG8_MMA(1, 0, At, B0); PG8_BAR; PG8_SCHED;
            PG8_STAGE(PG8_SB(1, 1), b3 + hstep, voffB);
            PG8_WAIT_V(6); PG8_BAR; PG8_MMA(1, 1, At, B1); PG8_BAR;
            }
        }
        if constexpr (Epi::USES_RSTD) {
            const LAS f32x4* sp = (const LAS f32x4*)(ssimg + tid * 32);
            const f32x4 sv = sp[0] + sp[1]; float p = (sv.x + sv.y) + (sv.z + sv.w); p += __shfl_xor(p, 1);
            if (!(tid & 1)) ((LAS float*)(lds + STAGE_BYTES + 16384))[tid >> 1] = rsqrtf(p * (1.0f / 1024.0f) + EPS);
        }
        if constexpr (ALIGN_EPI) { if (wr == 0) PG8_BAR; }
        if constexpr (Epi::USES_RSTD) {
            if (ui == 0 && wait_ctr != nullptr && tid == 0) {
                unsigned sp_ = 0u; while (xb_ld(wait_ctr) < wait_val) { __builtin_amdgcn_s_sleep(1); if (++sp_ > (XB_SPIN_CAP << 8)) break; } }
            PG8_WAIT_L(0); PG8_BAR; }
        E(acc, cur, wr, wc, fr, fq, rstd_tab);
        if (!has_next) break;
#pragma unroll
        for (int a = 0; a < 2; ++a)
#pragma unroll
            for (int b = 0; b < 2; ++b)
#pragma unroll
                for (int m = 0; m < 4; ++m)
#pragma unroll
                    for (int n = 0; n < 2; ++n) acc[a][b][m][n] = (f32x4){0.f, 0.f, 0.f, 0.f};
        cur = nxt; cA = nA; cB = nB; ++ui;
        if constexpr (ALIGN_EPI) { if (wr == 1) PG8_BAR; }
    }
    PG8_WAIT_V(0);
    if constexpr (!ALIGN_EPI) { if (wr == 0) PG8_BAR; }
    PG8_BAR;
#undef PG8_SA
#undef PG8_SB
#undef PG8_STAGE
#undef PG8_LDA
#undef PG8_LDB
#undef PG8_MMA
#undef PG8_WAIT_V
#undef PG8_WAIT_L
#undef PG8_BAR
#undef PG8_SCHED
}
__device__ __forceinline__ void gemm_prefetch_b(LAS unsigned char* lds, const bf16_t* Bt, int M, int N, int K, int G, int c, int wave_id) {
    int tid_ = phase_tid(wave_id);
    const int tid = tid_, wid = __builtin_amdgcn_readfirstlane(tid >> 6);
    unsigned voffB[2];
#pragma unroll
    for (int i = 0; i < 2; ++i) { int R, C; stage_rc(tid * 16 + i * 8192, R, C); const int Rb = (R & ~31) + perm32(R & 31); voffB[i] = (unsigned)(Rb * K + C) * 2u; }
    const size_t kstep = (size_t)(BK * 2), hstep = (size_t)HALF * K * 2, tstep = 2 * hstep;
    const unsigned ldsw = (unsigned)wid * 1024u;
    StaticOrder S; S.init(M, N, G, c); Unit u;
    if (!S.next(0, u)) return;
    const char* cB = (const char*)Bt + (size_t)u.pn * tstep;
#define PG8_PF(bufoff, gbase) do { _Pragma("unroll") for (int _i = 0; _i < 2; ++_i) \
        __builtin_amdgcn_global_load_lds((const unsigned*)((const char*)(gbase) + voffB[_i]), (LAS unsigned*)(lds + (bufoff) + ldsw + _i * 8192), 16, 0, 0); } while (0)
    PG8_PF((4 + 0) * HTB, cB); PG8_PF((4 + 1) * HTB, cB + hstep); PG8_PF((4 + 2) * HTB, cB + kstep); PG8_PF((4 + 3) * HTB, cB + hstep + kstep);
#undef PG8_PF
}
}

struct Args {
    const float* x; const float* even_w_in; const float* even_w_out; const float* a_w_s; const float* a_b_s; const float* a_ln_g; const float* a_ln_b;
    const float* b_w_pool; const float* b_scale; const float* odd_w_in; const float* odd_w_out; const float* c_w_dw; const float* c_b_dw; const float* c_ln_g; const float* c_ln_b;
    const float* d_w_dw; const float* norm_mix_g; const float* norm_ffn_g; const float* ffn_w_gate; const float* ffn_w_up; const float* ffn_w_down; const float* final_norm_g;
    float* out; unsigned char* ws; int ph_lo, ph_hi;
};

typedef const __attribute__((address_space(4))) Args* KArgsPtr;
__device__ __forceinline__ KArgsPtr fresh_args() { return (KArgsPtr)opaque_uniform_u64((unsigned long long)__builtin_amdgcn_kernarg_segment_ptr()); }

constexpr int P0_SCR_BYTES = 64 * 65 * 4;
__device__ __forceinline__ void p0_transpose_item(const float* W, int K, int N, bf16_t* WT, int grp, int gstride, int goff, const float* gk, LAS float* scr, int item, int lane, int oddmap = 0) {
    const int nblk = N / 64, kb = item / nblk, nb = item % nblk, k0 = 64 * kb, n0 = 64 * nb;
    const int lr = lane >> 4, lc = 4 * (lane & 15);
    f32x4 v[16];
#pragma unroll
    for (int i = 0; i < 16; ++i) v[i] = __builtin_nontemporal_load((const f32x4*)(W + (size_t)(k0 + 4 * i + lr) * N + n0 + lc));
#pragma unroll
    for (int i = 0; i < 16; ++i) { LAS float* p = scr + (4 * i + lr) * 65 + lc; p[0] = v[i].x; p[1] = v[i].y; p[2] = v[i].z; p[3] = v[i].w; }
    asm volatile("s_waitcnt lgkmcnt(0)" ::: "memory");
    const int c = lane & 7;
    float gv[8];
    if (gk) { const f32x4 g0 = *(const f32x4*)(gk + k0 + 8 * c), g1 = *(const f32x4*)(gk + k0 + 8 * c + 4);
#pragma unroll
        for (int j = 0; j < 4; ++j) { gv[j] = g0[j]; gv[4 + j] = g1[j]; } }
    else {
#pragma unroll
        for (int j = 0; j < 8; ++j) gv[j] = 1.0f; }
    int drow0 = (n0 / grp) * gstride + goff + (n0 % grp);
    if (oddmap) {
        const int seg = n0 >> 9, c0 = n0 & 511, pr = (c0 >> 7) * 256 + (c0 & 127);
        drow0 = seg == 0 ? pr : seg == 1 ? pr + 128 : seg == 2 ? 2048 + c0 : seg == 3 ? 1024 + pr : 1024 + pr + 128;
    }
#pragma unroll
    for (int j = 0; j < 8; ++j) { const int n = (lane >> 3) + 8 * j; const LAS float* s = scr + (8 * c) * 65 + n;
        float o[8];
#pragma unroll
        for (int e = 0; e < 8; ++e) o[e] = s[e * 65] * gv[e];
        __builtin_nontemporal_store(pack8(o), (u32x4*)(WT + (size_t)(drow0 + n) * K + k0 + 8 * c)); }
    asm volatile("s_waitcnt lgkmcnt(0)" ::: "memory");
}

__device__ __forceinline__ void p0_prologue(LAS unsigned char* lds, int vcu, int G, int wave_id) {
    const __attribute__((address_space(4))) Args& A = *fresh_args();
    int tid_ = phase_tid(wave_id);
    const int tid = tid_, lane = tid & 63, wave = __builtin_amdgcn_readfirstlane(tid >> 6);
    LAS float* scr = (LAS float*)(lds + wave * P0_SCR_BYTES);
    const int gw = vcu * NWAVES + wave, NGW = G * NWAVES;
    unsigned char* ws = A.ws;
    constexpr int I_IN0 = 16 * (EVEN_IN / 64), I_OUT = 16 * (D / 64), I_FF = 16 * (DFF / 64), I_DN = (DFF / 64) * (D / 64), I_IN1 = 16 * (ODD_IN / 64), I_WP = 2 * 2;
    constexpr int PER_LAYER_FFN = 2 * I_FF + I_DN;
    constexpr int NITEMS = I_IN0 + I_OUT + I_IN1 + I_OUT + 2 * PER_LAYER_FFN + 4 * I_WP;
    for (int it = gw; it < NITEMS; it += NGW) {
        int r = it;
        if (r < I_IN0) { p0_transpose_item(A.even_w_in, D, EVEN_IN, (bf16_t*)(ws + WS_WIN0), EVEN_IN, 0, 0, A.norm_mix_g, scr, r, lane); continue; } r -= I_IN0;
        if (r < I_OUT) { p0_transpose_item(A.even_w_out, D, D, (bf16_t*)(ws + WS_WOUT0), D, 0, 0, nullptr, scr, r, lane); continue; } r -= I_OUT;
        if (r < I_IN1) { p0_transpose_item(A.odd_w_in, D, ODD_IN, (bf16_t*)(ws + WS_WIN1), ODD_IN, 0, 0, A.norm_mix_g + D, scr, r, lane, 1); continue; } r -= I_IN1;
        if (r < I_OUT) { p0_transpose_item(A.odd_w_out, D, D, (bf16_t*)(ws + WS_WOUT1), D, 0, 0, nullptr, scr, r, lane); continue; } r -= I_OUT;
        if (r < 2 * PER_LAYER_FFN) {
            const int layer = r / PER_LAYER_FFN; r -= layer * PER_LAYER_FFN;
            bf16_t* wgu = (bf16_t*)(ws + (layer ? WS_WGU1 : WS_WGU0)); bf16_t* wdn = (bf16_t*)(ws + (layer ? WS_WDN1 : WS_WDN0));
            const float* gk = A.norm_ffn_g + layer * D;
            if (r < I_FF) { p0_transpose_item(A.ffn_w_gate + (size_t)layer * D * DFF, D, DFF, wgu, 128, 256, 0, gk, scr, r, lane); continue; } r -= I_FF;
            if (r < I_FF) { p0_transpose_item(A.ffn_w_up + (size_t)layer * D * DFF, D, DFF, wgu, 128, 256, 128, gk, scr, r, lane); continue; } r -= I_FF;
            p0_transpose_item(A.ffn_w_down + (size_t)layer * DFF * D, DFF, D, wdn, D, 0, 0, nullptr, scr, r, lane); continue;
        }
        r -= 2 * PER_LAYER_FFN;
        { const int g = r / I_WP; r -= g * I_WP;
          p0_transpose_item(A.b_w_pool + (size_t)g * 128 * 128, 128, 128, (bf16_t*)(ws + WS_WP) + (size_t)g * 128 * 128, 128, 0, 0, nullptr, scr, r, lane); }
    }
    { bf16_t* wm = (bf16_t*)(ws + WS_WS);
      for (int e = (vcu * NTHREADS + tid) * 2; e < 4 * 128 * 128; e += G * NTHREADS * 2) {
          const int i = (e >> 7) & 127, j = e & 127; const bool keep = (i >> 6) >= (j >> 6);
          const float a = keep ? A.a_w_s[e] : 0.f, b = keep ? A.a_w_s[e + 1] : 0.f;
          *(unsigned*)(wm + e) = cvt_pk_bf16(a, b); } }
    { bf16_t* xb = (bf16_t*)(ws + WS_XB); float* ss = (float*)(ws + WS_SS);
      for (int m0 = gw * 4; m0 < M_TOK; m0 += NGW * 4) {
          f32x4 v[4][4];
#pragma unroll
          for (int r = 0; r < 4; ++r)
#pragma unroll
              for (int j = 0; j < 4; ++j) v[r][j] = __builtin_nontemporal_load((const f32x4*)(A.x + (size_t)(m0 + r) * D) + lane + 64 * j);
#pragma unroll
          for (int r = 0; r < 4; ++r) {
              float s = 0.f;
#pragma unroll
              for (int j = 0; j < 4; ++j) s += (v[r][j].x * v[r][j].x + v[r][j].y * v[r][j].y) + (v[r][j].z * v[r][j].z + v[r][j].w * v[r][j].w);
              s = wave_sum(s);
              u32x2* o8 = (u32x2*)(xb + (size_t)(m0 + r) * D) + lane;
#pragma unroll
              for (int j = 0; j < 4; ++j) { u32x2 w; w.x = cvt_pk_bf16(v[r][j].x, v[r][j].y); w.y = cvt_pk_bf16(v[r][j].z, v[r][j].w); o8[64 * j] = w; }
              if (lane < 4) { f32x4 t = (f32x4){0.f, 0.f, 0.f, 0.f}; if (lane == 0) t.x = s; *((f32x4*)(ss + (size_t)(m0 + r) * 16) + lane) = t; }
          }
      } }
}

constexpr int VN_STRIDE = 1056;
constexpr int PL_STRIDE = 1040;
__device__ __forceinline__ float seg16_sum(float v) { v += __shfl_xor(v, 1); v += __shfl_xor(v, 2); v += __shfl_xor(v, 4); v += __shfl_xor(v, 8); return v; }

template <int NCH> struct PoolVec;
template <> struct PoolVec<8> { typedef u32x4 T; static __device__ __forceinline__ T zero() { return (u32x4){0u, 0u, 0u, 0u}; }
    static __device__ __forceinline__ void unpack(const T r, float (&v)[8]) { unpack8(r, v); }
    static __device__ __forceinline__ T pack(const float (&v)[8]) { return pack8(v); } };
template <> struct PoolVec<4> { typedef u32x2 T; static __device__ __forceinline__ T zero() { return (u32x2){0u, 0u}; }
    static __device__ __forceinline__ void unpack(const T r, float (&v)[4]) { v[0] = bf_lo(r.x); v[1] = bf_hi(r.x); v[2] = bf_lo(r.y); v[3] = bf_hi(r.y); }
    static __device__ __forceinline__ T pack(const float (&v)[4]) { T o; o.x = cvt_pk_bf16(v[0], v[1]); o.y = cvt_pk_bf16(v[2], v[3]); return o; } };
template <int WIN, int NCH> __device__ __forceinline__ void pool_segment(const bf16_t* zp  , int posb, LAS unsigned char* dst  ) {
    typedef PoolVec<NCH> PV; typedef typename PV::T VT;
    constexpr int NR = 16 + WIN - 1;
    VT raw[NR];
#pragma unroll
    for (int i = 0; i < NR; ++i) { const int rel = i - (WIN - 1); const int relc = (posb + rel >= 0) ? rel : -posb;
        raw[i] = *(const VT*)(zp + (long)relc * EVEN_IN); }
#pragma unroll
    for (int i = 0; i < WIN - 1; ++i) { const int rel = i - (WIN - 1); if (posb + rel < 0) raw[i] = PV::zero(); }
    float s[NCH];
#pragma unroll
    for (int j = 0; j < NCH; ++j) s[j] = 0.f;
#pragma unroll
    for (int i = 0; i < WIN - 1; ++i) { float x[NCH]; PV::unpack(raw[i], x);
#pragma unroll
        for (int j = 0; j < NCH; ++j) s[j] += x[j]; }
#pragma unroll
    for (int i = 0; i < 16; ++i) {
        float x[NCH]; PV::unpack(raw[i + WIN - 1], x);
        const int pos = posb + i; const int cnt = (pos + 1 < WIN) ? pos + 1 : WIN; const float inv = 1.0f / (float)cnt;
        float o[NCH];
#pragma unroll
        for (int j = 0; j < NCH; ++j) { s[j] += x[j]; o[j] = s[j] * inv - x[j]; }
        *(LAS VT*)(dst + i * PL_STRIDE) = PV::pack(o);
        float y[NCH]; PV::unpack(raw[i], y);
#pragma unroll
        for (int j = 0; j < NCH; ++j) s[j] -= y[j];
    }
}

__device__ __forceinline__ void mixer_even(LAS unsigned char* lds, int vcu, int G, int wave_id) {
    const __attribute__((address_space(4))) Args& A = *fresh_args();
    int tid_ = phase_tid(wave_id);
    const int tid = tid_, lane = tid & 63, w = __builtin_amdgcn_readfirstlane(tid >> 6), fr = lane & 15, fq = lane >> 4;
    const bf16_t* Z = (const bf16_t*)(A.ws + WS_Z); bf16_t* Y = (bf16_t*)(A.ws + WS_Y);
    const bf16_t* Wm = (const bf16_t*)(A.ws + WS_WS); const bf16_t* WpT = (const bf16_t*)(A.ws + WS_WP);
    const int hg = w >> 1, dh = w & 1;
    for (int blk = vcu; blk < M_TOK / 128; blk += G) {
        const int row_base = blk * 128; const int pos_base = row_base & (SEQ - 1);
        {
            const int c = hg * 128 + 8 * fr, sg = dh * 4 + fq, ts = 16 * sg;
            const bf16_t* zp = Z + (size_t)(row_base + ts) * EVEN_IN + 1024 + c;
            LAS unsigned char* dst = lds + ts * PL_STRIDE + c * 2;
            if (hg == 0) pool_segment<2, 8>(zp, pos_base + ts, dst);
            else if (hg == 1) pool_segment<4, 8>(zp, pos_base + ts, dst);
            else if (hg == 2) pool_segment<8, 8>(zp, pos_base + ts, dst);
            else { pool_segment<16, 4>(zp, pos_base + ts, dst); pool_segment<16, 4>(zp + 4, pos_base + ts, dst + 8); }
        }
        bf16x8 wpf[4][4];
        { const bf16_t* WpT_ = WpT; OPAQUE_S(WpT_);
#pragma unroll
        for (int n = 0; n < 4; ++n)
#pragma unroll
            for (int ks = 0; ks < 4; ++ks) wpf[n][ks] = *(const bf16x8*)(WpT_ + ((size_t)(hg * 128 + dh * 64 + n * 16 + fr) * 128 + ks * 32 + 8 * fq)); }
        __syncthreads();
        {
            f32x4 sc[4]; const float* bsc = A.b_scale; OPAQUE_S(bsc);
#pragma unroll
            for (int n = 0; n < 4; ++n) sc[n] = *(const f32x4*)(bsc + hg * 128 + dh * 64 + n * 16 + 4 * fq);
#pragma unroll 2
            for (int m = 0; m < 8; ++m) {
                f32x4 acc[4];
#pragma unroll
                for (int n = 0; n < 4; ++n) acc[n] = (f32x4){0.f, 0.f, 0.f, 0.f};
#pragma unroll
                for (int ks = 0; ks < 4; ++ks) {
                    const bf16x8 pf = *(const LAS bf16x8*)(lds + (m * 16 + fr) * PL_STRIDE + (hg * 128 + ks * 32 + 8 * fq) * 2);
#pragma unroll
                    for (int n = 0; n < 4; ++n) acc[n] = __builtin_amdgcn_mfma_f32_16x16x32_bf16(wpf[n][ks], pf, acc[n], 0, 0, 0);
                }
                const size_t row = (size_t)(row_base + m * 16 + fr);
#pragma unroll
                for (int n = 0; n < 4; ++n) {
                    u32x2 o; o.x = cvt_pk_bf16(acc[n].x * sc[n].x, acc[n].y * sc[n].y); o.y = cvt_pk_bf16(acc[n].z * sc[n].z, acc[n].w * sc[n].w);
                    *(u32x2*)(Y + row * D + 512 + hg * 128 + dh * 64 + n * 16 + 4 * fq) = o;
                }
            }
        }
        __syncthreads();
        {
            u32x4 raw[4][4];
#pragma unroll
            for (int r = 0; r < 4; ++r)
#pragma unroll
                for (int j = 0; j < 4; ++j) raw[r][j] = *(const u32x4*)(Z + (size_t)(row_base + 16 * w + 4 * r + fq) * EVEN_IN + 512 + 128 * j + 8 * fr);
            float mu[4], rstd[4];
#pragma unroll
            for (int r = 0; r < 4; ++r) {
                float s = 0.f, q = 0.f;
#pragma unroll
                for (int j = 0; j < 4; ++j) { float v[8]; unpack8(raw[r][j], v);
#pragma unroll
                    for (int e = 0; e < 8; ++e) { s += v[e]; q += v[e] * v[e]; } }
                s = seg16_sum(s); q = seg16_sum(q);
                mu[r] = s * (1.0f / 512.0f); const float var = fmaxf(q * (1.0f / 512.0f) - mu[r] * mu[r], 0.f); rstd[r] = rsqrtf(var + EPS);
            }
            const float* lgp = A.a_ln_g; const float* lbp = A.a_ln_b; OPAQUE_S(lgp); OPAQUE_S(lbp);
#pragma unroll
            for (int j = 0; j < 4; ++j) {
                const f32x4 g0 = *(const f32x4*)(lgp + 128 * j + 8 * fr), g1 = *(const f32x4*)(lgp + 128 * j + 8 * fr + 4), b0 = *(const f32x4*)(lbp + 128 * j + 8 * fr), b1 = *(const f32x4*)(lbp + 128 * j + 8 * fr + 4);
#pragma unroll
                for (int r = 0; r < 4; ++r) {
                    float v[8], o[8]; unpack8(raw[r][j], v);
#pragma unroll
                    for (int e = 0; e < 4; ++e) { o[e] = (v[e] - mu[r]) * rstd[r] * g0[e] + b0[e]; o[4 + e] = (v[4 + e] - mu[r]) * rstd[r] * g1[e] + b1[e]; }
                    *(LAS u32x4*)(lds + (16 * w + 4 * r + fq) * VN_STRIDE + (128 * j + 8 * fr) * 2) = pack8(o);
                }
            }
        }
        __syncthreads();
        {
            const int h = hg;
            const int q4 = (lane >> 2) & 3, p4 = lane & 3;
            const LAS unsigned char* vbase = lds + (4 * fq + q4) * VN_STRIDE + (h * 128 + dh * 64 + 4 * p4) * 2;
#pragma unroll
            for (int mh = 0; mh < 2; ++mh) {
                u32x2 wlo[4][4], whi[4][4]; const bf16_t* Wm_ = Wm; OPAQUE_S(Wm_);
#pragma unroll
                for (int m = 0; m < 4; ++m)
#pragma unroll
                    for (int ks = 0; ks < 4; ++ks) {
                        if (mh == 0 && ks >= 2) continue;
                        const bf16_t* wp = Wm_ + ((size_t)(h * 128 + (4 * mh + m) * 16 + fr) * 128 + ks * 32 + 4 * fq);
                        wlo[m][ks] = *(const u32x2*)wp; whi[m][ks] = *(const u32x2*)(wp + 16);
                    }
                u32x2 ur[4][4]; const float* abs_ = A.a_b_s; OPAQUE_S(abs_);
#pragma unroll
                for (int m = 0; m < 4; ++m)
#pragma unroll
                    for (int n = 0; n < 4; ++n) ur[m][n] = *(const u32x2*)(Z + (size_t)(row_base + (4 * mh + m) * 16 + fr) * EVEN_IN + h * 128 + dh * 64 + n * 16 + 4 * fq);
                f32x4 acc[4][4];
#pragma unroll
                for (int m = 0; m < 4; ++m)
#pragma unroll
                    for (int n = 0; n < 4; ++n) acc[m][n] = (f32x4){0.f, 0.f, 0.f, 0.f};
#pragma unroll
                for (int ks = 0; ks < 4; ++ks) {
                    if (mh == 0 && ks >= 2) continue;
                    bf16x8 vf[4];
#pragma unroll
                    for (int n = 0; n < 4; ++n) {
                        const s16x4 lo = __builtin_amdgcn_ds_read_tr16_b64_v4i16((LAS s16x4*)(vbase + (ks * 32) * VN_STRIDE + n * 32));
                        const s16x4 hi = __builtin_amdgcn_ds_read_tr16_b64_v4i16((LAS s16x4*)(vbase + (ks * 32 + 16) * VN_STRIDE + n * 32));
                        vf[n] = (bf16x8){lo.x, lo.y, lo.z, lo.w, hi.x, hi.y, hi.z, hi.w};
                    }
#pragma unroll
                    for (int m = 0; m < 4; ++m) {
                        union { u32x4 u; bf16x8 b; } wf; wf.u = (u32x4){wlo[m][ks].x, wlo[m][ks].y, whi[m][ks].x, whi[m][ks].y};
#pragma unroll
                        for (int n = 0; n < 4; ++n) acc[m][n] = __builtin_amdgcn_mfma_f32_16x16x32_bf16(vf[n], wf.b, acc[m][n], 0, 0, 0);
                    }
                }
#pragma unroll
                for (int m = 0; m < 4; ++m) {
                    const int i = (4 * mh + m) * 16 + fr; const float bs = abs_[h * 128 + i]; const size_t row = (size_t)(row_base + i);
#pragma unroll
                    for (int n = 0; n < 4; ++n) {
                        const int d = h * 128 + dh * 64 + n * 16 + 4 * fq;
                        const f32x4 sv = acc[m][n];
                        u32x2 o; o.x = cvt_pk_bf16(bf_lo(ur[m][n].x) * (sv.x + bs), bf_hi(ur[m][n].x) * (sv.y + bs)); o.y = cvt_pk_bf16(bf_lo(ur[m][n].y) * (sv.z + bs), bf_hi(ur[m][n].y) * (sv.w + bs));
                        *(u32x2*)(Y + row * D + d) = o;
                    }
                }
            }
        }
        __syncthreads();
    }
}

template <int S, int T> __device__ __forceinline__ void conv_t(f32x2 (&acc)[32], const f32x2 (&wt)[31], const f32x2 hv) {
    if constexpr (T < 32) { if constexpr (S - T >= 0 && S - T <= 30) acc[T] = acc[T] + wt[S - T] * hv; conv_t<S, T + 1>(acc, wt, hv); }
}
template <int S> __device__ __forceinline__ void conv_s(f32x2 (&acc)[32], const f32x2 (&wt)[31], const LAS unsigned char* hp) {
    if constexpr (S < 62) {
        const unsigned hr = *(const LAS unsigned*)(hp + S * 1024);
        conv_t<S, 0>(acc, wt, (f32x2){bf_lo(hr), bf_hi(hr)});
        conv_s<S + 1>(acc, wt, hp);
    }
}
__device__ __forceinline__ void mixer_odd(LAS unsigned char* lds, int vcu, int G, int wave_id) {
    const __attribute__((address_space(4))) Args& A = *fresh_args();
    int tid_ = phase_tid(wave_id);
    const int tid = tid_, lane = tid & 63, w = __builtin_amdgcn_readfirstlane(tid >> 6), fr = lane & 15, fq = lane >> 4;
    const bf16_t* Z = (const bf16_t*)(A.ws + WS_Z); bf16_t* Y = (bf16_t*)(A.ws + WS_Y);
    constexpr int TT = 64, HALO = 30, HROWS = TT + HALO;
    const int tpv = (M_TOK / TT) / G, contig = (tpv * G == M_TOK / TT);
    for (int ti = 0; ti * G + vcu < M_TOK / TT; ++ti) {
        const int tile = contig ? vcu * tpv + ti : ti * G + vcu;
        const int t0 = tile * TT; const int pos0 = t0 & (SEQ - 1);
        for (int r = w; r < HROWS; r += NWAVES) {
            if (pos0 + r - HALO >= 0) __builtin_amdgcn_global_load_lds((const unsigned*)(Z + (size_t)(t0 + r - HALO) * EVEN_IN + 8 * lane), (LAS unsigned*)(lds + r * 1024), 16, 0, 0);
            else *(LAS u32x4*)(lds + r * 1024 + lane * 16) = (u32x4){0u, 0u, 0u, 0u};
        }
        asm volatile("s_waitcnt vmcnt(0)" ::: "memory");
        __syncthreads();
        const int cp = tid & 255, th = tid >> 8;
        f32x2 acc[32];
        {
            f32x2 wt[31];
            const float* cw = A.c_w_dw; OPAQUE_S(cw); const float* cb = A.c_b_dw; OPAQUE_S(cb);
            const float* wbase = cw + 2 * cp;
#pragma unroll
            for (int j = 0; j < 31; ++j) wt[j] = *(const f32x2*)(wbase + j * 512);
            const f32x2 bias = *(const f32x2*)(cb + 2 * cp);
#pragma unroll
            for (int t = 0; t < 32; ++t) acc[t] = bias;
            const LAS unsigned char* hp = lds + (32 * th) * 1024 + 4 * cp;
            conv_s<0>(acc, wt, hp);
        }
        __syncthreads();
#pragma unroll
        for (int t = 0; t < 32; ++t) *(LAS unsigned*)(lds + (32 * th + t) * 1024 + 4 * cp) = cvt_pk_bf16(acc[t].x, acc[t].y);
        {
            const int c8 = tid & 63, tg = tid >> 6;
            float w0[8], w1[8], w2[8];
            { const float* dw = A.d_w_dw; OPAQUE_S(dw); const float* wp = dw + 8 * c8;
              const f32x4 a0 = *(const f32x4*)wp, a1 = *(const f32x4*)(wp + 4), b0 = *(const f32x4*)(wp + 512), b1 = *(const f32x4*)(wp + 516), c0 = *(const f32x4*)(wp + 1024), c1 = *(const f32x4*)(wp + 1028);
#pragma unroll
              for (int j = 0; j < 4; ++j) { w0[j] = a0[j]; w0[4 + j] = a1[j]; w1[j] = b0[j]; w1[4 + j] = b1[j]; w2[j] = c0[j]; w2[4 + j] = c1[j]; } }
#pragma unroll 1
            for (int rd = 0; rd < 2; ++rd) {
                const int tk0 = 8 * tg + 4 * rd;
                const bf16_t* zp = Z + (size_t)(t0 + tk0) * EVEN_IN + 512 + 8 * c8;
                u32x4 rp[6], rb[4];
#pragma unroll
                for (int i = 0; i < 6; ++i) { const int rel = i - 2; const int relc = (pos0 + tk0 + rel >= 0) ? rel : 0;
                    rp[i] = *(const u32x4*)(zp + (long)relc * EVEN_IN);
                    if (pos0 + tk0 + rel < 0) rp[i] = (u32x4){0u, 0u, 0u, 0u}; }
#pragma unroll
                for (int i = 0; i < 4; ++i) rb[i] = *(const u32x4*)(zp + (long)i * EVEN_IN + 512);
                float p[6][8];
#pragma unroll
                for (int i = 0; i < 6; ++i) unpack8(rp[i], p[i]);
#pragma unroll
                for (int i = 0; i < 4; ++i) {
                    float bg[8], o[8]; unpack8(rb[i], bg);
#pragma unroll
                    for (int j = 0; j < 8; ++j) o[j] = bg[j] * (w0[j] * p[i][j] + w1[j] * p[i + 1][j] + w2[j] * p[i + 2][j]);
                    *(u32x4*)(Y + (size_t)(t0 + tk0 + i) * D + 512 + 8 * c8) = pack8(o);
                }
            }
        }
        __syncthreads();
        {
            f32x4 lg[4][2], lb[4][2]; const float* lgp = A.c_ln_g; const float* lbp = A.c_ln_b; OPAQUE_S(lgp); OPAQUE_S(lbp);
#pragma unroll
            for (int j = 0; j < 4; ++j) { lg[j][0] = *(const f32x4*)(lgp + 128 * j + 8 * fr); lg[j][1] = *(const f32x4*)(lgp + 128 * j + 8 * fr + 4);
                                          lb[j][0] = *(const f32x4*)(lbp + 128 * j + 8 * fr); lb[j][1] = *(const f32x4*)(lbp + 128 * j + 8 * fr + 4); }
#pragma unroll
            for (int r = 0; r < 2; ++r) {
                const int tok = 8 * w + 4 * r + fq;
                float v[4][8]; float s = 0.f, q = 0.f;
#pragma unroll
                for (int j = 0; j < 4; ++j) { unpack8(*(const LAS u32x4*)(lds + tok * 1024 + (128 * j + 8 * fr) * 2), v[j]);
#pragma unroll
                    for (int e = 0; e < 8; ++e) { s += v[j][e]; q += v[j][e] * v[j][e]; } }
                s = seg16_sum(s); q = seg16_sum(q);
                const float mu = s * (1.0f / 512.0f); const float var = fmaxf(q * (1.0f / 512.0f) - mu * mu, 0.f); const float rstd = rsqrtf(var + EPS);
#pragma unroll
                for (int j = 0; j < 4; ++j) {
                    float o[8];
#pragma unroll
                    for (int e = 0; e < 4; ++e) { o[e] = silu_f((v[j][e] - mu) * rstd * lg[j][0][e] + lb[j][0][e]); o[4 + e] = silu_f((v[j][4 + e] - mu) * rstd * lg[j][1][e] + lb[j][1][e]); }
                    *(u32x4*)(Y + (size_t)(t0 + tok) * D + 128 * j + 8 * fr) = pack8(o);
                }
            }
        }
        __syncthreads();
    }
}

__device__ __forceinline__ void final_norm(int vcu, int G, int wave_id) {
    const __attribute__((address_space(4))) Args& A = *fresh_args();
    int tid_ = phase_tid(wave_id);
    const int tid = tid_, lane = tid & 63, wave = __builtin_amdgcn_readfirstlane(tid >> 6);
    const int gw = vcu * NWAVES + wave, NGW = G * NWAVES;
    const float* ss = (const float*)(A.ws + WS_SS); const bf16_t* xb = (const bf16_t*)(A.ws + WS_XB);
    f32x4 gg[4];
#pragma unroll
    for (int j = 0; j < 4; ++j) gg[j] = *((const f32x4*)A.final_norm_g + 2 * lane + 128 * (j >> 1) + (j & 1));
    const int gpv = (M_TOK / 4) / G, contig = (gpv * G == M_TOK / 4) && (gpv % NWAVES == 0);
    for (int gi = 0; (gi * NGW + gw) * 4 < M_TOK; ++gi) {
        const int m0 = contig ? (vcu * gpv + gi * NWAVES + wave) * 4 : (gi * NGW + gw) * 4;
        float part[4]; u32x4 raw[4][2];
#pragma unroll
        for (int r = 0; r < 4; ++r) { part[r] = ss[(size_t)(m0 + r) * 16 + (lane & 15)];
            raw[r][0] = __builtin_nontemporal_load((const u32x4*)(xb + (size_t)(m0 + r) * D) + lane); raw[r][1] = __builtin_nontemporal_load((const u32x4*)(xb + (size_t)(m0 + r) * D) + lane + 64); }
#pragma unroll
        for (int r = 0; r < 4; ++r) {
            const float rs = rsqrtf(seg16_sum(part[r]) * (1.0f / 1024.0f) + EPS);
            f32x4* orow = (f32x4*)(A.out + (size_t)(m0 + r) * D);
#pragma unroll
            for (int hh = 0; hh < 2; ++hh) {
                float v[8]; unpack8(raw[r][hh], v);
                orow[128 * hh + 2 * lane] = (f32x4){v[0], v[1], v[2], v[3]} * rs * gg[2 * hh];
                orow[128 * hh + 2 * lane + 1] = (f32x4){v[4], v[5], v[6], v[7]} * rs * gg[2 * hh + 1];
            }
        }
    }
}

#ifndef PG8_SP2
#define PG8_SP2 true
#endif
#ifndef PG8_ALIGN
#define PG8_ALIGN true
#endif
__global__ void __launch_bounds__(NTHREADS, 2) trunk_fwd(Args args) {
    extern __shared__ __attribute__((aligned(16))) unsigned char lds_raw[];
    LAS unsigned char* lds = (LAS unsigned char*)lds_raw;
    const int G = gridDim.x, bx = blockIdx.x;
    const int wave_id = __builtin_amdgcn_readfirstlane(threadIdx.x >> 6);
    const int vcu = (G % 8 == 0) ? (bx % 8) * (G / 8) + bx / 8 : bx;
    const int lo = fresh_args()->ph_lo, hi = fresh_args()->ph_hi;
#define WSP(off) (fresh_args()->ws + (off))
#ifndef KIND_MASK
#define KIND_MASK 0xff
#endif
#define KIND(b) (((KIND_MASK) >> (b)) & 1)
#define IN(k) (lo <= (k) && (k) < hi)
#if USE_CG_SYNC
#define SEAM(k, loc, arr, PRE) do { if (IN(k) && IN((k) + 1)) { cg::this_grid().sync(); } } while (0)
#define BPRE(k) false
#else
    if (threadIdx.x < 4) ((volatile LAS unsigned*)(lds + LDS_MISC_OFF))[threadIdx.x] = 0u;
    __syncthreads();
    XcdBarrier bar = xcd_barrier_post((unsigned*)WSP(WS_CTL) + CW_BAR, (volatile LAS unsigned*)(lds + LDS_MISC_OFF));
    if (lo < 0) cg::this_grid().sync();
#define SEAM(k, loc, arr, PRE) do { if (IN(k) && IN((k) + 1)) { xcd_barrier_enter(); PRE; xcd_barrier_finish(bar, wave_id, (loc) ? lmode : 0u, (arr)); } } while (0)
#define BPRE(k) (IN((k) - 1) && IN(k))
#define PFB(Wt, N_, K_) pg8::gemm_prefetch_b(lds, (const bf16_t*)(WSP(0) + (Wt)), M_TOK, (N_), (K_), G, bxv, wave_id)
#endif

    unsigned lmode = 0u; int bxv = bx, vcv = vcu;
    if (KIND(0) && IN(0)) { for (int rep = 0; rep < NREP(0); ++rep) p0_prologue(lds, vcu, G, wave_id); }
    SEAM(0, 0, 0u, (void)0);
#if !USE_CG_SYNC
    if (IN(0) && IN(1)) {
        volatile LAS unsigned* st = (volatile LAS unsigned*)(lds + LDS_MISC_OFF);
        lmode = __builtin_amdgcn_readfirstlane(st[3]);
        if (lmode) { bxv = (int)__builtin_amdgcn_readfirstlane(st[2]) * 8 + (int)bar.x; vcv = (bxv % 8) * (G / 8) + bxv / 8; }
    }
#endif
#pragma unroll 1
    for (int layer = 0; layer < 2; ++layer) {
        const int pb = 1 + 5 * layer;
        if (KIND(1) && IN(pb + 0)) {
            const int N = layer ? ODD_IN : EVEN_IN;
            unsigned char* ws = WSP(0); pg8::Gemm g{(const bf16_t*)(ws + WS_XB), (const bf16_t*)(ws + (layer ? WS_WIN1 : WS_WIN0)), M_TOK, N, D}; pg8::StaticOrder S; S.init(M_TOK, N, G, bxv);
            pg8::EpiScaleBf16 E{(bf16_t*)(ws + WS_Z), layer, (const float*)(ws + WS_SS)};
            pg8::gemm_phase<pg8::EpiScaleBf16, PG8_ALIGN, PG8_SP2>(lds, g, S, E, wave_id, (lmode && layer) ? (unsigned*)ws + (WS_CTL / 4 + CW_BAR + XB_DONE_B) : nullptr, (unsigned)G, layer == 1 && BPRE(pb + 0));
        }
        SEAM(pb + 0, 0, 0u, (void)0);
        if (IN(pb + 1)) { if (layer == 0) { if (KIND(2)) for (int rep = 0; rep < NREP(2); ++rep) mixer_even(lds, vcv, G, wave_id); } else { if (KIND(3)) for (int rep = 0; rep < NREP(3); ++rep) mixer_odd(lds, vcv, G, wave_id); } }
        SEAM(pb + 1, 1, 0u, PFB(layer ? WS_WOUT1 : WS_WOUT0, D, D));
        if (KIND(4) && IN(pb + 2)) {
            unsigned char* ws = WSP(0); pg8::Gemm g{(const bf16_t*)(ws + WS_Y), (const bf16_t*)(ws + (layer ? WS_WOUT1 : WS_WOUT0)), M_TOK, D, D}; pg8::StaticOrder S; S.init(M_TOK, D, G, bxv);
            pg8::EpiResid E{(bf16_t*)(ws + WS_XB), (float*)(ws + WS_SS)};
            pg8::gemm_phase<pg8::EpiResid, PG8_ALIGN, PG8_SP2>(lds, g, S, E, wave_id, nullptr, 0u, BPRE(pb + 2));
        }
        SEAM(pb + 2, 1, XB_DONE_A, PFB(layer ? WS_WGU1 : WS_WGU0, GU, D));
        if (KIND(5) && IN(pb + 3)) {
            unsigned char* ws = WSP(0); pg8::Gemm g{(const bf16_t*)(ws + WS_XB), (const bf16_t*)(ws + (layer ? WS_WGU1 : WS_WGU0)), M_TOK, GU, D}; pg8::StaticOrder S; S.init(M_TOK, GU, G, bxv);
            pg8::EpiSwiGLU E{(bf16_t*)(ws + WS_ACT), (const float*)(ws + WS_SS)};
            pg8::gemm_phase<pg8::EpiSwiGLU, PG8_ALIGN, PG8_SP2>(lds, g, S, E, wave_id, lmode ? (unsigned*)ws + (WS_CTL / 4 + CW_BAR + XB_DONE_A) : nullptr, (unsigned)G * (unsigned)(layer + 1), BPRE(pb + 3));
        }
        SEAM(pb + 3, 1, 0u, PFB(layer ? WS_WDN1 : WS_WDN0, D, DFF));
        if (KIND(6) && IN(pb + 4)) {
            unsigned char* ws = WSP(0); pg8::Gemm g{(const bf16_t*)(ws + WS_ACT), (const bf16_t*)(ws + (layer ? WS_WDN1 : WS_WDN0)), M_TOK, D, DFF}; pg8::StaticOrder S; S.init(M_TOK, D, G, bxv);
            pg8::EpiResid E{(bf16_t*)(ws + WS_XB), (float*)(ws + WS_SS)};
            pg8::gemm_phase<pg8::EpiResid, PG8_ALIGN, PG8_SP2>(lds, g, S, E, wave_id, nullptr, 0u, BPRE(pb + 4));
        }
        SEAM(pb + 4, 1, layer ? 0u : XB_DONE_B, if (layer == 0) PFB(WS_WIN1, ODD_IN, D));
    }
    if (KIND(7) && IN(11)) for (int rep = 0; rep < NREP(7); ++rep) final_norm(vcv, G, wave_id);
#undef IN
#undef SEAM
#undef BPRE
}

extern "C" void kernel_launch(void* const* d_in, const int* in_sizes, int n_in, void* d_out, int out_size, void* d_ws, size_t ws_size, hipStream_t stream) {
    static int grid = 0;
    if (grid == 0) {
        if (n_in != 22 || in_sizes[0] != M_TOK * D || out_size != M_TOK * D || ws_size < WS_END) {
            fprintf(stderr, "kernel_launch: unexpected shapes: n_in %d in0 %d out %d ws %zu (need %zu)\n", n_in, n_in > 0 ? in_sizes[0] : -1, out_size, ws_size, (size_t)WS_END); grid = -1; return; }
        int dev = 0, cus = 0, per_cu = 0;
        if (hipGetDevice(&dev) != hipSuccess || hipDeviceGetAttribute(&cus, hipDeviceAttributeMultiprocessorCount, dev) != hipSuccess) { fprintf(stderr, "kernel_launch: device query failed\n"); grid = -1; return; }
        if (hipFuncSetAttribute((const void*)trunk_fwd, hipFuncAttributeMaxDynamicSharedMemorySize, LDS_BYTES) != hipSuccess) { fprintf(stderr, "kernel_launch: hipFuncSetAttribute failed\n"); grid = -1; return; }
        if (hipOccupancyMaxActiveBlocksPerMultiprocessor(&per_cu, (const void*)trunk_fwd, NTHREADS, LDS_BYTES) != hipSuccess || per_cu < 1) { fprintf(stderr, "kernel_launch: occupancy query says %d blocks/CU\n", per_cu); per_cu = 1; }
        (void)hipGetLastError();
        grid = cus;
        fprintf(stderr, "kernel_launch: cus %d per_cu %d grid %d\n", cus, per_cu, grid);
    }
    if (grid < 0) return;
    Args a{};
    const float** f = (const float**)&a;
    for (int i = 0; i < 22; ++i) f[i] = (const float*)d_in[i];
    const size_t ws_off = ((ws_size - WS_END) / (2 * MiB)) * (2 * MiB);
    a.out = (float*)d_out; a.ws = (unsigned char*)d_ws + ws_off;
#if MK_PER_PHASE
    for (int p = 0; p < 12; ++p) {
        a.ph_lo = p; a.ph_hi = p + 1;
        for (int rep = 0; rep < 1 + ((PROBE_DUP >> p) & 1); ++rep)
            hipLaunchKernelGGL(trunk_fwd, dim3(grid), dim3(NTHREADS), LDS_BYTES, stream, a);
    }
#else
    a.ph_lo = 0; a.ph_hi = 12;
    if (hipMemsetAsync((char*)a.ws + WS_CTL, 0, 65536, stream) != hipSuccess) { fprintf(stderr, "kernel_launch: memset failed\n"); return; }
    void* kargs[] = {&a};
    hipError_t e = hipLaunchCooperativeKernel((const void*)trunk_fwd, dim3(grid), dim3(NTHREADS), kargs, LDS_BYTES, stream);
    if (e != hipSuccess) fprintf(stderr, "kernel_launch: cooperative launch failed: %s (grid %d)\n", hipGetErrorString(e), grid);
#endif
}
```

```cpp
#include <hip/hip_runtime.h>
#include <hip/hip_cooperative_groups.h>
#include <cstdio>
#include <cstdint>
namespace cg = cooperative_groups;

#ifndef MK_PER_PHASE
#define MK_PER_PHASE 0
#endif

#ifndef PROBE_DUPK
#define PROBE_DUPK 0
#endif
#define NREP(k) (1 + (((PROBE_DUPK) >> (k)) & 1))
#ifndef PROBE_DUP
#define PROBE_DUP 0
#endif

#define LAS __attribute__((address_space(3)))
typedef unsigned short bf16_t;
typedef short bf16x8 __attribute__((ext_vector_type(8)));
typedef short s16x4 __attribute__((ext_vector_type(4)));
typedef float f32x4 __attribute__((ext_vector_type(4)));
typedef float f32x2 __attribute__((ext_vector_type(2)));
typedef unsigned u32x4 __attribute__((ext_vector_type(4)));
typedef unsigned u32x2 __attribute__((ext_vector_type(2)));

constexpr int M_TOK = 32768, D = 1024, SEQ = 8192;
constexpr int EVEN_IN = 1536, ODD_IN = 2560, DFF = 2816, GU = 2 * DFF;
constexpr float EPS = 1e-6f;
constexpr int NWAVES = 8, NTHREADS = 512;

constexpr size_t MiB = 1u << 20;
constexpr size_t WS_CTL = 0, CTL_BYTES = 1 * MiB;
constexpr size_t WS_WIN0 = 2 * MiB, WS_WOUT0 = 5 * MiB, WS_WGU0 = 7 * MiB, WS_WDN0 = 18 * MiB;
constexpr size_t WS_WIN1 = 24 * MiB, WS_WOUT1 = 29 * MiB, WS_WGU1 = 31 * MiB, WS_WDN1 = 42 * MiB;
constexpr size_t WS_WS = 48 * MiB, WS_WP = 49 * MiB;
constexpr size_t WS_SS = 50 * MiB;
constexpr size_t WS_XB = 64 * MiB;
constexpr size_t WS_Z = 128 * MiB;
constexpr size_t WS_ACT = 128 * MiB;
constexpr size_t WS_Y = 224 * MiB;
constexpr size_t WS_END = 304 * MiB;

constexpr int LDS_BYTES = 155648;
constexpr int LDS_MISC_OFF = LDS_BYTES - 256;
constexpr int CW_BAR = 4096;
#ifndef USE_CG_SYNC
#define USE_CG_SYNC 0
#endif

__device__ __forceinline__ unsigned cvt_pk_bf16(float lo, float hi) { unsigned r; asm volatile("v_cvt_pk_bf16_f32 %0, %1, %2" : "=v"(r) : "v"(lo), "v"(hi)); return r; }
__device__ __forceinline__ unsigned long long opaque_uniform_u64(unsigned long long v) {
    unsigned lo = __builtin_amdgcn_readfirstlane((unsigned)v), hi = __builtin_amdgcn_readfirstlane((unsigned)(v >> 32));
    asm volatile("" : "+s"(lo), "+s"(hi));
    return ((unsigned long long)hi << 32) | lo;
}
template <class T> __device__ __forceinline__ T* opaque_uniform(T* p) { return (T*)opaque_uniform_u64((unsigned long long)p); }
#define OPAQUE_S(p) p = opaque_uniform(p)
__device__ __forceinline__ float bf_lo(unsigned u) { return __uint_as_float(u << 16); }
__device__ __forceinline__ float bf_hi(unsigned u) { return __uint_as_float(u & 0xffff0000u); }
__device__ __forceinline__ float wave_sum(float v) {
#pragma unroll
    for (int o = 1; o < 64; o <<= 1) v += __shfl_xor(v, o);
    return v;
}
__device__ __forceinline__ float sigmoid_f(float x) { return __builtin_amdgcn_rcpf(1.0f + __expf(-x)); }
__device__ __forceinline__ float silu_f(float x) { return x * sigmoid_f(x); }
__device__ __forceinline__ float gelu_tanh_f(float x) { const float u = 0.7978845608028654f * (x + 0.044715f * x * x * x); return x * sigmoid_f(2.0f * u); }
__device__ __forceinline__ f32x4 exp2_v4(const f32x4 t) { f32x4 e; e.x = __builtin_amdgcn_exp2f(t.x); e.y = __builtin_amdgcn_exp2f(t.y); e.z = __builtin_amdgcn_exp2f(t.z); e.w = __builtin_amdgcn_exp2f(t.w); return e; }
__device__ __forceinline__ f32x4 rcp_v4(const f32x4 d) { f32x4 r; r.x = __builtin_amdgcn_rcpf(d.x); r.y = __builtin_amdgcn_rcpf(d.y); r.z = __builtin_amdgcn_rcpf(d.z); r.w = __builtin_amdgcn_rcpf(d.w); return r; }
__device__ __forceinline__ f32x4 sigmoid_scaled_v4(const f32x4 x, const float c) { return rcp_v4(exp2_v4(x * c) + 1.0f); }
__device__ __forceinline__ f32x4 gelu_tanh_v4(const f32x4 x) {
    const f32x4 w = x * (x * x * 0.044715f + 1.0f);
    return x * rcp_v4(exp2_v4(w * -2.3022081986f) + 1.0f);
}
__device__ __forceinline__ void unpack8(const u32x4 r, float (&v)[8]) {
    v[0] = bf_lo(r.x); v[1] = bf_hi(r.x); v[2] = bf_lo(r.y); v[3] = bf_hi(r.y); v[4] = bf_lo(r.z); v[5] = bf_hi(r.z); v[6] = bf_lo(r.w); v[7] = bf_hi(r.w);
}
__device__ __forceinline__ u32x4 pack8(const float (&v)[8]) {
    u32x4 r; r.x = cvt_pk_bf16(v[0], v[1]); r.y = cvt_pk_bf16(v[2], v[3]); r.z = cvt_pk_bf16(v[4], v[5]); r.w = cvt_pk_bf16(v[6], v[7]); return r;
}
__device__ __forceinline__ float row_rstd(const float* ss, int row) {
    const f32x4* p = (const f32x4*)(ss + (size_t)row * 16);
    const f32x4 a = p[0], b = p[1], c = p[2], d = p[3];
    const f32x4 s = (a + b) + (c + d);
    return rsqrtf(((s.x + s.y) + (s.z + s.w)) * (1.0f / 1024.0f) + EPS);
}


__device__ __forceinline__ int phase_tid(int wave_id) {
    unsigned ones = ~0u; asm volatile("" : "+s"(ones));
    int t = wave_id * 64 + (int)__builtin_amdgcn_mbcnt_hi(ones, __builtin_amdgcn_mbcnt_lo(ones, 0u));
    asm volatile("" : "+v"(t)); return t;
}

typedef __attribute__((address_space(1))) unsigned gu32;
#define XB_TMO      128
#define XB_XCNT(j)  (256  + 64 * (j))
#define XB_XSUB(j)  (1280 + 64 * (j))
#define XB_XGEN(j)  (2304 + 64 * (j))
#define XB_TOP      3328
#define XB_TOPGEN   3392
#define XB_DONE_A   3456
#define XB_DONE_B   3520
#define XB_FIN(pm)  (3584 + 16 * (pm))
#define XCD_BAR_WORDS (3584 + 16 * 128)
#define XB_SPIN_CAP (1u << 18)
__device__ __forceinline__ unsigned xb_ld(unsigned* p)              { return __hip_atomic_load(p, __ATOMIC_RELAXED, __HIP_MEMORY_SCOPE_AGENT); }
__device__ __forceinline__ unsigned xb_add(unsigned* p, unsigned v) { return __hip_atomic_fetch_add(p, v, __ATOMIC_RELAXED, __HIP_MEMORY_SCOPE_AGENT); }
__device__ __forceinline__ unsigned xb_xcc_id() { return (unsigned)__builtin_amdgcn_s_getreg((3 << 11) | 20) & 0xFu; }
#define XB_SPIN(cond, bar) do { unsigned _sp = 0; while (cond) { __builtin_amdgcn_s_sleep(1); \
    if ((++_sp & 255u) == 0u) { if (xb_ld(&(bar)[XB_TMO])) break; if (_sp > XB_SPIN_CAP) { atomicAdd(&(bar)[XB_TMO], 1u); break; } } } } while (0)
struct XcdBarrier { unsigned* bar; unsigned x; volatile LAS unsigned* st; };
__device__ __forceinline__ XcdBarrier xcd_barrier_post(unsigned* bar, volatile LAS unsigned* st) {
    XcdBarrier b; b.bar = bar; b.x = xb_xcc_id(); b.st = st;
    if (threadIdx.x == 0) st[2] = xb_add(&bar[XB_XCNT(b.x)], 1u);
    return b;
}
__device__ __forceinline__ void xcd_barrier_complete(unsigned* bar, unsigned x, unsigned& nloc, unsigned& nx, unsigned& uni) {
    const unsigned G = gridDim.x * gridDim.y * gridDim.z;
    unsigned sum, cnt, mine, bad, sp = 0u;
    for (;;) {
        sum = 0u; cnt = 0u; mine = 0u; bad = 0u;
#pragma unroll
        for (unsigned j = 0; j < 16; ++j) { const unsigned c = xb_ld(&bar[XB_XCNT(j)]); sum += c; cnt += (c > 0u) ? 1u : 0u; mine = (j == x) ? c : mine; bad |= (c != 0u && c * 8u != G) ? 1u : 0u; }
        if (sum == G) break;
        __builtin_amdgcn_s_sleep(1);
        if ((++sp & 255u) == 0u) { if (xb_ld(&bar[XB_TMO])) break; if (sp > XB_SPIN_CAP) { atomicAdd(&bar[XB_TMO], 1u); break; } }
    }
    nloc = mine > 0u ? mine : 1u; nx = cnt > 0u ? cnt : 1u;
    uni = (sum == G && cnt == 8u && bad == 0u && x < 8u) ? 1u : 0u;
}
__device__ __forceinline__ void xcd_barrier(const XcdBarrier& b, int wave_id, unsigned local = 0u, unsigned arrive = 0u) {
    asm volatile("s_waitcnt vmcnt(0)" ::: "memory");
    __syncthreads();
    unsigned ones = ~0u; asm volatile("" : "+s"(ones));
    if (wave_id == 0 && __builtin_amdgcn_mbcnt_hi(ones, __builtin_amdgcn_mbcnt_lo(ones, 0u)) == 0u) {
        unsigned* bar = b.bar;
        __builtin_amdgcn_s_waitcnt(0);
        unsigned nloc = b.st[0], nx = b.st[1];
        if (nloc == 0u) { unsigned uni; xcd_barrier_complete(bar, b.x, nloc, nx, uni); b.st[0] = nloc; b.st[1] = nx; b.st[3] = uni; }
        if (arrive) (void)xb_add(&bar[arrive], 1u);
        const unsigned old = xb_add(&bar[XB_XSUB(b.x)], 1u);
        const unsigned gen = old / nloc;
        if (old + 1u == (gen + 1u) * nloc) {
            if (!local) {
                __builtin_amdgcn_fence(__ATOMIC_RELEASE, "agent");
                asm volatile("s_waitcnt vmcnt(0)" ::: "memory");
                const unsigned og = xb_add(&bar[XB_TOP], 1u);
                const unsigned tg = og / nx;
                if (og + 1u == (tg + 1u) * nx) xb_add(&bar[XB_TOPGEN], 1u);
                else XB_SPIN(xb_ld(&bar[XB_TOPGEN]) == tg, bar);
            }
            __builtin_amdgcn_fence(__ATOMIC_ACQUIRE, "agent");
            xb_add(&bar[XB_XGEN(b.x)], 1u);
            asm volatile("s_waitcnt vmcnt(0)" ::: "memory");
        } else {
            XB_SPIN(xb_ld(&bar[XB_XGEN(b.x)]) == gen, bar);
            __builtin_amdgcn_fence(__ATOMIC_ACQUIRE, "agent");
            asm volatile("s_waitcnt vmcnt(0)" ::: "memory");
        }
    }
    __syncthreads();
}

__device__ __forceinline__ float row_sumsq_part(const float* ss, int row, int fq) { const f32x4 a = *(const f32x4*)(ss + (size_t)row * 16 + 4 * fq); return (a.x + a.y) + (a.z + a.w); }
__device__ __forceinline__ float rstd_from_part(float p) { p += __shfl_xor(p, 16); p += __shfl_xor(p, 32); return rsqrtf(p * (1.0f / 1024.0f) + EPS); }

namespace pg8 {
constexpr int BM = 256, BK = 64, HALF = 128, HTB = HALF * BK * 2, STAGE_BYTES = 8 * HTB, NXCD = 8, WGM = 4;
__device__ __forceinline__ int lds_byte(int r, int c) { const int st = (r >> 4) * 2 + (c >> 5), rr = r & 15, cc = c & 31, ob = rr * 64 + cc * 2; return st * 1024 + (ob ^ (((ob >> 9) & 1) << 5)); }
__device__ __forceinline__ void stage_rc(int b, int& R, int& C) { const int st = b / 1024, sb = b % 1024, swz = sb ^ (((sb >> 9) & 1) << 5); R = (st >> 1) * 16 + swz / 64; C = (st & 1) * 32 + (swz % 64) / 2; }
__device__ __forceinline__ int perm32(int rho) { const int n = rho >> 4, i = rho & 15; return 8 * (i >> 2) + 4 * n + (i & 3); }

struct Unit { int pm, pn; };
struct Gemm { const bf16_t* A; const bf16_t* Bt; int M, N, K; };

struct StaticOrder {
    int nM, nN, nwg, G, c;
    __device__ void init(int M, int N, int G_, int c_) { nM = M / BM; nN = N / BM; nwg = nM * nN; G = G_; c = c_; }
    __device__ bool next(int i, Unit& u) const {
        const long L = (long)i * G + c; if (L >= nwg) return false;
        int wgid = (int)L; { const int q = nwg / NXCD, r = nwg % NXCD, xcd = wgid % NXCD, off = wgid / NXCD; wgid = (xcd < r ? xcd * (q + 1) : r * (q + 1) + (xcd - r) * q) + off; }
        const int nig = WGM * nN, gid = wgid / nig, fm = gid * WGM, gsz = (nM - fm) < WGM ? (nM - fm) : WGM;
        u.pm = fm + ((wgid % nig) % gsz); u.pn = (wgid % nig) / gsz; return true;
    }
};

struct EpiScaleBf16 {
    static constexpr bool PERM = true, USES_RSTD = true, FINAL = false;
    bf16_t* O; int odd; const float* ss;
    __device__ __forceinline__ void operator()(const f32x4 (&acc)[2][2][4][2], const Unit& u, int wr, int wc, int fr, int fq, const LAS float* rl) const {
        const int row0 = u.pm * BM + wr * 64 + fr;
        if (odd && u.pn < 8) {
            const bool glu = u.pn < 4;
            const int col0 = (glu ? 128 * u.pn : 512 + 128 * (u.pn - 4)) + wc * 32 + 8 * fq;
#pragma unroll
            for (int ai = 0; ai < 2; ++ai)
#pragma unroll
                for (int m = 0; m < 4; ++m) {
                    const int row = row0 + ai * HALF + m * 16; const float rs = rl[ai * HALF + wr * 64 + m * 16 + fr];
                    f32x4 o0, o1;
                    if (glu) {
                        const float c1 = -1.4426950408889634f * rs;
                        o0 = acc[ai][0][m][0] * (sigmoid_scaled_v4(acc[ai][1][m][0], c1) * rs); o1 = acc[ai][0][m][1] * (sigmoid_scaled_v4(acc[ai][1][m][1], c1) * rs);
                    } else {
                        const float rs2 = rs * rs;
                        o0 = (acc[ai][0][m][0] * acc[ai][1][m][0]) * rs2; o1 = (acc[ai][0][m][1] * acc[ai][1][m][1]) * rs2;
                    }
                    u32x4 w; w.x = cvt_pk_bf16(o0[0], o0[1]); w.y = cvt_pk_bf16(o0[2], o0[3]); w.z = cvt_pk_bf16(o1[0], o1[1]); w.w = cvt_pk_bf16(o1[2], o1[3]);
                    *(u32x4*)(O + (size_t)row * EVEN_IN + col0) = w;
                }
            return;
        }
        const int col0 = (odd ? 1024 + 256 * (u.pn - 8) : u.pn * BM) + wc * 32 + 8 * fq;
        const bool act = !odd && u.pn < 4;
#pragma unroll
        for (int ai = 0; ai < 2; ++ai)
#pragma unroll
            for (int m = 0; m < 4; ++m) {
                const int row = row0 + ai * HALF + m * 16; const float rs = rl[ai * HALF + wr * 64 + m * 16 + fr];
                bf16_t* rowp = O + (size_t)row * EVEN_IN + col0;
#pragma unroll
                for (int bj = 0; bj < 2; ++bj) {
                    f32x4 v0 = acc[ai][bj][m][0] * rs, v1 = acc[ai][bj][m][1] * rs;
                    if (act) { v0 = gelu_tanh_v4(v0); v1 = gelu_tanh_v4(v1); }
                    u32x4 w; w.x = cvt_pk_bf16(v0[0], v0[1]); w.y = cvt_pk_bf16(v0[2], v0[3]); w.z = cvt_pk_bf16(v1[0], v1[1]); w.w = cvt_pk_bf16(v1[2], v1[3]);
                    *(u32x4*)(rowp + bj * HALF) = w;
                }
            }
    }
};
struct EpiSwiGLU {
    static constexpr bool PERM = true, USES_RSTD = true, FINAL = false;
    bf16_t* O; const float* ss;
    __device__ __forceinline__ void operator()(const f32x4 (&acc)[2][2][4][2], const Unit& u, int wr, int wc, int fr, int fq, const LAS float* rl) const {
        const int row0 = u.pm * BM + wr * 64 + fr, f0 = u.pn * HALF + wc * 32 + 8 * fq;
#pragma unroll
        for (int ai = 0; ai < 2; ++ai)
#pragma unroll
            for (int m = 0; m < 4; ++m) {
                const int row = row0 + ai * HALF + m * 16; const float rs = rl[ai * HALF + wr * 64 + m * 16 + fr];
                const float c1 = -1.4426950408889634f * rs, rs2 = rs * rs;
                const f32x4 a0 = (acc[ai][0][m][0] * acc[ai][1][m][0]) * (sigmoid_scaled_v4(acc[ai][0][m][0], c1) * rs2);
                const f32x4 a1 = (acc[ai][0][m][1] * acc[ai][1][m][1]) * (sigmoid_scaled_v4(acc[ai][0][m][1], c1) * rs2);
                u32x4 w; w.x = cvt_pk_bf16(a0[0], a0[1]); w.y = cvt_pk_bf16(a0[2], a0[3]); w.z = cvt_pk_bf16(a1[0], a1[1]); w.w = cvt_pk_bf16(a1[2], a1[3]);
                __builtin_nontemporal_store(w, (u32x4*)(O + (size_t)row * DFF + f0));
            }
    }
};
struct EpiResid {
    static constexpr bool PERM = true, USES_RSTD = false, OVERLAP = false, FINAL = false;
    bf16_t* xb; float* ss;
    __device__ __forceinline__ void operator()(const f32x4 (&acc)[2][2][4][2], const Unit& u, int wr, int wc, int fr, int fq, const LAS float*) const {
        int lrow = wr * 64 + fr; asm volatile("" : "+v"(lrow));
        const int row0 = u.pm * BM + lrow, col0 = u.pn * BM + wc * 32 + 8 * fq;
        bf16_t* base = xb + (size_t)row0 * D + col0;
        u32x4 rv[2][4][2];
#pragma unroll
        for (int ai = 0; ai < 2; ++ai)
#pragma unroll
            for (int m = 0; m < 4; ++m)
#pragma unroll
                for (int bj = 0; bj < 2; ++bj) rv[ai][m][bj] = *(const u32x4*)(base + (size_t)(ai * HALF + m * 16) * D + bj * HALF);
#pragma unroll
        for (int ai = 0; ai < 2; ++ai)
#pragma unroll
            for (int m = 0; m < 4; ++m) {
                f32x4 q4 = (f32x4){0.f, 0.f, 0.f, 0.f};
#pragma unroll
                for (int bj = 0; bj < 2; ++bj) {
                    const u32x4 rw = rv[ai][m][bj];
                    const f32x4 h0 = (f32x4){bf_lo(rw.x), bf_hi(rw.x), bf_lo(rw.y), bf_hi(rw.y)} + acc[ai][bj][m][0];
                    const f32x4 h1 = (f32x4){bf_lo(rw.z), bf_hi(rw.z), bf_lo(rw.w), bf_hi(rw.w)} + acc[ai][bj][m][1];
                    q4 += h0 * h0 + h1 * h1;
                    u32x4 w; w.x = cvt_pk_bf16(h0.x, h0.y); w.y = cvt_pk_bf16(h0.z, h0.w); w.z = cvt_pk_bf16(h1.x, h1.y); w.w = cvt_pk_bf16(h1.z, h1.w);
                    *(u32x4*)(base + (size_t)(ai * HALF + m * 16) * D + bj * HALF) = w;
                }
                float q = (q4.x + q4.y) + (q4.z + q4.w);
                q += __shfl_xor(q, 16); q += __shfl_xor(q, 32);
                if (fq == 0) ss[(size_t)(row0 + ai * HALF + m * 16) * 16 + u.pn * 4 + wc] = q;
            }
    }
};

struct EpiFinal {
    static constexpr bool PERM = true, USES_RSTD = false, OVERLAP = false, FINAL = true;
    const bf16_t* xb; float* ss; float* out; const float* gain; unsigned* flags;
    __device__ __forceinline__ void pre(f32x4 (&acc)[2][2][4][2], const Unit& u, int wr, int wc, int fr, int fq) const {
        int lrow = wr * 64 + fr; asm volatile("" : "+v"(lrow));
        const int row0 = u.pm * BM + lrow, col0 = u.pn * BM + wc * 32 + 8 * fq;
        const bf16_t* base = xb + (size_t)row0 * D + col0;
        u32x4 rv[2][4][2];
#pragma unroll
        for (int ai = 0; ai < 2; ++ai)
#pragma unroll
            for (int m = 0; m < 4; ++m)
#pragma unroll
                for (int bj = 0; bj < 2; ++bj) rv[ai][m][bj] = *(const u32x4*)(base + (size_t)(ai * HALF + m * 16) * D + bj * HALF);
#pragma unroll
        for (int ai = 0; ai < 2; ++ai)
#pragma unroll
            for (int m = 0; m < 4; ++m) {
                f32x4 q4 = (f32x4){0.f, 0.f, 0.f, 0.f};
#pragma unroll
                for (int bj = 0; bj < 2; ++bj) {
                    const u32x4 rw = rv[ai][m][bj];
                    const f32x4 h0 = (f32x4){bf_lo(rw.x), bf_hi(rw.x), bf_lo(rw.y), bf_hi(rw.y)} + acc[ai][bj][m][0];
                    const f32x4 h1 = (f32x4){bf_lo(rw.z), bf_hi(rw.z), bf_lo(rw.w), bf_hi(rw.w)} + acc[ai][bj][m][1];
                    q4 += h0 * h0 + h1 * h1;
                    acc[ai][bj][m][0] = h0; acc[ai][bj][m][1] = h1;
                }
                float q = (q4.x + q4.y) + (q4.z + q4.w);
                q += __shfl_xor(q, 16); q += __shfl_xor(q, 32);
                if (fq == 0) ss[(size_t)(row0 + ai * HALF + m * 16) * 16 + u.pn * 4 + wc] = q;
            }
    }
    __device__ __forceinline__ void post(const f32x4 (&acc)[2][2][4][2], const Unit& u, int wr, int wc, int fr, int fq, const LAS float* rl) const {
        int lrow = wr * 64 + fr; asm volatile("" : "+v"(lrow));
        const int row0 = u.pm * BM + lrow, col0 = u.pn * BM + wc * 32 + 8 * fq;
        const float* gp = gain; OPAQUE_S(gp);
        f32x4 gv[2][2];
#pragma unroll
        for (int bj = 0; bj < 2; ++bj)
#pragma unroll
            for (int n = 0; n < 2; ++n) gv[bj][n] = *(const f32x4*)(gp + col0 + bj * HALF + 4 * n);
        float* base = out + (size_t)row0 * D + col0;
#pragma unroll
        for (int ai = 0; ai < 2; ++ai)
#pragma unroll
            for (int m = 0; m < 4; ++m) {
                const float rs = rl[ai * HALF + wr * 64 + m * 16 + fr];
#pragma unroll
                for (int bj = 0; bj < 2; ++bj)
#pragma unroll
                    for (int n = 0; n < 2; ++n) *(f32x4*)(base + (size_t)(ai * HALF + m * 16) * D + bj * HALF + 4 * n) = acc[ai][bj][m][n] * rs * gv[bj][n];
            }
    }
    __device__ __forceinline__ void operator()(const f32x4 (&)[2][2][4][2], const Unit&, int, int, int, int, const LAS float*) const {}
};

template <class Epi, bool ALIGN_EPI, bool SP2>
__device__ __forceinline__ void gemm_phase(LAS unsigned char* lds, const Gemm g, const StaticOrder& S, const Epi& E, int wave_id, unsigned* wait_ctr = nullptr, unsigned wait_val = 0u) {
    int tid_ = phase_tid(wave_id);
    const int tid = tid_, wid = __builtin_amdgcn_readfirstlane(tid >> 6), lane = tid & 63, wr = wid >> 2, wc = wid & 3, fr = lane & 15, fq = lane >> 4;
    const int K = g.K, nt = K / BK;
    unsigned voffA[2], voffB[2];
#pragma unroll
    for (int i = 0; i < 2; ++i) { int R, C; stage_rc(tid * 16 + i * 8192, R, C); const int Rb = Epi::PERM ? ((R & ~31) + perm32(R & 31)) : R;
        voffA[i] = (unsigned)(R * K + C) * 2u; voffB[i] = (unsigned)(Rb * K + C) * 2u; }
    const size_t kstep = (size_t)(BK * 2);
    const size_t hstep = (size_t)HALF * K * 2;
    const size_t tstep = 2 * hstep;
    const unsigned ldsw = (unsigned)wid * 1024u;
    const int aoff = lds_byte(wr * 64 + fr, fq * 8), boff = lds_byte(wc * 32 + fr, fq * 8);
#define PG8_SA(b, h) (((b) * 2 + (h)) * HTB)
#define PG8_SB(b, h) ((4 + (b) * 2 + (h)) * HTB)
#define PG8_STAGE(bufoff, gbase, voff) do { _Pragma("unroll") for (int _i = 0; _i < 2; ++_i) \
        __builtin_amdgcn_global_load_lds((const unsigned*)((const char*)(gbase) + (voff)[_i]), (LAS unsigned*)(lds + (bufoff) + ldsw + _i * 8192), 16, 0, 0); } while (0)
#define PG8_LDA(dst, b, h) do { _Pragma("unroll") for (int m = 0; m < 4; ++m) _Pragma("unroll") for (int k = 0; k < 2; ++k) dst[m][k] = *(const LAS bf16x8*)(lds + PG8_SA(b, h) + aoff + m * 2048 + k * 1024); } while (0)
#define PG8_LDB(dst, b, h) do { _Pragma("unroll") for (int n = 0; n < 2; ++n) _Pragma("unroll") for (int k = 0; k < 2; ++k) dst[n][k] = *(const LAS bf16x8*)(lds + PG8_SB(b, h) + boff + n * 2048 + k * 1024); } while (0)
#define PG8_MMA(ai, bj, At, Bt) do { __builtin_amdgcn_s_setprio(1); _Pragma("unroll") for (int m = 0; m < 4; ++m) _Pragma("unroll") for (int n = 0; n < 2; ++n) _Pragma("unroll") for (int k = 0; k < 2; ++k) \
        acc[ai][bj][m][n] = __builtin_amdgcn_mfma_f32_16x16x32_bf16(Bt[n][k], At[m][k], acc[ai][bj][m][n], 0, 0, 0); __builtin_amdgcn_s_setprio(0); } while (0)
#define PG8_AUX_SC1 16
#define PG8_WAIT_V(n) asm volatile("s_waitcnt vmcnt(" #n ")" ::: "memory")
#define PG8_WAIT_L(n) asm volatile("s_waitcnt lgkmcnt(" #n ")" ::: "memory")
#define PG8_BAR __builtin_amdgcn_s_barrier()
#define PG8_SCHED __builtin_amdgcn_sched_barrier(0)
    Unit cur, nxt; int ui = 0;
    if (!S.next(0, cur)) return;
#ifdef PROBE_STAGGER
    if (blockIdx.x & 8) { const unsigned long long t0 = __builtin_amdgcn_s_memrealtime(); while (__builtin_amdgcn_s_memrealtime() - t0 < PROBE_STAGGER) __builtin_amdgcn_s_sleep(8); }
#endif
    f32x4 acc[2][2][4][2];
#pragma unroll
    for (int a = 0; a < 2; ++a)
#pragma unroll
        for (int b = 0; b < 2; ++b)
#pragma unroll
            for (int m = 0; m < 4; ++m)
#pragma unroll
                for (int n = 0; n < 2; ++n) acc[a][b][m][n] = (f32x4){0.f, 0.f, 0.f, 0.f};
    bf16x8 At[4][2], B0[2][2], B1[2][2];
    const char* cA = (const char*)g.A + (size_t)cur.pm * tstep; const char* cB = (const char*)g.Bt + (size_t)cur.pn * tstep;
    if constexpr (SP2) {
        PG8_STAGE(PG8_SB(0, 0), cB, voffB); PG8_STAGE(PG8_SB(0, 1), cB + hstep, voffB); PG8_STAGE(PG8_SA(0, 0), cA, voffA); PG8_STAGE(PG8_SA(0, 1), cA + hstep, voffA);
        if (wr == 1) PG8_BAR;
        PG8_WAIT_V(2); PG8_BAR;
        PG8_STAGE(PG8_SB(1, 0), cB + kstep, voffB); PG8_STAGE(PG8_SA(1, 0), cA + kstep, voffA); PG8_STAGE(PG8_SB(1, 1), cB + hstep + kstep, voffB);
        PG8_WAIT_V(6); PG8_BAR;
    } else {
        PG8_STAGE(PG8_SB(0, 0), cB, voffB); PG8_STAGE(PG8_SA(0, 0), cA, voffA); PG8_STAGE(PG8_SB(0, 1), cB + hstep, voffB); PG8_STAGE(PG8_SA(0, 1), cA + hstep, voffA);
        if (wr == 1) PG8_BAR;
        PG8_WAIT_V(4); PG8_BAR;
        PG8_STAGE(PG8_SB(1, 0), cB + kstep, voffB); PG8_STAGE(PG8_SA(1, 0), cA + kstep, voffA); PG8_STAGE(PG8_SB(1, 1), cB + hstep + kstep, voffB);
        PG8_WAIT_V(6); PG8_BAR;
    }
    LAS unsigned char* ssimg = lds + STAGE_BYTES;
    const LAS float* rstd_tab = (const LAS float*)(lds + STAGE_BYTES + 16384);
    for (;;) {
        const bool has_next = S.next(ui + 1, nxt);
        const char* nA = has_next ? (const char*)g.A + (size_t)nxt.pm * tstep : cA; const char* nB = has_next ? (const char*)g.Bt + (size_t)nxt.pn * tstep : cB;
        for (int t = 0; t < nt; t += 2) {
            const bool last = (t == nt - 2);
            const char* a1 = cA + (size_t)(t + 1) * kstep;
            const char* a2 = last ? nA : cA + (size_t)(t + 2) * kstep; const char* b2 = last ? nB : cB + (size_t)(t + 2) * kstep;
            const char* a3 = a2 + kstep; const char* b3 = b2 + kstep;
            if constexpr (Epi::USES_RSTD) { if (last) {
                unsigned loff = lane * 16; asm volatile("" : "+v"(loff));
                const char* sp = (const char*)E.ss + (size_t)cur.pm * 16384 + wid * 2048 + loff;
                __builtin_amdgcn_global_load_lds((const unsigned*)sp, (LAS unsigned*)(ssimg + wid * 2048), 16, 0, 0);
                __builtin_amdgcn_global_load_lds((const unsigned*)(sp + 1024), (LAS unsigned*)(ssimg + wid * 2048 + 1024), 16, 0, 0); } }
            if constexpr (SP2) {
            PG8_LDB(B0, 0, 0); PG8_LDB(B1, 0, 1); PG8_SCHED; PG8_LDA(At, 0, 0); PG8_STAGE(PG8_SA(1, 1), a1 + hstep, voffA);
            PG8_WAIT_V(8); PG8_WAIT_L(0); PG8_BAR; PG8_MMA(0, 0, At, B0); PG8_MMA(0, 1, At, B1); PG8_BAR; PG8_SCHED;
            PG8_LDA(At, 0, 1); PG8_STAGE(PG8_SB(0, 0), b2, voffB); PG8_STAGE(PG8_SB(0, 1), b2 + hstep, voffB); PG8_STAGE(PG8_SA(0, 0), a2, voffA);
            PG8_WAIT_V(8); PG8_WAIT_L(0); PG8_BAR; PG8_MMA(1, 0, At, B0); PG8_MMA(1, 1, At, B1); PG8_BAR; PG8_SCHED;
            PG8_LDB(B0, 1, 0); PG8_LDB(B1, 1, 1); PG8_SCHED; PG8_LDA(At, 1, 0); PG8_STAGE(PG8_SA(0, 1), a2 + hstep, voffA);
            PG8_WAIT_V(8); PG8_WAIT_L(0); PG8_BAR; PG8_MMA(0, 0, At, B0); PG8_MMA(0, 1, At, B1); PG8_BAR; PG8_SCHED;
            PG8_LDA(At, 1, 1); PG8_STAGE(PG8_SB(1, 0), b3, voffB); PG8_STAGE(PG8_SB(1, 1), b3 + hstep, voffB); PG8_STAGE(PG8_SA(1, 0), a3, voffA);
            PG8_WAIT_V(8); PG8_WAIT_L(0); PG8_BAR; PG8_MMA(1, 0, At, B0); PG8_MMA(1, 1, At, B1); PG8_BAR; PG8_SCHED;
            } else {
            PG8_LDB(B0, 0, 0); PG8_SCHED; PG8_LDA(At, 0, 0); PG8_STAGE(PG8_SA(1, 1), a1 + hstep, voffA);
            PG8_WAIT_L(8); PG8_BAR; PG8_WAIT_L(0); PG8_MMA(0, 0, At, B0); PG8_BAR; PG8_SCHED;
            PG8_LDB(B1, 0, 1); PG8_STAGE(PG8_SB(0, 0), b2, voffB);
            PG8_BAR; PG8_WAIT_L(0); PG8_MMA(0, 1, At, B1); PG8_BAR;
            PG8_LDA(At, 0, 1); PG8_STAGE(PG8_SA(0, 0), a2, voffA);
            PG8_BAR; PG8_WAIT_L(0); PG8_MMA(1, 0, At, B0); PG8_BAR; PG8_SCHED;
            PG8_STAGE(PG8_SB(0, 1), b2 + hstep, voffB);
            PG8_WAIT_V(6); PG8_BAR; PG8_MMA(1, 1, At, B1); PG8_BAR;
            PG8_LDB(B0, 1, 0); PG8_SCHED; PG8_LDA(At, 1, 0); PG8_STAGE(PG8_SA(0, 1), a2 + hstep, voffA);
            PG8_WAIT_L(8); PG8_BAR; PG8_WAIT_L(0); PG8_MMA(0, 0, At, B0); PG8_BAR; PG8_SCHED;
            PG8_LDB(B1, 1, 1); PG8_STAGE(PG8_SB(1, 0), b3, voffB);
            PG8_BAR; PG8_WAIT_L(0); PG8_MMA(0, 1, At, B1); PG8_BAR;
            PG8_LDA(At, 1, 1); PG8_STAGE(PG8_SA(1, 0), a3, voffA);
            PG8_BAR; PG8_WAIT_L(0); PG8_MMA(1, 0, At, B0); PG8_BAR; PG8_SCHED;
            PG8_STAGE(PG8_SB(1, 1), b3 + hstep, voffB);
            PG8_WAIT_V(6); PG8_BAR; PG8_MMA(1, 1, At, B1); PG8_BAR;
            }
        }
        if constexpr (Epi::USES_RSTD) {
            const LAS f32x4* sp = (const LAS f32x4*)(ssimg + tid * 32);
            const f32x4 sv = sp[0] + sp[1]; float p = (sv.x + sv.y) + (sv.z + sv.w); p += __shfl_xor(p, 1);
            if (!(tid & 1)) ((LAS float*)(lds + STAGE_BYTES + 16384))[tid >> 1] = rsqrtf(p * (1.0f / 1024.0f) + EPS);
        }
        if constexpr (ALIGN_EPI) { if (wr == 0) PG8_BAR; }
        if constexpr (Epi::USES_RSTD) {
            if (ui == 0 && wait_ctr != nullptr && tid == 0) {
                unsigned sp_ = 0u; while (xb_ld(wait_ctr) < wait_val) { __builtin_amdgcn_s_sleep(1); if (++sp_ > (XB_SPIN_CAP << 8)) break; } }
            PG8_WAIT_L(0); PG8_BAR; }
        if constexpr (Epi::FINAL) {
            E.pre(acc, cur, wr, wc, fr, fq);
            asm volatile("s_waitcnt vmcnt(0)" ::: "memory"); PG8_BAR;
            if (tid == 0) { unsigned* f_ = E.flags + 16 * cur.pm; (void)xb_add(f_, 1u);
                unsigned sp_ = 0u; while (xb_ld(f_) < 4u) { __builtin_amdgcn_s_sleep(1); if (++sp_ > (XB_SPIN_CAP << 8)) break; } }
            PG8_BAR;
            { unsigned loff = lane * 16; asm volatile("" : "+v"(loff));
              const char* sp = (const char*)E.ss + (size_t)cur.pm * 16384 + wid * 2048 + loff;
              __builtin_amdgcn_global_load_lds((const unsigned*)sp, (LAS unsigned*)(ssimg + wid * 2048), 16, 0, PG8_AUX_SC1);
              __builtin_amdgcn_global_load_lds((const unsigned*)(sp + 1024), (LAS unsigned*)(ssimg + wid * 2048 + 1024), 16, 0, PG8_AUX_SC1); }
            asm volatile("s_waitcnt vmcnt(0)" ::: "memory"); PG8_BAR;
            { const LAS f32x4* sp = (const LAS f32x4*)(ssimg + tid * 32);
              const f32x4 sv = sp[0] + sp[1]; float p = (sv.x + sv.y) + (sv.z + sv.w); p += __shfl_xor(p, 1);
              if (!(tid & 1)) ((LAS float*)(lds + STAGE_BYTES + 16384))[tid >> 1] = rsqrtf(p * (1.0f / 1024.0f) + EPS); }
            PG8_WAIT_L(0); PG8_BAR;
            E.post(acc, cur, wr, wc, fr, fq, rstd_tab);
        } else
        E(acc, cur, wr, wc, fr, fq, rstd_tab);
        if (!has_next) break;
#pragma unroll
        for (int a = 0; a < 2; ++a)
#pragma unroll
            for (int b = 0; b < 2; ++b)
#pragma unroll
                for (int m = 0; m < 4; ++m)
#pragma unroll
                    for (int n = 0; n < 2; ++n) acc[a][b][m][n] = (f32x4){0.f, 0.f, 0.f, 0.f};
        cur = nxt; cA = nA; cB = nB; ++ui;
        if constexpr (ALIGN_EPI) { if (wr == 1) PG8_BAR; }
    }
    PG8_WAIT_V(0);
    if constexpr (!ALIGN_EPI) { if (wr == 0) PG8_BAR; }
    PG8_BAR;
#undef PG8_SA
#undef PG8_SB
#undef PG8_STAGE
#undef PG8_LDA
#undef PG8_LDB
#undef PG8_MMA
#undef PG8_WAIT_V
#undef PG8_WAIT_L
#undef PG8_BAR
#undef PG8_SCHED
}
}

struct Args {
    const float* x; const float* even_w_in; const float* even_w_out; const float* a_w_s; const float* a_b_s; const float* a_ln_g; const float* a_ln_b;
    const float* b_w_pool; const float* b_scale; const float* odd_w_in; const float* odd_w_out; const float* c_w_dw; const float* c_b_dw; const float* c_ln_g; const float* c_ln_b;
    const float* d_w_dw; const float* norm_mix_g; const float* norm_ffn_g; const float* ffn_w_gate; const float* ffn_w_up; const float* ffn_w_down; const float* final_norm_g;
    float* out; unsigned char* ws; int ph_lo, ph_hi;
};

typedef const __attribute__((address_space(4))) Args* KArgsPtr;
__device__ __forceinline__ KArgsPtr fresh_args() { return (KArgsPtr)opaque_uniform_u64((unsigned long long)__builtin_amdgcn_kernarg_segment_ptr()); }

constexpr int P0_SCR_BYTES = 64 * 65 * 4;
__device__ __forceinline__ void p0_transpose_item(const float* W, int K, int N, bf16_t* WT, int grp, int gstride, int goff, const float* gk, LAS float* scr, int item, int lane, int oddmap = 0) {
    const int nblk = N / 64, kb = item / nblk, nb = item % nblk, k0 = 64 * kb, n0 = 64 * nb;
    const int lr = lane >> 4, lc = 4 * (lane & 15);
    f32x4 v[16];
#pragma unroll
    for (int i = 0; i < 16; ++i) v[i] = __builtin_nontemporal_load((const f32x4*)(W + (size_t)(k0 + 4 * i + lr) * N + n0 + lc));
#pragma unroll
    for (int i = 0; i < 16; ++i) { LAS float* p = scr + (4 * i + lr) * 65 + lc; p[0] = v[i].x; p[1] = v[i].y; p[2] = v[i].z; p[3] = v[i].w; }
    asm volatile("s_waitcnt lgkmcnt(0)" ::: "memory");
    const int c = lane & 7;
    float gv[8];
    if (gk) { const f32x4 g0 = *(const f32x4*)(gk + k0 + 8 * c), g1 = *(const f32x4*)(gk + k0 + 8 * c + 4);
#pragma unroll
        for (int j = 0; j < 4; ++j) { gv[j] = g0[j]; gv[4 + j] = g1[j]; } }
    else {
#pragma unroll
        for (int j = 0; j < 8; ++j) gv[j] = 1.0f; }
    int drow0 = (n0 / grp) * gstride + goff + (n0 % grp);
    if (oddmap) {
        const int seg = n0 >> 9, c0 = n0 & 511, pr = (c0 >> 7) * 256 + (c0 & 127);
        drow0 = seg == 0 ? pr : seg == 1 ? pr + 128 : seg == 2 ? 2048 + c0 : seg == 3 ? 1024 + pr : 1024 + pr + 128;
    }
#pragma unroll
    for (int j = 0; j < 8; ++j) { const int n = (lane >> 3) + 8 * j; const LAS float* s = scr + (8 * c) * 65 + n;
        float o[8];
#pragma unroll
        for (int e = 0; e < 8; ++e) o[e] = s[e * 65] * gv[e];
        __builtin_nontemporal_store(pack8(o), (u32x4*)(WT + (size_t)(drow0 + n) * K + k0 + 8 * c)); }
    asm volatile("s_waitcnt lgkmcnt(0)" ::: "memory");
}

__device__ __forceinline__ void p0_prologue(LAS unsigned char* lds, int vcu, int G, int wave_id) {
    const __attribute__((address_space(4))) Args& A = *fresh_args();
    int tid_ = phase_tid(wave_id);
    const int tid = tid_, lane = tid & 63, wave = __builtin_amdgcn_readfirstlane(tid >> 6);
    LAS float* scr = (LAS float*)(lds + wave * P0_SCR_BYTES);
    const int gw = vcu * NWAVES + wave, NGW = G * NWAVES;
    unsigned char* ws = A.ws;
    constexpr int I_IN0 = 16 * (EVEN_IN / 64), I_OUT = 16 * (D / 64), I_FF = 16 * (DFF / 64), I_DN = (DFF / 64) * (D / 64), I_IN1 = 16 * (ODD_IN / 64), I_WP = 2 * 2;
    constexpr int PER_LAYER_FFN = 2 * I_FF + I_DN;
    constexpr int NITEMS = I_IN0 + I_OUT + I_IN1 + I_OUT + 2 * PER_LAYER_FFN + 4 * I_WP;
    for (int it = gw; it < NITEMS; it += NGW) {
        int r = it;
        if (r < I_IN0) { p0_transpose_item(A.even_w_in, D, EVEN_IN, (bf16_t*)(ws + WS_WIN0), EVEN_IN, 0, 0, A.norm_mix_g, scr, r, lane); continue; } r -= I_IN0;
        if (r < I_OUT) { p0_transpose_item(A.even_w_out, D, D, (bf16_t*)(ws + WS_WOUT0), D, 0, 0, nullptr, scr, r, lane); continue; } r -= I_OUT;
        if (r < I_IN1) { p0_transpose_item(A.odd_w_in, D, ODD_IN, (bf16_t*)(ws + WS_WIN1), ODD_IN, 0, 0, A.norm_mix_g + D, scr, r, lane, 1); continue; } r -= I_IN1;
        if (r < I_OUT) { p0_transpose_item(A.odd_w_out, D, D, (bf16_t*)(ws + WS_WOUT1), D, 0, 0, nullptr, scr, r, lane); continue; } r -= I_OUT;
        if (r < 2 * PER_LAYER_FFN) {
            const int layer = r / PER_LAYER_FFN; r -= layer * PER_LAYER_FFN;
            bf16_t* wgu = (bf16_t*)(ws + (layer ? WS_WGU1 : WS_WGU0)); bf16_t* wdn = (bf16_t*)(ws + (layer ? WS_WDN1 : WS_WDN0));
            const float* gk = A.norm_ffn_g + layer * D;
            if (r < I_FF) { p0_transpose_item(A.ffn_w_gate + (size_t)layer * D * DFF, D, DFF, wgu, 128, 256, 0, gk, scr, r, lane); continue; } r -= I_FF;
            if (r < I_FF) { p0_transpose_item(A.ffn_w_up + (size_t)layer * D * DFF, D, DFF, wgu, 128, 256, 128, gk, scr, r, lane); continue; } r -= I_FF;
            p0_transpose_item(A.ffn_w_down + (size_t)layer * DFF * D, DFF, D, wdn, D, 0, 0, nullptr, scr, r, lane); continue;
        }
        r -= 2 * PER_LAYER_FFN;
        { const int g = r / I_WP; r -= g * I_WP;
          p0_transpose_item(A.b_w_pool + (size_t)g * 128 * 128, 128, 128, (bf16_t*)(ws + WS_WP) + (size_t)g * 128 * 128, 128, 0, 0, nullptr, scr, r, lane); }
    }
    { bf16_t* wm = (bf16_t*)(ws + WS_WS);
      for (int e = (vcu * NTHREADS + tid) * 2; e < 4 * 128 * 128; e += G * NTHREADS * 2) {
          const int i = (e >> 7) & 127, j = e & 127; const bool keep = (i >> 6) >= (j >> 6);
          const float a = keep ? A.a_w_s[e] : 0.f, b = keep ? A.a_w_s[e + 1] : 0.f;
          *(unsigned*)(wm + e) = cvt_pk_bf16(a, b); } }
    { bf16_t* xb = (bf16_t*)(ws + WS_XB); float* ss = (float*)(ws + WS_SS);
      for (int m0 = gw * 4; m0 < M_TOK; m0 += NGW * 4) {
          f32x4 v[4][4];
#pragma unroll
          for (int r = 0; r < 4; ++r)
#pragma unroll
              for (int j = 0; j < 4; ++j) v[r][j] = __builtin_nontemporal_load((const f32x4*)(A.x + (size_t)(m0 + r) * D) + lane + 64 * j);
#pragma unroll
          for (int r = 0; r < 4; ++r) {
              float s = 0.f;
#pragma unroll
              for (int j = 0; j < 4; ++j) s += (v[r][j].x * v[r][j].x + v[r][j].y * v[r][j].y) + (v[r][j].z * v[r][j].z + v[r][j].w * v[r][j].w);
              s = wave_sum(s);
              u32x2* o8 = (u32x2*)(xb + (size_t)(m0 + r) * D) + lane;
#pragma unroll
              for (int j = 0; j < 4; ++j) { u32x2 w; w.x = cvt_pk_bf16(v[r][j].x, v[r][j].y); w.y = cvt_pk_bf16(v[r][j].z, v[r][j].w); o8[64 * j] = w; }
              if (lane < 4) { f32x4 t = (f32x4){0.f, 0.f, 0.f, 0.f}; if (lane == 0) t.x = s; *((f32x4*)(ss + (size_t)(m0 + r) * 16) + lane) = t; }
          }
      } }
}

constexpr int VN_STRIDE = 1056;
constexpr int PL_STRIDE = 1040;
__device__ __forceinline__ float seg16_sum(float v) { v += __shfl_xor(v, 1); v += __shfl_xor(v, 2); v += __shfl_xor(v, 4); v += __shfl_xor(v, 8); return v; }

template <int NCH> struct PoolVec;
template <> struct PoolVec<8> { typedef u32x4 T; static __device__ __forceinline__ T zero() { return (u32x4){0u, 0u, 0u, 0u}; }
    static __device__ __forceinline__ void unpack(const T r, float (&v)[8]) { unpack8(r, v); }
    static __device__ __forceinline__ T pack(const float (&v)[8]) { return pack8(v); } };
template <> struct PoolVec<4> { typedef u32x2 T; static __device__ __forceinline__ T zero() { return (u32x2){0u, 0u}; }
    static __device__ __forceinline__ void unpack(const T r, float (&v)[4]) { v[0] = bf_lo(r.x); v[1] = bf_hi(r.x); v[2] = bf_lo(r.y); v[3] = bf_hi(r.y); }
    static __device__ __forceinline__ T pack(const float (&v)[4]) { T o; o.x = cvt_pk_bf16(v[0], v[1]); o.y = cvt_pk_bf16(v[2], v[3]); return o; } };
template <int WIN, int NCH> __device__ __forceinline__ void pool_segment(const bf16_t* zp  , int posb, LAS unsigned char* dst  ) {
    typedef PoolVec<NCH> PV; typedef typename PV::T VT;
    constexpr int NR = 16 + WIN - 1;
    VT raw[NR];
#pragma unroll
    for (int i = 0; i < NR; ++i) { const int rel = i - (WIN - 1); const int relc = (posb + rel >= 0) ? rel : -posb;
        raw[i] = *(const VT*)(zp + (long)relc * EVEN_IN); }
#pragma unroll
    for (int i = 0; i < WIN - 1; ++i) { const int rel = i - (WIN - 1); if (posb + rel < 0) raw[i] = PV::zero(); }
    float s[NCH];
#pragma unroll
    for (int j = 0; j < NCH; ++j) s[j] = 0.f;
#pragma unroll
    for (int i = 0; i < WIN - 1; ++i) { float x[NCH]; PV::unpack(raw[i], x);
#pragma unroll
        for (int j = 0; j < NCH; ++j) s[j] += x[j]; }
#pragma unroll
    for (int i = 0; i < 16; ++i) {
        float x[NCH]; PV::unpack(raw[i + WIN - 1], x);
        const int pos = posb + i; const int cnt = (pos + 1 < WIN) ? pos + 1 : WIN; const float inv = 1.0f / (float)cnt;
        float o[NCH];
#pragma unroll
        for (int j = 0; j < NCH; ++j) { s[j] += x[j]; o[j] = s[j] * inv - x[j]; }
        *(LAS VT*)(dst + i * PL_STRIDE) = PV::pack(o);
        float y[NCH]; PV::unpack(raw[i], y);
#pragma unroll
        for (int j = 0; j < NCH; ++j) s[j] -= y[j];
    }
}

__device__ __forceinline__ void mixer_even(LAS unsigned char* lds, int vcu, int G, int wave_id) {
    const __attribute__((address_space(4))) Args& A = *fresh_args();
    int tid_ = phase_tid(wave_id);
    const int tid = tid_, lane = tid & 63, w = __builtin_amdgcn_readfirstlane(tid >> 6), fr = lane & 15, fq = lane >> 4;
    const bf16_t* Z = (const bf16_t*)(A.ws + WS_Z); bf16_t* Y = (bf16_t*)(A.ws + WS_Y);
    const bf16_t* Wm = (const bf16_t*)(A.ws + WS_WS); const bf16_t* WpT = (const bf16_t*)(A.ws + WS_WP);
    const int hg = w >> 1, dh = w & 1;
    for (int blk = vcu; blk < M_TOK / 128; blk += G) {
        const int row_base = blk * 128; const int pos_base = row_base & (SEQ - 1);
        {
            const int c = hg * 128 + 8 * fr, sg = dh * 4 + fq, ts = 16 * sg;
            const bf16_t* zp = Z + (size_t)(row_base + ts) * EVEN_IN + 1024 + c;
            LAS unsigned char* dst = lds + ts * PL_STRIDE + c * 2;
            if (hg == 0) pool_segment<2, 8>(zp, pos_base + ts, dst);
            else if (hg == 1) pool_segment<4, 8>(zp, pos_base + ts, dst);
            else if (hg == 2) pool_segment<8, 8>(zp, pos_base + ts, dst);
            else { pool_segment<16, 4>(zp, pos_base + ts, dst); pool_segment<16, 4>(zp + 4, pos_base + ts, dst + 8); }
        }
        bf16x8 wpf[4][4];
        { const bf16_t* WpT_ = WpT; OPAQUE_S(WpT_);
#pragma unroll
        for (int n = 0; n < 4; ++n)
#pragma unroll
            for (int ks = 0; ks < 4; ++ks) wpf[n][ks] = *(const bf16x8*)(WpT_ + ((size_t)(hg * 128 + dh * 64 + n * 16 + fr) * 128 + ks * 32 + 8 * fq)); }
        __syncthreads();
        {
            f32x4 sc[4]; const float* bsc = A.b_scale; OPAQUE_S(bsc);
#pragma unroll
            for (int n = 0; n < 4; ++n) sc[n] = *(const f32x4*)(bsc + hg * 128 + dh * 64 + n * 16 + 4 * fq);
#pragma unroll 2
            for (int m = 0; m < 8; ++m) {
                f32x4 acc[4];
#pragma unroll
                for (int n = 0; n < 4; ++n) acc[n] = (f32x4){0.f, 0.f, 0.f, 0.f};
#pragma unroll
                for (int ks = 0; ks < 4; ++ks) {
                    const bf16x8 pf = *(const LAS bf16x8*)(lds + (m * 16 + fr) * PL_STRIDE + (hg * 128 + ks * 32 + 8 * fq) * 2);
#pragma unroll
                    for (int n = 0; n < 4; ++n) acc[n] = __builtin_amdgcn_mfma_f32_16x16x32_bf16(wpf[n][ks], pf, acc[n], 0, 0, 0);
                }
                const size_t row = (size_t)(row_base + m * 16 + fr);
#pragma unroll
                for (int n = 0; n < 4; ++n) {
                    u32x2 o; o.x = cvt_pk_bf16(acc[n].x * sc[n].x, acc[n].y * sc[n].y); o.y = cvt_pk_bf16(acc[n].z * sc[n].z, acc[n].w * sc[n].w);
                    *(u32x2*)(Y + row * D + 512 + hg * 128 + dh * 64 + n * 16 + 4 * fq) = o;
                }
            }
        }
        __syncthreads();
        {
            u32x4 raw[4][4];
#pragma unroll
            for (int r = 0; r < 4; ++r)
#pragma unroll
                for (int j = 0; j < 4; ++j) raw[r][j] = *(const u32x4*)(Z + (size_t)(row_base + 16 * w + 4 * r + fq) * EVEN_IN + 512 + 128 * j + 8 * fr);
            float mu[4], rstd[4];
#pragma unroll
            for (int r = 0; r < 4; ++r) {
                float s = 0.f, q = 0.f;
#pragma unroll
                for (int j = 0; j < 4; ++j) { float v[8]; unpack8(raw[r][j], v);
#pragma unroll
                    for (int e = 0; e < 8; ++e) { s += v[e]; q += v[e] * v[e]; } }
                s = seg16_sum(s); q = seg16_sum(q);
                mu[r] = s * (1.0f / 512.0f); const float var = fmaxf(q * (1.0f / 512.0f) - mu[r] * mu[r], 0.f); rstd[r] = rsqrtf(var + EPS);
            }
            const float* lgp = A.a_ln_g; const float* lbp = A.a_ln_b; OPAQUE_S(lgp); OPAQUE_S(lbp);
#pragma unroll
            for (int j = 0; j < 4; ++j) {
                const f32x4 g0 = *(const f32x4*)(lgp + 128 * j + 8 * fr), g1 = *(const f32x4*)(lgp + 128 * j + 8 * fr + 4), b0 = *(const f32x4*)(lbp + 128 * j + 8 * fr), b1 = *(const f32x4*)(lbp + 128 * j + 8 * fr + 4);
#pragma unroll
                for (int r = 0; r < 4; ++r) {
                    float v[8], o[8]; unpack8(raw[r][j], v);
#pragma unroll
                    for (int e = 0; e < 4; ++e) { o[e] = (v[e] - mu[r]) * rstd[r] * g0[e] + b0[e]; o[4 + e] = (v[4 + e] - mu[r]) * rstd[r] * g1[e] + b1[e]; }
                    *(LAS u32x4*)(lds + (16 * w + 4 * r + fq) * VN_STRIDE + (128 * j + 8 * fr) * 2) = pack8(o);
                }
            }
        }
        __syncthreads();
        {
            const int h = hg;
            const int q4 = (lane >> 2) & 3, p4 = lane & 3;
            const LAS unsigned char* vbase = lds + (4 * fq + q4) * VN_STRIDE + (h * 128 + dh * 64 + 4 * p4) * 2;
#pragma unroll
            for (int mh = 0; mh < 2; ++mh) {
                u32x2 wlo[4][4], whi[4][4]; const bf16_t* Wm_ = Wm; OPAQUE_S(Wm_);
#pragma unroll
                for (int m = 0; m < 4; ++m)
#pragma unroll
                    for (int ks = 0; ks < 4; ++ks) {
                        if (mh == 0 && ks >= 2) continue;
                        const bf16_t* wp = Wm_ + ((size_t)(h * 128 + (4 * mh + m) * 16 + fr) * 128 + ks * 32 + 4 * fq);
                        wlo[m][ks] = *(const u32x2*)wp; whi[m][ks] = *(const u32x2*)(wp + 16);
                    }
                u32x2 ur[4][4]; const float* abs_ = A.a_b_s; OPAQUE_S(abs_);
#pragma unroll
                for (int m = 0; m < 4; ++m)
#pragma unroll
                    for (int n = 0; n < 4; ++n) ur[m][n] = *(const u32x2*)(Z + (size_t)(row_base + (4 * mh + m) * 16 + fr) * EVEN_IN + h * 128 + dh * 64 + n * 16 + 4 * fq);
                f32x4 acc[4][4];
#pragma unroll
                for (int m = 0; m < 4; ++m)
#pragma unroll
                    for (int n = 0; n < 4; ++n) acc[m][n] = (f32x4){0.f, 0.f, 0.f, 0.f};
#pragma unroll
                for (int ks = 0; ks < 4; ++ks) {
                    if (mh == 0 && ks >= 2) continue;
                    bf16x8 vf[4];
#pragma unroll
                    for (int n = 0; n < 4; ++n) {
                        const s16x4 lo = __builtin_amdgcn_ds_read_tr16_b64_v4i16((LAS s16x4*)(vbase + (ks * 32) * VN_STRIDE + n * 32));
                        const s16x4 hi = __builtin_amdgcn_ds_read_tr16_b64_v4i16((LAS s16x4*)(vbase + (ks * 32 + 16) * VN_STRIDE + n * 32));
                        vf[n] = (bf16x8){lo.x, lo.y, lo.z, lo.w, hi.x, hi.y, hi.z, hi.w};
                    }
#pragma unroll
                    for (int m = 0; m < 4; ++m) {
                        union { u32x4 u; bf16x8 b; } wf; wf.u = (u32x4){wlo[m][ks].x, wlo[m][ks].y, whi[m][ks].x, whi[m][ks].y};
#pragma unroll
                        for (int n = 0; n < 4; ++n) acc[m][n] = __builtin_amdgcn_mfma_f32_16x16x32_bf16(vf[n], wf.b, acc[m][n], 0, 0, 0);
                    }
                }
#pragma unroll
                for (int m = 0; m < 4; ++m) {
                    const int i = (4 * mh + m) * 16 + fr; const float bs = abs_[h * 128 + i]; const size_t row = (size_t)(row_base + i);
#pragma unroll
                    for (int n = 0; n < 4; ++n) {
                        const int d = h * 128 + dh * 64 + n * 16 + 4 * fq;
                        const f32x4 sv = acc[m][n];
                        u32x2 o; o.x = cvt_pk_bf16(bf_lo(ur[m][n].x) * (sv.x + bs), bf_hi(ur[m][n].x) * (sv.y + bs)); o.y = cvt_pk_bf16(bf_lo(ur[m][n].y) * (sv.z + bs), bf_hi(ur[m][n].y) * (sv.w + bs));
                        *(u32x2*)(Y + row * D + d) = o;
                    }
                }
            }
        }
        __syncthreads();
    }
}

template <int S, int T> __device__ __forceinline__ void conv_t(f32x2 (&acc)[32], const f32x2 (&wt)[31], const f32x2 hv) {
    if constexpr (T < 32) { if constexpr (S - T >= 0 && S - T <= 30) acc[T] = acc[T] + wt[S - T] * hv; conv_t<S, T + 1>(acc, wt, hv); }
}
template <int S> __device__ __forceinline__ void conv_s(f32x2 (&acc)[32], const f32x2 (&wt)[31], const LAS unsigned char* hp) {
    if constexpr (S < 62) {
        const unsigned hr = *(const LAS unsigned*)(hp + S * 1024);
        conv_t<S, 0>(acc, wt, (f32x2){bf_lo(hr), bf_hi(hr)});
        conv_s<S + 1>(acc, wt, hp);
    }
}
__device__ __forceinline__ void mixer_odd(LAS unsigned char* lds, int vcu, int G, int wave_id) {
    const __attribute__((address_space(4))) Args& A = *fresh_args();
    int tid_ = phase_tid(wave_id);
    const int tid = tid_, lane = tid & 63, w = __builtin_amdgcn_readfirstlane(tid >> 6), fr = lane & 15, fq = lane >> 4;
    const bf16_t* Z = (const bf16_t*)(A.ws + WS_Z); bf16_t* Y = (bf16_t*)(A.ws + WS_Y);
    constexpr int TT = 64, HALO = 30, HROWS = TT + HALO;
    const int tpv = (M_TOK / TT) / G, contig = (tpv * G == M_TOK / TT);
    for (int ti = 0; ti * G + vcu < M_TOK / TT; ++ti) {
        const int tile = contig ? vcu * tpv + ti : ti * G + vcu;
        const int t0 = tile * TT; const int pos0 = t0 & (SEQ - 1);
        for (int r = w; r < HROWS; r += NWAVES) {
            if (pos0 + r - HALO >= 0) __builtin_amdgcn_global_load_lds((const unsigned*)(Z + (size_t)(t0 + r - HALO) * EVEN_IN + 8 * lane), (LAS unsigned*)(lds + r * 1024), 16, 0, 0);
            else *(LAS u32x4*)(lds + r * 1024 + lane * 16) = (u32x4){0u, 0u, 0u, 0u};
        }
        asm volatile("s_waitcnt vmcnt(0)" ::: "memory");
        __syncthreads();
        const int cp = tid & 255, th = tid >> 8;
        f32x2 acc[32];
        {
            f32x2 wt[31];
            const float* cw = A.c_w_dw; OPAQUE_S(cw); const float* cb = A.c_b_dw; OPAQUE_S(cb);
            const float* wbase = cw + 2 * cp;
#pragma unroll
            for (int j = 0; j < 31; ++j) wt[j] = *(const f32x2*)(wbase + j * 512);
            const f32x2 bias = *(const f32x2*)(cb + 2 * cp);
#pragma unroll
            for (int t = 0; t < 32; ++t) acc[t] = bias;
            const LAS unsigned char* hp = lds + (32 * th) * 1024 + 4 * cp;
            conv_s<0>(acc, wt, hp);
        }
        __syncthreads();
#pragma unroll
        for (int t = 0; t < 32; ++t) *(LAS unsigned*)(lds + (32 * th + t) * 1024 + 4 * cp) = cvt_pk_bf16(acc[t].x, acc[t].y);
        {
            const int c8 = tid & 63, tg = tid >> 6;
            float w0[8], w1[8], w2[8];
            { const float* dw = A.d_w_dw; OPAQUE_S(dw); const float* wp = dw + 8 * c8;
              const f32x4 a0 = *(const f32x4*)wp, a1 = *(const f32x4*)(wp + 4), b0 = *(const f32x4*)(wp + 512), b1 = *(const f32x4*)(wp + 516), c0 = *(const f32x4*)(wp + 1024), c1 = *(const f32x4*)(wp + 1028);
#pragma unroll
              for (int j = 0; j < 4; ++j) { w0[j] = a0[j]; w0[4 + j] = a1[j]; w1[j] = b0[j]; w1[4 + j] = b1[j]; w2[j] = c0[j]; w2[4 + j] = c1[j]; } }
#pragma unroll 1
            for (int rd = 0; rd < 2; ++rd) {
                const int tk0 = 8 * tg + 4 * rd;
                const bf16_t* zp = Z + (size_t)(t0 + tk0) * EVEN_IN + 512 + 8 * c8;
                u32x4 rp[6], rb[4];
#pragma unroll
                for (int i = 0; i < 6; ++i) { const int rel = i - 2; const int relc = (pos0 + tk0 + rel >= 0) ? rel : 0;
                    rp[i] = *(const u32x4*)(zp + (long)relc * EVEN_IN);
                    if (pos0 + tk0 + rel < 0) rp[i] = (u32x4){0u, 0u, 0u, 0u}; }
#pragma unroll
                for (int i = 0; i < 4; ++i) rb[i] = *(const u32x4*)(zp + (long)i * EVEN_IN + 512);
                float p[6][8];
#pragma unroll
                for (int i = 0; i < 6; ++i) unpack8(rp[i], p[i]);
#pragma unroll
                for (int i = 0; i < 4; ++i) {
                    float bg[8], o[8]; unpack8(rb[i], bg);
#pragma unroll
                    for (int j = 0; j < 8; ++j) o[j] = bg[j] * (w0[j] * p[i][j] + w1[j] * p[i + 1][j] + w2[j] * p[i + 2][j]);
                    *(u32x4*)(Y + (size_t)(t0 + tk0 + i) * D + 512 + 8 * c8) = pack8(o);
                }
            }
        }
        __syncthreads();
        {
            f32x4 lg[4][2], lb[4][2]; const float* lgp = A.c_ln_g; const float* lbp = A.c_ln_b; OPAQUE_S(lgp); OPAQUE_S(lbp);
#pragma unroll
            for (int j = 0; j < 4; ++j) { lg[j][0] = *(const f32x4*)(lgp + 128 * j + 8 * fr); lg[j][1] = *(const f32x4*)(lgp + 128 * j + 8 * fr + 4);
                                          lb[j][0] = *(const f32x4*)(lbp + 128 * j + 8 * fr); lb[j][1] = *(const f32x4*)(lbp + 128 * j + 8 * fr + 4); }
#pragma unroll
            for (int r = 0; r < 2; ++r) {
                const int tok = 8 * w + 4 * r + fq;
                float v[4][8]; float s = 0.f, q = 0.f;
#pragma unroll
                for (int j = 0; j < 4; ++j) { unpack8(*(const LAS u32x4*)(lds + tok * 1024 + (128 * j + 8 * fr) * 2), v[j]);
#pragma unroll
                    for (int e = 0; e < 8; ++e) { s += v[j][e]; q += v[j][e] * v[j][e]; } }
                s = seg16_sum(s); q = seg16_sum(q);
                const float mu = s * (1.0f / 512.0f); const float var = fmaxf(q * (1.0f / 512.0f) - mu * mu, 0.f); const float rstd = rsqrtf(var + EPS);
#pragma unroll
                for (int j = 0; j < 4; ++j) {
                    float o[8];
#pragma unroll
                    for (int e = 0; e < 4; ++e) { o[e] = silu_f((v[j][e] - mu) * rstd * lg[j][0][e] + lb[j][0][e]); o[4 + e] = silu_f((v[j][4 + e] - mu) * rstd * lg[j][1][e] + lb[j][1][e]); }
                    *(u32x4*)(Y + (size_t)(t0 + tok) * D + 128 * j + 8 * fr) = pack8(o);
                }
            }
        }
        __syncthreads();
    }
}

__device__ __forceinline__ void final_norm(int vcu, int G, int wave_id) {
    const __attribute__((address_space(4))) Args& A = *fresh_args();
    int tid_ = phase_tid(wave_id);
    const int tid = tid_, lane = tid & 63, wave = __builtin_amdgcn_readfirstlane(tid >> 6);
    const int gw = vcu * NWAVES + wave, NGW = G * NWAVES;
    const float* ss = (const float*)(A.ws + WS_SS); const bf16_t* xb = (const bf16_t*)(A.ws + WS_XB);
    f32x4 gg[4];
#pragma unroll
    for (int j = 0; j < 4; ++j) gg[j] = *((const f32x4*)A.final_norm_g + 2 * lane + 128 * (j >> 1) + (j & 1));
    const int gpv = (M_TOK / 4) / G, contig = (gpv * G == M_TOK / 4) && (gpv % NWAVES == 0);
    for (int gi = 0; (gi * NGW + gw) * 4 < M_TOK; ++gi) {
        const int m0 = contig ? (vcu * gpv + gi * NWAVES + wave) * 4 : (gi * NGW + gw) * 4;
        float part[4]; u32x4 raw[4][2];
#pragma unroll
        for (int r = 0; r < 4; ++r) { part[r] = ss[(size_t)(m0 + r) * 16 + (lane & 15)];
            raw[r][0] = __builtin_nontemporal_load((const u32x4*)(xb + (size_t)(m0 + r) * D) + lane); raw[r][1] = __builtin_nontemporal_load((const u32x4*)(xb + (size_t)(m0 + r) * D) + lane + 64); }
#pragma unroll
        for (int r = 0; r < 4; ++r) {
            const float rs = rsqrtf(seg16_sum(part[r]) * (1.0f / 1024.0f) + EPS);
            f32x4* orow = (f32x4*)(A.out + (size_t)(m0 + r) * D);
#pragma unroll
            for (int hh = 0; hh < 2; ++hh) {
                float v[8]; unpack8(raw[r][hh], v);
                orow[128 * hh + 2 * lane] = (f32x4){v[0], v[1], v[2], v[3]} * rs * gg[2 * hh];
                orow[128 * hh + 2 * lane + 1] = (f32x4){v[4], v[5], v[6], v[7]} * rs * gg[2 * hh + 1];
            }
        }
    }
}

#ifndef PG8_SP2
#define PG8_SP2 true
#endif
#ifndef PG8_ALIGN
#define PG8_ALIGN true
#endif
__global__ void __launch_bounds__(NTHREADS, 2) trunk_fwd(Args args) {
    extern __shared__ __attribute__((aligned(16))) unsigned char lds_raw[];
    LAS unsigned char* lds = (LAS unsigned char*)lds_raw;
    const int G = gridDim.x, bx = blockIdx.x;
    const int wave_id = __builtin_amdgcn_readfirstlane(threadIdx.x >> 6);
    const int vcu = (G % 8 == 0) ? (bx % 8) * (G / 8) + bx / 8 : bx;
    const int lo = fresh_args()->ph_lo, hi = fresh_args()->ph_hi;
#define WSP(off) (fresh_args()->ws + (off))
#ifndef KIND_MASK
#define KIND_MASK 0xff
#endif
#define KIND(b) (((KIND_MASK) >> (b)) & 1)
#define IN(k) (lo <= (k) && (k) < hi)
#if USE_CG_SYNC
#define SEAM(k, loc, arr) do { if (IN(k) && IN((k) + 1)) { cg::this_grid().sync(); } } while (0)
#else
    if (threadIdx.x < 4) ((volatile LAS unsigned*)(lds + LDS_MISC_OFF))[threadIdx.x] = 0u;
    __syncthreads();
    XcdBarrier bar = xcd_barrier_post((unsigned*)WSP(WS_CTL) + CW_BAR, (volatile LAS unsigned*)(lds + LDS_MISC_OFF));
    if (lo < 0) cg::this_grid().sync();
#define SEAM(k, loc, arr) do { if (IN(k) && IN((k) + 1)) { xcd_barrier(bar, wave_id, (loc) ? lmode : 0u, (arr)); } } while (0)
#endif

    unsigned lmode = 0u; int bxv = bx, vcv = vcu;
    if (KIND(0) && IN(0)) { for (int rep = 0; rep < NREP(0); ++rep) p0_prologue(lds, vcu, G, wave_id); }
    SEAM(0, 0, 0u);
#if !USE_CG_SYNC
    if (IN(0) && IN(1)) {
        volatile LAS unsigned* st = (volatile LAS unsigned*)(lds + LDS_MISC_OFF);
        lmode = __builtin_amdgcn_readfirstlane(st[3]);
        if (lmode) { bxv = (int)__builtin_amdgcn_readfirstlane(st[2]) * 8 + (int)bar.x; vcv = (bxv % 8) * (G / 8) + bxv / 8; }
    }
#endif
    const bool fused_final = lmode && IN(10) && IN(11);
#pragma unroll 1
    for (int layer = 0; layer < 2; ++layer) {
        const int pb = 1 + 5 * layer;
        if (KIND(1) && IN(pb + 0)) {
            const int N = layer ? ODD_IN : EVEN_IN;
            unsigned char* ws = WSP(0); pg8::Gemm g{(const bf16_t*)(ws + WS_XB), (const bf16_t*)(ws + (layer ? WS_WIN1 : WS_WIN0)), M_TOK, N, D}; pg8::StaticOrder S; S.init(M_TOK, N, G, bxv);
            pg8::EpiScaleBf16 E{(bf16_t*)(ws + WS_Z), layer, (const float*)(ws + WS_SS)};
            pg8::gemm_phase<pg8::EpiScaleBf16, PG8_ALIGN, PG8_SP2>(lds, g, S, E, wave_id, (lmode && layer) ? (unsigned*)ws + (WS_CTL / 4 + CW_BAR + XB_DONE_B) : nullptr, (unsigned)G);
        }
        SEAM(pb + 0, 0, 0u);
        if (IN(pb + 1)) { if (layer == 0) { if (KIND(2)) for (int rep = 0; rep < NREP(2); ++rep) mixer_even(lds, vcv, G, wave_id); } else { if (KIND(3)) for (int rep = 0; rep < NREP(3); ++rep) mixer_odd(lds, vcv, G, wave_id); } }
        SEAM(pb + 1, 1, 0u);
        if (KIND(4) && IN(pb + 2)) {
            unsigned char* ws = WSP(0); pg8::Gemm g{(const bf16_t*)(ws + WS_Y), (const bf16_t*)(ws + (layer ? WS_WOUT1 : WS_WOUT0)), M_TOK, D, D}; pg8::StaticOrder S; S.init(M_TOK, D, G, bxv);
            pg8::EpiResid E{(bf16_t*)(ws + WS_XB), (float*)(ws + WS_SS)};
            pg8::gemm_phase<pg8::EpiResid, PG8_ALIGN, PG8_SP2>(lds, g, S, E, wave_id);
        }
        SEAM(pb + 2, 1, XB_DONE_A);
        if (KIND(5) && IN(pb + 3)) {
            unsigned char* ws = WSP(0); pg8::Gemm g{(const bf16_t*)(ws + WS_XB), (const bf16_t*)(ws + (layer ? WS_WGU1 : WS_WGU0)), M_TOK, GU, D}; pg8::StaticOrder S; S.init(M_TOK, GU, G, bxv);
            pg8::EpiSwiGLU E{(bf16_t*)(ws + WS_ACT), (const float*)(ws + WS_SS)};
            pg8::gemm_phase<pg8::EpiSwiGLU, PG8_ALIGN, PG8_SP2>(lds, g, S, E, wave_id, lmode ? (unsigned*)ws + (WS_CTL / 4 + CW_BAR + XB_DONE_A) : nullptr, (unsigned)G * (unsigned)(layer + 1));
        }
        SEAM(pb + 3, 1, 0u);
        if (KIND(6) && IN(pb + 4)) {
            unsigned char* ws = WSP(0); pg8::Gemm g{(const bf16_t*)(ws + WS_ACT), (const bf16_t*)(ws + (layer ? WS_WDN1 : WS_WDN0)), M_TOK, D, DFF}; pg8::StaticOrder S; S.init(M_TOK, D, G, bxv);
            if (layer == 1 && fused_final) {
                pg8::EpiFinal E{(const bf16_t*)(ws + WS_XB), (float*)(ws + WS_SS), fresh_args()->out, fresh_args()->final_norm_g, (unsigned*)ws + (WS_CTL / 4 + CW_BAR + XB_FIN(0))};
                pg8::gemm_phase<pg8::EpiFinal, PG8_ALIGN, PG8_SP2>(lds, g, S, E, wave_id);
            } else {
            pg8::EpiResid E{(bf16_t*)(ws + WS_XB), (float*)(ws + WS_SS)};
            pg8::gemm_phase<pg8::EpiResid, PG8_ALIGN, PG8_SP2>(lds, g, S, E, wave_id);
            }
        }
        if (!(layer == 1 && fused_final))
        SEAM(pb + 4, 1, layer ? 0u : XB_DONE_B);
    }
    if (KIND(7) && IN(11) && !fused_final) for (int rep = 0; rep < NREP(7); ++rep) final_norm(vcv, G, wave_id);
#undef IN
#undef SEAM
}

extern "C" void kernel_launch(void* const* d_in, const int* in_sizes, int n_in, void* d_out, int out_size, void* d_ws, size_t ws_size, hipStream_t stream) {
    static int grid = 0;
    if (grid == 0) {
        if (n_in != 22 || in_sizes[0] != M_TOK * D || out_size != M_TOK * D || ws_size < WS_END) {
            fprintf(stderr, "kernel_launch: unexpected shapes: n_in %d in0 %d out %d ws %zu (need %zu)\n", n_in, n_in > 0 ? in_sizes[0] : -1, out_size, ws_size, (size_t)WS_END); grid = -1; return; }
        int dev = 0, cus = 0, per_cu = 0;
        if (hipGetDevice(&dev) != hipSuccess || hipDeviceGetAttribute(&cus, hipDeviceAttributeMultiprocessorCount, dev) != hipSuccess) { fprintf(stderr, "kernel_launch: device query failed\n"); grid = -1; return; }
        if (hipFuncSetAttribute((const void*)trunk_fwd, hipFuncAttributeMaxDynamicSharedMemorySize, LDS_BYTES) != hipSuccess) { fprintf(stderr, "kernel_launch: hipFuncSetAttribute failed\n"); grid = -1; return; }
        if (hipOccupancyMaxActiveBlocksPerMultiprocessor(&per_cu, (const void*)trunk_fwd, NTHREADS, LDS_BYTES) != hipSuccess || per_cu < 1) { fprintf(stderr, "kernel_launch: occupancy query says %d blocks/CU\n", per_cu); per_cu = 1; }
        (void)hipGetLastError();
        grid = cus;
        fprintf(stderr, "kernel_launch: cus %d per_cu %d grid %d\n", cus, per_cu, grid);
    }
    if (grid < 0) return;
    Args a{};
    const float** f = (const float**)&a;
    for (int i = 0; i < 22; ++i) f[i] = (const float*)d_in[i];
    const size_t ws_off = ((ws_size - WS_END) / (2 * MiB)) * (2 * MiB);
    a.out = (float*)d_out; a.ws = (unsigned char*)d_ws + ws_off;
#if MK_PER_PHASE
    for (int p = 0; p < 12; ++p) {
        a.ph_lo = p; a.ph_hi = p + 1;
        for (int rep = 0; rep < 1 + ((PROBE_DUP >> p) & 1); ++rep)
            hipLaunchKernelGGL(trunk_fwd, dim3(grid), dim3(NTHREADS), LDS_BYTES, stream, a);
    }
#else
    a.ph_lo = 0; a.ph_hi = 12;
    if (hipMemsetAsync((char*)a.ws + WS_CTL, 0, 65536, stream) != hipSuccess) { fprintf(stderr, "kernel_launch: memset failed\n"); return; }
    void* kargs[] = {&a};
    hipError_t e = hipLaunchCooperativeKernel((const void*)trunk_fwd, dim3(grid), dim3(NTHREADS), kargs, LDS_BYTES, stream);
    if (e != hipSuccess) fprintf(stderr, "kernel_launch: cooperative launch failed: %s (grid %d)\n", hipGetErrorString(e), grid);
#endif
}
```

```cpp
#include <hip/hip_runtime.h>
#include <hip/hip_cooperative_groups.h>
#include <cstdio>
#include <cstdint>
namespace cg = cooperative_groups;

#ifndef MK_PER_PHASE
#define MK_PER_PHASE 0
#endif

#ifndef PROBE_DUPK
#define PROBE_DUPK 0
#endif
#define NREP(k) (1 + (((PROBE_DUPK) >> (k)) & 1))
#ifndef PROBE_DUP
#define PROBE_DUP 0
#endif

#define LAS __attribute__((address_space(3)))
typedef unsigned short bf16_t;
typedef short bf16x8 __attribute__((ext_vector_type(8)));
typedef short s16x4 __attribute__((ext_vector_type(4)));
typedef float f32x4 __attribute__((ext_vector_type(4)));
typedef float f32x2 __attribute__((ext_vector_type(2)));
typedef unsigned u32x4 __attribute__((ext_vector_type(4)));
typedef unsigned u32x2 __attribute__((ext_vector_type(2)));

constexpr int M_TOK = 32768, D = 1024, SEQ = 8192;
constexpr int EVEN_IN = 1536, ODD_IN = 2560, DFF = 2816, GU = 2 * DFF;
constexpr float EPS = 1e-6f;
constexpr int NWAVES = 8, NTHREADS = 512;

constexpr size_t MiB = 1u << 20;
constexpr size_t WS_CTL = 0, CTL_BYTES = 1 * MiB;
constexpr size_t WS_WIN0 = 2 * MiB, WS_WOUT0 = 5 * MiB, WS_WGU0 = 7 * MiB, WS_WDN0 = 18 * MiB;
constexpr size_t WS_WIN1 = 24 * MiB, WS_WOUT1 = 29 * MiB, WS_WGU1 = 31 * MiB, WS_WDN1 = 42 * MiB;
constexpr size_t WS_WS = 48 * MiB, WS_WP = 49 * MiB;
constexpr size_t WS_SS = 50 * MiB;
constexpr size_t WS_XB = 64 * MiB;
constexpr size_t WS_Z = 128 * MiB;
constexpr size_t WS_ACT = 128 * MiB;
constexpr size_t WS_Y = 224 * MiB;
constexpr size_t WS_END = 304 * MiB;

constexpr int LDS_BYTES = 155648;
constexpr int LDS_MISC_OFF = LDS_BYTES - 256;
constexpr int CW_BAR = 4096;
#ifndef USE_CG_SYNC
#define USE_CG_SYNC 0
#endif

__device__ __forceinline__ unsigned cvt_pk_bf16(float lo, float hi) { unsigned r; asm volatile("v_cvt_pk_bf16_f32 %0, %1, %2" : "=v"(r) : "v"(lo), "v"(hi)); return r; }
__device__ __forceinline__ unsigned long long opaque_uniform_u64(unsigned long long v) {
    unsigned lo = __builtin_amdgcn_readfirstlane((unsigned)v), hi = __builtin_amdgcn_readfirstlane((unsigned)(v >> 32));
    asm volatile("" : "+s"(lo), "+s"(hi));
    return ((unsigned long long)hi << 32) | lo;
}
template <class T> __device__ __forceinline__ T* opaque_uniform(T* p) { return (T*)opaque_uniform_u64((unsigned long long)p); }
#define OPAQUE_S(p) p = opaque_uniform(p)
__device__ __forceinline__ float bf_lo(unsigned u) { return __uint_as_float(u << 16); }
__device__ __forceinline__ float bf_hi(unsigned u) { return __uint_as_float(u & 0xffff0000u); }
__device__ __forceinline__ float wave_sum(float v) {
#pragma unroll
    for (int o = 1; o < 64; o <<= 1) v += __shfl_xor(v, o);
    return v;
}
__device__ __forceinline__ float sigmoid_f(float x) { return __builtin_amdgcn_rcpf(1.0f + __expf(-x)); }
__device__ __forceinline__ float silu_f(float x) { return x * sigmoid_f(x); }
__device__ __forceinline__ float gelu_tanh_f(float x) { const float u = 0.7978845608028654f * (x + 0.044715f * x * x * x); return x * sigmoid_f(2.0f * u); }
__device__ __forceinline__ f32x4 exp2_v4(const f32x4 t) { f32x4 e; e.x = __builtin_amdgcn_exp2f(t.x); e.y = __builtin_amdgcn_exp2f(t.y); e.z = __builtin_amdgcn_exp2f(t.z); e.w = __builtin_amdgcn_exp2f(t.w); return e; }
__device__ __forceinline__ f32x4 rcp_v4(const f32x4 d) { f32x4 r; r.x = __builtin_amdgcn_rcpf(d.x); r.y = __builtin_amdgcn_rcpf(d.y); r.z = __builtin_amdgcn_rcpf(d.z); r.w = __builtin_amdgcn_rcpf(d.w); return r; }
__device__ __forceinline__ f32x4 sigmoid_scaled_v4(const f32x4 x, const float c) { return rcp_v4(exp2_v4(x * c) + 1.0f); }
__device__ __forceinline__ f32x4 gelu_tanh_v4(const f32x4 x) {
    const f32x4 w = x * (x * x * 0.044715f + 1.0f);
    return x * rcp_v4(exp2_v4(w * -2.3022081986f) + 1.0f);
}
__device__ __forceinline__ void unpack8(const u32x4 r, float (&v)[8]) {
    v[0] = bf_lo(r.x); v[1] = bf_hi(r.x); v[2] = bf_lo(r.y); v[3] = bf_hi(r.y); v[4] = bf_lo(r.z); v[5] = bf_hi(r.z); v[6] = bf_lo(r.w); v[7] = bf_hi(r.w);
}
__device__ __forceinline__ u32x4 pack8(const float (&v)[8]) {
    u32x4 r; r.x = cvt_pk_bf16(v[0], v[1]); r.y = cvt_pk_bf16(v[2], v[3]); r.z = cvt_pk_bf16(v[4], v[5]); r.w = cvt_pk_bf16(v[6], v[7]); return r;
}
__device__ __forceinline__ float row_rstd(const float* ss, int row) {
    const f32x4* p = (const f32x4*)(ss + (size_t)row * 16);
    const f32x4 a = p[0], b = p[1], c = p[2], d = p[3];
    const f32x4 s = (a + b) + (c + d);
    return rsqrtf(((s.x + s.y) + (s.z + s.w)) * (1.0f / 1024.0f) + EPS);
}


__device__ __forceinline__ int phase_tid(int wave_id) {
    unsigned ones = ~0u; asm volatile("" : "+s"(ones));
    int t = wave_id * 64 + (int)__builtin_amdgcn_mbcnt_hi(ones, __builtin_amdgcn_mbcnt_lo(ones, 0u));
    asm volatile("" : "+v"(t)); return t;
}

typedef __attribute__((address_space(1))) unsigned gu32;
#define XB_TMO      128
#define XB_XCNT(j)  (256  + 64 * (j))
#define XB_XSUB(j)  (1280 + 64 * (j))
#define XB_XGEN(j)  (2304 + 64 * (j))
#define XB_TOP      3328
#define XB_TOPGEN   3392
#define XB_DONE_A   3456
#define XB_DONE_B   3520
#define XB_FIN(pm)  (3584 + 16 * (pm))
#define XCD_BAR_WORDS (3584 + 16 * 128)
#define XB_SPIN_CAP (1u << 18)
__device__ __forceinline__ unsigned xb_ld(unsigned* p)              { return __hip_atomic_load(p, __ATOMIC_RELAXED, __HIP_MEMORY_SCOPE_AGENT); }
__device__ __forceinline__ unsigned xb_add(unsigned* p, unsigned v) { return __hip_atomic_fetch_add(p, v, __ATOMIC_RELAXED, __HIP_MEMORY_SCOPE_AGENT); }
__device__ __forceinline__ unsigned xb_xcc_id() { return (unsigned)__builtin_amdgcn_s_getreg((3 << 11) | 20) & 0xFu; }
#define XB_SPIN(cond, bar) do { unsigned _sp = 0; while (cond) { __builtin_amdgcn_s_sleep(1); \
    if ((++_sp & 255u) == 0u) { if (xb_ld(&(bar)[XB_TMO])) break; if (_sp > XB_SPIN_CAP) { atomicAdd(&(bar)[XB_TMO], 1u); break; } } } } while (0)
struct XcdBarrier { unsigned* bar; unsigned x; volatile LAS unsigned* st; };
__device__ __forceinline__ XcdBarrier xcd_barrier_post(unsigned* bar, volatile LAS unsigned* st) {
    XcdBarrier b; b.bar = bar; b.x = xb_xcc_id(); b.st = st;
    if (threadIdx.x == 0) st[2] = xb_add(&bar[XB_XCNT(b.x)], 1u);
    return b;
}
__device__ __forceinline__ void xcd_barrier_complete(unsigned* bar, unsigned x, unsigned& nloc, unsigned& nx, unsigned& uni) {
    const unsigned G = gridDim.x * gridDim.y * gridDim.z;
    unsigned sum, cnt, mine, bad, sp = 0u;
    for (;;) {
        sum = 0u; cnt = 0u; mine = 0u; bad = 0u;
#pragma unroll
        for (unsigned j = 0; j < 16; ++j) { const unsigned c = xb_ld(&bar[XB_XCNT(j)]); sum += c; cnt += (c > 0u) ? 1u : 0u; mine = (j == x) ? c : mine; bad |= (c != 0u && c * 8u != G) ? 1u : 0u; }
        if (sum == G) break;
        __builtin_amdgcn_s_sleep(1);
        if ((++sp & 255u) == 0u) { if (xb_ld(&bar[XB_TMO])) break; if (sp > XB_SPIN_CAP) { atomicAdd(&bar[XB_TMO], 1u); break; } }
    }
    nloc = mine > 0u ? mine : 1u; nx = cnt > 0u ? cnt : 1u;
    uni = (sum == G && cnt == 8u && bad == 0u && x < 8u) ? 1u : 0u;
}
__device__ __forceinline__ void xcd_barrier(const XcdBarrier& b, int wave_id, unsigned local = 0u, unsigned arrive = 0u) {
    asm volatile("s_waitcnt vmcnt(0)" ::: "memory");
    __syncthreads();
    unsigned ones = ~0u; asm volatile("" : "+s"(ones));
    if (wave_id == 0 && __builtin_amdgcn_mbcnt_hi(ones, __builtin_amdgcn_mbcnt_lo(ones, 0u)) == 0u) {
        unsigned* bar = b.bar;
        __builtin_amdgcn_s_waitcnt(0);
        unsigned nloc = b.st[0], nx = b.st[1];
        if (nloc == 0u) { unsigned uni; xcd_barrier_complete(bar, b.x, nloc, nx, uni); b.st[0] = nloc; b.st[1] = nx; b.st[3] = uni; }
        if (arrive) (void)xb_add(&bar[arrive], 1u);
        const unsigned old = xb_add(&bar[XB_XSUB(b.x)], 1u);
        const unsigned gen = old / nloc;
        if (old + 1u == (gen + 1u) * nloc) {
            if (!local) {
                __builtin_amdgcn_fence(__ATOMIC_RELEASE, "agent");
                asm volatile("s_waitcnt vmcnt(0)" ::: "memory");
                const unsigned og = xb_add(&bar[XB_TOP], 1u);
                const unsigned tg = og / nx;
                if (og + 1u == (tg + 1u) * nx) xb_add(&bar[XB_TOPGEN], 1u);
                else XB_SPIN(xb_ld(&bar[XB_TOPGEN]) == tg, bar);
            }
            __builtin_amdgcn_fence(__ATOMIC_ACQUIRE, "agent");
            xb_add(&bar[XB_XGEN(b.x)], 1u);
            asm volatile("s_waitcnt vmcnt(0)" ::: "memory");
        } else {
            XB_SPIN(xb_ld(&bar[XB_XGEN(b.x)]) == gen, bar);
            __builtin_amdgcn_fence(__ATOMIC_ACQUIRE, "agent");
            asm volatile("s_waitcnt vmcnt(0)" ::: "memory");
        }
    }
    __syncthreads();
}

__device__ __forceinline__ float row_sumsq_part(const float* ss, int row, int fq) { const f32x4 a = *(const f32x4*)(ss + (size_t)row * 16 + 4 * fq); return (a.x + a.y) + (a.z + a.w); }
__device__ __forceinline__ float rstd_from_part(float p) { p += __shfl_xor(p, 16); p += __shfl_xor(p, 32); return rsqrtf(p * (1.0f / 1024.0f) + EPS); }

namespace pg8 {
constexpr int BM = 256, BK = 64, HALF = 128, HTB = HALF * BK * 2, STAGE_BYTES = 8 * HTB, NXCD = 8, WGM = 4;
__device__ __forceinline__ int lds_byte(int r, int c) { const int st = (r >> 4) * 2 + (c >> 5), rr = r & 15, cc = c & 31, ob = rr * 64 + cc * 2; return st * 1024 + (ob ^ (((ob >> 9) & 1) << 5)); }
__device__ __forceinline__ void stage_rc(int b, int& R, int& C) { const int st = b / 1024, sb = b % 1024, swz = sb ^ (((sb >> 9) & 1) << 5); R = (st >> 1) * 16 + swz / 64; C = (st & 1) * 32 + (swz % 64) / 2; }
__device__ __forceinline__ int perm32(int rho) { const int n = rho >> 4, i = rho & 15; return 8 * (i >> 2) + 4 * n + (i & 3); }

struct Unit { int pm, pn; };
struct Gemm { const bf16_t* A; const bf16_t* Bt; int M, N, K; };

struct StaticOrder {
    int nM, nN, nwg, G, c;
    __device__ void init(int M, int N, int G_, int c_) { nM = M / BM; nN = N / BM; nwg = nM * nN; G = G_; c = c_; }
    __device__ bool next(int i, Unit& u) const {
        const long L = (long)i * G + c; if (L >= nwg) return false;
        int wgid = (int)L; { const int q = nwg / NXCD, r = nwg % NXCD, xcd = wgid % NXCD, off = wgid / NXCD; wgid = (xcd < r ? xcd * (q + 1) : r * (q + 1) + (xcd - r) * q) + off; }
        const int nig = WGM * nN, gid = wgid / nig, fm = gid * WGM, gsz = (nM - fm) < WGM ? (nM - fm) : WGM;
        u.pm = fm + ((wgid % nig) % gsz); u.pn = (wgid % nig) / gsz; return true;
    }
};

struct EpiScaleBf16 {
    static constexpr bool PERM = true, USES_RSTD = true, FINAL = false;
    bf16_t* O; int odd; const float* ss;
    __device__ __forceinline__ void operator()(const f32x4 (&acc)[2][2][4][2], const Unit& u, int wr, int wc, int fr, int fq, const LAS float* rl) const {
        const int row0 = u.pm * BM + wr * 64 + fr;
        if (odd && u.pn < 8) {
            const bool glu = u.pn < 4;
            const int col0 = (glu ? 128 * u.pn : 512 + 128 * (u.pn - 4)) + wc * 32 + 8 * fq;
#pragma unroll
            for (int ai = 0; ai < 2; ++ai)
#pragma unroll
                for (int m = 0; m < 4; ++m) {
                    const int row = row0 + ai * HALF + m * 16; const float rs = rl[ai * HALF + wr * 64 + m * 16 + fr];
                    f32x4 o0, o1;
                    if (glu) {
                        const float c1 = -1.4426950408889634f * rs;
                        o0 = acc[ai][0][m][0] * (sigmoid_scaled_v4(acc[ai][1][m][0], c1) * rs); o1 = acc[ai][0][m][1] * (sigmoid_scaled_v4(acc[ai][1][m][1], c1) * rs);
                    } else {
                        const float rs2 = rs * rs;
                        o0 = (acc[ai][0][m][0] * acc[ai][1][m][0]) * rs2; o1 = (acc[ai][0][m][1] * acc[ai][1][m][1]) * rs2;
                    }
                    u32x4 w; w.x = cvt_pk_bf16(o0[0], o0[1]); w.y = cvt_pk_bf16(o0[2], o0[3]); w.z = cvt_pk_bf16(o1[0], o1[1]); w.w = cvt_pk_bf16(o1[2], o1[3]);
                    *(u32x4*)(O + (size_t)row * EVEN_IN + col0) = w;
                }
            return;
        }
        const int col0 = (odd ? 1024 + 256 * (u.pn - 8) : u.pn * BM) + wc * 32 + 8 * fq;
        const bool act = !odd && u.pn < 4;
#pragma unroll
        for (int ai = 0; ai < 2; ++ai)
#pragma unroll
            for (int m = 0; m < 4; ++m) {
                const int row = row0 + ai * HALF + m * 16; const float rs = rl[ai * HALF + wr * 64 + m * 16 + fr];
                bf16_t* rowp = O + (size_t)row * EVEN_IN + col0;
#pragma unroll
                for (int bj = 0; bj < 2; ++bj) {
                    f32x4 v0 = acc[ai][bj][m][0] * rs, v1 = acc[ai][bj][m][1] * rs;
                    if (act) { v0 = gelu_tanh_v4(v0); v1 = gelu_tanh_v4(v1); }
                    u32x4 w; w.x = cvt_pk_bf16(v0[0], v0[1]); w.y = cvt_pk_bf16(v0[2], v0[3]); w.z = cvt_pk_bf16(v1[0], v1[1]); w.w = cvt_pk_bf16(v1[2], v1[3]);
                    *(u32x4*)(rowp + bj * HALF) = w;
                }
            }
    }
};
struct EpiSwiGLU {
    static constexpr bool PERM = true, USES_RSTD = true, FINAL = false;
    bf16_t* O; const float* ss;
    __device__ __forceinline__ void operator()(const f32x4 (&acc)[2][2][4][2], const Unit& u, int wr, int wc, int fr, int fq, const LAS float* rl) const {
        const int row0 = u.pm * BM + wr * 64 + fr, f0 = u.pn * HALF + wc * 32 + 8 * fq;
#pragma unroll
        for (int ai = 0; ai < 2; ++ai)
#pragma unroll
            for (int m = 0; m < 4; ++m) {
                const int row = row0 + ai * HALF + m * 16; const float rs = rl[ai * HALF + wr * 64 + m * 16 + fr];
                const float c1 = -1.4426950408889634f * rs, rs2 = rs * rs;
                const f32x4 a0 = (acc[ai][0][m][0] * acc[ai][1][m][0]) * (sigmoid_scaled_v4(acc[ai][0][m][0], c1) * rs2);
                const f32x4 a1 = (acc[ai][0][m][1] * acc[ai][1][m][1]) * (sigmoid_scaled_v4(acc[ai][0][m][1], c1) * rs2);
                u32x4 w; w.x = cvt_pk_bf16(a0[0], a0[1]); w.y = cvt_pk_bf16(a0[2], a0[3]); w.z = cvt_pk_bf16(a1[0], a1[1]); w.w = cvt_pk_bf16(a1[2], a1[3]);
                *(u32x4*)(O + (size_t)row * DFF + f0) = w;
            }
    }
};
struct EpiResid {
    static constexpr bool PERM = true, USES_RSTD = false, OVERLAP = false, FINAL = false;
    bf16_t* xb; float* ss;
    __device__ __forceinline__ void operator()(const f32x4 (&acc)[2][2][4][2], const Unit& u, int wr, int wc, int fr, int fq, const LAS float*) const {
        int lrow = wr * 64 + fr; asm volatile("" : "+v"(lrow));
        const int row0 = u.pm * BM + lrow, col0 = u.pn * BM + wc * 32 + 8 * fq;
        bf16_t* base = xb + (size_t)row0 * D + col0;
        u32x4 rv[2][4][2];
#pragma unroll
        for (int ai = 0; ai < 2; ++ai)
#pragma unroll
            for (int m = 0; m < 4; ++m)
#pragma unroll
                for (int bj = 0; bj < 2; ++bj) rv[ai][m][bj] = *(const u32x4*)(base + (size_t)(ai * HALF + m * 16) * D + bj * HALF);
#pragma unroll
        for (int ai = 0; ai < 2; ++ai)
#pragma unroll
            for (int m = 0; m < 4; ++m) {
                f32x4 q4 = (f32x4){0.f, 0.f, 0.f, 0.f};
#pragma unroll
                for (int bj = 0; bj < 2; ++bj) {
                    const u32x4 rw = rv[ai][m][bj];
                    const f32x4 h0 = (f32x4){bf_lo(rw.x), bf_hi(rw.x), bf_lo(rw.y), bf_hi(rw.y)} + acc[ai][bj][m][0];
                    const f32x4 h1 = (f32x4){bf_lo(rw.z), bf_hi(rw.z), bf_lo(rw.w), bf_hi(rw.w)} + acc[ai][bj][m][1];
                    q4 += h0 * h0 + h1 * h1;
                    u32x4 w; w.x = cvt_pk_bf16(h0.x, h0.y); w.y = cvt_pk_bf16(h0.z, h0.w); w.z = cvt_pk_bf16(h1.x, h1.y); w.w = cvt_pk_bf16(h1.z, h1.w);
                    *(u32x4*)(base + (size_t)(ai * HALF + m * 16) * D + bj * HALF) = w;
                }
                float q = (q4.x + q4.y) + (q4.z + q4.w);
                q += __shfl_xor(q, 16); q += __shfl_xor(q, 32);
                if (fq == 0) ss[(size_t)(row0 + ai * HALF + m * 16) * 16 + u.pn * 4 + wc] = q;
            }
    }
};

struct EpiFinal {
    static constexpr bool PERM = true, USES_RSTD = false, OVERLAP = false, FINAL = true;
    const bf16_t* xb; float* ss; float* out; const float* gain; unsigned* flags;
    __device__ __forceinline__ void pre(f32x4 (&acc)[2][2][4][2], const Unit& u, int wr, int wc, int fr, int fq) const {
        int lrow = wr * 64 + fr; asm volatile("" : "+v"(lrow));
        const int row0 = u.pm * BM + lrow, col0 = u.pn * BM + wc * 32 + 8 * fq;
        const bf16_t* base = xb + (size_t)row0 * D + col0;
        u32x4 rv[2][4][2];
#pragma unroll
        for (int ai = 0; ai < 2; ++ai)
#pragma unroll
            for (int m = 0; m < 4; ++m)
#pragma unroll
                for (int bj = 0; bj < 2; ++bj) rv[ai][m][bj] = *(const u32x4*)(base + (size_t)(ai * HALF + m * 16) * D + bj * HALF);
#pragma unroll
        for (int ai = 0; ai < 2; ++ai)
#pragma unroll
            for (int m = 0; m < 4; ++m) {
                f32x4 q4 = (f32x4){0.f, 0.f, 0.f, 0.f};
#pragma unroll
                for (int bj = 0; bj < 2; ++bj) {
                    const u32x4 rw = rv[ai][m][bj];
                    const f32x4 h0 = (f32x4){bf_lo(rw.x), bf_hi(rw.x), bf_lo(rw.y), bf_hi(rw.y)} + acc[ai][bj][m][0];
                    const f32x4 h1 = (f32x4){bf_lo(rw.z), bf_hi(rw.z), bf_lo(rw.w), bf_hi(rw.w)} + acc[ai][bj][m][1];
                    q4 += h0 * h0 + h1 * h1;
                    acc[ai][bj][m][0] = h0; acc[ai][bj][m][1] = h1;
                }
                float q = (q4.x + q4.y) + (q4.z + q4.w);
                q += __shfl_xor(q, 16); q += __shfl_xor(q, 32);
                if (fq == 0) ss[(size_t)(row0 + ai * HALF + m * 16) * 16 + u.pn * 4 + wc] = q;
            }
    }
    __device__ __forceinline__ void post(const f32x4 (&acc)[2][2][4][2], const Unit& u, int wr, int wc, int fr, int fq, const LAS float* rl) const {
        int lrow = wr * 64 + fr; asm volatile("" : "+v"(lrow));
        const int row0 = u.pm * BM + lrow, col0 = u.pn * BM + wc * 32 + 8 * fq;
        const float* gp = gain; OPAQUE_S(gp);
        f32x4 gv[2][2];
#pragma unroll
        for (int bj = 0; bj < 2; ++bj)
#pragma unroll
            for (int n = 0; n < 2; ++n) gv[bj][n] = *(const f32x4*)(gp + col0 + bj * HALF + 4 * n);
        float* base = out + (size_t)row0 * D + col0;
#pragma unroll
        for (int ai = 0; ai < 2; ++ai)
#pragma unroll
            for (int m = 0; m < 4; ++m) {
                const float rs = rl[ai * HALF + wr * 64 + m * 16 + fr];
#pragma unroll
                for (int bj = 0; bj < 2; ++bj)
#pragma unroll
                    for (int n = 0; n < 2; ++n) *(f32x4*)(base + (size_t)(ai * HALF + m * 16) * D + bj * HALF + 4 * n) = acc[ai][bj][m][n] * rs * gv[bj][n];
            }
    }
    __device__ __forceinline__ void operator()(const f32x4 (&)[2][2][4][2], const Unit&, int, int, int, int, const LAS float*) const {}
};

template <class Epi, bool ALIGN_EPI, bool SP2>
__device__ __forceinline__ void gemm_phase(LAS unsigned char* lds, const Gemm g, const StaticOrder& S, const Epi& E, int wave_id, unsigned* wait_ctr = nullptr, unsigned wait_val = 0u) {
    int tid_ = phase_tid(wave_id);
    const int tid = tid_, wid = __builtin_amdgcn_readfirstlane(tid >> 6), lane = tid & 63, wr = wid >> 2, wc = wid & 3, fr = lane & 15, fq = lane >> 4;
    const int K = g.K, nt = K / BK;
    unsigned voffA[2], voffB[2];
#pragma unroll
    for (int i = 0; i < 2; ++i) { int R, C; stage_rc(tid * 16 + i * 8192, R, C); const int Rb = Epi::PERM ? ((R & ~31) + perm32(R & 31)) : R;
        voffA[i] = (unsigned)(R * K + C) * 2u; voffB[i] = (unsigned)(Rb * K + C) * 2u; }
    const size_t kstep = (size_t)(BK * 2);
    const size_t hstep = (size_t)HALF * K * 2;
    const size_t tstep = 2 * hstep;
    const unsigned ldsw = (unsigned)wid * 1024u;
    const int aoff = lds_byte(wr * 64 + fr, fq * 8), boff = lds_byte(wc * 32 + fr, fq * 8);
#define PG8_SA(b, h) (((b) * 2 + (h)) * HTB)
#define PG8_SB(b, h) ((4 + (b) * 2 + (h)) * HTB)
#define PG8_STAGE(bufoff, gbase, voff) do { _Pragma("unroll") for (int _i = 0; _i < 2; ++_i) \
        __builtin_amdgcn_global_load_lds((const unsigned*)((const char*)(gbase) + (voff)[_i]), (LAS unsigned*)(lds + (bufoff) + ldsw + _i * 8192), 16, 0, 0); } while (0)
#define PG8_LDA(dst, b, h) do { _Pragma("unroll") for (int m = 0; m < 4; ++m) _Pragma("unroll") for (int k = 0; k < 2; ++k) dst[m][k] = *(const LAS bf16x8*)(lds + PG8_SA(b, h) + aoff + m * 2048 + k * 1024); } while (0)
#define PG8_LDB(dst, b, h) do { _Pragma("unroll") for (int n = 0; n < 2; ++n) _Pragma("unroll") for (int k = 0; k < 2; ++k) dst[n][k] = *(const LAS bf16x8*)(lds + PG8_SB(b, h) + boff + n * 2048 + k * 1024); } while (0)
#define PG8_MMA(ai, bj, At, Bt) do { __builtin_amdgcn_s_setprio(1); _Pragma("unroll") for (int m = 0; m < 4; ++m) _Pragma("unroll") for (int n = 0; n < 2; ++n) _Pragma("unroll") for (int k = 0; k < 2; ++k) \
        acc[ai][bj][m][n] = __builtin_amdgcn_mfma_f32_16x16x32_bf16(Bt[n][k], At[m][k], acc[ai][bj][m][n], 0, 0, 0); __builtin_amdgcn_s_setprio(0); } while (0)
#define PG8_AUX_SC1 16
#define PG8_WAIT_V(n) asm volatile("s_waitcnt vmcnt(" #n ")" ::: "memory")
#define PG8_WAIT_L(n) asm volatile("s_waitcnt lgkmcnt(" #n ")" ::: "memory")
#define PG8_BAR __builtin_amdgcn_s_barrier()
#define PG8_SCHED __builtin_amdgcn_sched_barrier(0)
    Unit cur, nxt; int ui = 0;
    if (!S.next(0, cur)) return;
#ifdef PROBE_STAGGER
    if (blockIdx.x & 8) { const unsigned long long t0 = __builtin_amdgcn_s_memrealtime(); while (__builtin_amdgcn_s_memrealtime() - t0 < PROBE_STAGGER) __builtin_amdgcn_s_sleep(8); }
#endif
    f32x4 acc[2][2][4][2];
#pragma unroll
    for (int a = 0; a < 2; ++a)
#pragma unroll
        for (int b = 0; b < 2; ++b)
#pragma unroll
            for (int m = 0; m < 4; ++m)
#pragma unroll
                for (int n = 0; n < 2; ++n) acc[a][b][m][n] = (f32x4){0.f, 0.f, 0.f, 0.f};
    bf16x8 At[4][2], B0[2][2], B1[2][2];
    const char* cA = (const char*)g.A + (size_t)cur.pm * tstep; const char* cB = (const char*)g.Bt + (size_t)cur.pn * tstep;
    if constexpr (SP2) {
        PG8_STAGE(PG8_SB(0, 0), cB, voffB); PG8_STAGE(PG8_SB(0, 1), cB + hstep, voffB); PG8_STAGE(PG8_SA(0, 0), cA, voffA); PG8_STAGE(PG8_SA(0, 1), cA + hstep, voffA);
        if (wr == 1) PG8_BAR;
        PG8_WAIT_V(2); PG8_BAR;
        PG8_STAGE(PG8_SB(1, 0), cB + kstep, voffB); PG8_STAGE(PG8_SA(1, 0), cA + kstep, voffA); PG8_STAGE(PG8_SB(1, 1), cB + hstep + kstep, voffB);
        PG8_WAIT_V(6); PG8_BAR;
    } else {
        PG8_STAGE(PG8_SB(0, 0), cB, voffB); PG8_STAGE(PG8_SA(0, 0), cA, voffA); PG8_STAGE(PG8_SB(0, 1), cB + hstep, voffB); PG8_STAGE(PG8_SA(0, 1), cA + hstep, voffA);
        if (wr == 1) PG8_BAR;
        PG8_WAIT_V(4); PG8_BAR;
        PG8_STAGE(PG8_SB(1, 0), cB + kstep, voffB); PG8_STAGE(PG8_SA(1, 0), cA + kstep, voffA); PG8_STAGE(PG8_SB(1, 1), cB + hstep + kstep, voffB);
        PG8_WAIT_V(6); PG8_BAR;
    }
    LAS unsigned char* ssimg = lds + STAGE_BYTES;
    const LAS float* rstd_tab = (const LAS float*)(lds + STAGE_BYTES + 16384);
    for (;;) {
        const bool has_next = S.next(ui + 1, nxt);
        const char* nA = has_next ? (const char*)g.A + (size_t)nxt.pm * tstep : cA; const char* nB = has_next ? (const char*)g.Bt + (size_t)nxt.pn * tstep : cB;
        for (int t = 0; t < nt; t += 2) {
            const bool last = (t == nt - 2);
            const char* a1 = cA + (size_t)(t + 1) * kstep;
            const char* a2 = last ? nA : cA + (size_t)(t + 2) * kstep; const char* b2 = last ? nB : cB + (size_t)(t + 2) * kstep;
            const char* a3 = a2 + kstep; const char* b3 = b2 + kstep;
            if constexpr (Epi::USES_RSTD) { if (last) {
                unsigned loff = lane * 16; asm volatile("" : "+v"(loff));
                const char* sp = (const char*)E.ss + (size_t)cur.pm * 16384 + wid * 2048 + loff;
                __builtin_amdgcn_global_load_lds((const unsigned*)sp, (LAS unsigned*)(ssimg + wid * 2048), 16, 0, 0);
                __builtin_amdgcn_global_load_lds((const unsigned*)(sp + 1024), (LAS unsigned*)(ssimg + wid * 2048 + 1024), 16, 0, 0); } }
            if constexpr (SP2) {
            PG8_LDB(B0, 0, 0); PG8_LDB(B1, 0, 1); PG8_SCHED; PG8_LDA(At, 0, 0); PG8_STAGE(PG8_SA(1, 1), a1 + hstep, voffA);
            PG8_WAIT_V(8); PG8_WAIT_L(0); PG8_BAR; PG8_MMA(0, 0, At, B0); PG8_MMA(0, 1, At, B1); PG8_BAR; PG8_SCHED;
            PG8_LDA(At, 0, 1); PG8_STAGE(PG8_SB(0, 0), b2, voffB); PG8_STAGE(PG8_SB(0, 1), b2 + hstep, voffB); PG8_STAGE(PG8_SA(0, 0), a2, voffA);
            PG8_WAIT_V(8); PG8_WAIT_L(0); PG8_BAR; PG8_MMA(1, 0, At, B0); PG8_MMA(1, 1, At, B1); PG8_BAR; PG8_SCHED;
            PG8_LDB(B0, 1, 0); PG8_LDB(B1, 1, 1); PG8_SCHED; PG8_LDA(At, 1, 0); PG8_STAGE(PG8_SA(0, 1), a2 + hstep, voffA);
            PG8_WAIT_V(8); PG8_WAIT_L(0); PG8_BAR; PG8_MMA(0, 0, At, B0); PG8_MMA(0, 1, At, B1); PG8_BAR; PG8_SCHED;
            PG8_LDA(At, 1, 1); PG8_STAGE(PG8_SB(1, 0), b3, voffB); PG8_STAGE(PG8_SB(1, 1), b3 + hstep, voffB); PG8_STAGE(PG8_SA(1, 0), a3, voffA);
            PG8_WAIT_V(8); PG8_WAIT_L(0); PG8_BAR; PG8_MMA(1, 0, At, B0); PG8_MMA(1, 1, At, B1); PG8_BAR; PG8_SCHED;
            } else {
            PG8_LDB(B0, 0, 0); PG8_SCHED; PG8_LDA(At, 0, 0); PG8_STAGE(PG8_SA(1, 1), a1 + hstep, voffA);
            PG8_WAIT_L(8); PG8_BAR; PG8_WAIT_L(0); PG8_MMA(0, 0, At, B0); PG8_BAR; PG8_SCHED;
            PG8_LDB(B1, 0, 1); PG8_STAGE(PG8_SB(0, 0), b2, voffB);
            PG8_BAR; PG8_WAIT_L(0); PG8_MMA(0, 1, At, B1); PG8_BAR;
            PG8_LDA(At, 0, 1); PG8_STAGE(PG8_SA(0, 0), a2, voffA);
            PG8_BAR; PG8_WAIT_L(0); PG8_MMA(1, 0, At, B0); PG8_BAR; PG8_SCHED;
            PG8_STAGE(PG8_SB(0, 1), b2 + hstep, voffB);
            PG8_WAIT_V(6); PG8_BAR; PG8_MMA(1, 1, At, B1); PG8_BAR;
            PG8_LDB(B0, 1, 0); PG8_SCHED; PG8_LDA(At, 1, 0); PG8_STAGE(PG8_SA(0, 1), a2 + hstep, voffA);
            PG8_WAIT_L(8); PG8_BAR; PG8_WAIT_L(0); PG8_MMA(0, 0, At, B0); PG8_BAR; PG8_SCHED;
            PG8_LDB(B1, 1, 1); PG8_STAGE(PG8_SB(1, 0), b3, voffB);
            PG8_BAR; PG8_WAIT_L(0); PG8_MMA(0, 1, At, B1); PG8_BAR;
            PG8_LDA(At, 1, 1); PG8_STAGE(PG8_SA(1, 0), a3, voffA);
            PG8_BAR; PG8_WAIT_L(0); PG8_MMA(1, 0, At, B0); PG8_BAR; PG8_SCHED;
            PG8_STAGE(PG8_SB(1, 1), b3 + hstep, voffB);
            PG8_WAIT_V(6); PG8_BAR; PG8_MMA(1, 1, At, B1); PG8_BAR;
            }
        }
        if constexpr (Epi::USES_RSTD) {
            const LAS f32x4* sp = (const LAS f32x4*)(ssimg + tid * 32);
            const f32x4 sv = sp[0] + sp[1]; float p = (sv.x + sv.y) + (sv.z + sv.w); p += __shfl_xor(p, 1);
            if (!(tid & 1)) ((LAS float*)(lds + STAGE_BYTES + 16384))[tid >> 1] = rsqrtf(p * (1.0f / 1024.0f) + EPS);
        }
        if constexpr (ALIGN_EPI) { if (wr == 0) PG8_BAR; }
        if constexpr (Epi::USES_RSTD) {
            if (ui == 0 && wait_ctr != nullptr && tid == 0) {
                unsigned sp_ = 0u; while (xb_ld(wait_ctr) < wait_val) { __builtin_amdgcn_s_sleep(1); if (++sp_ > (XB_SPIN_CAP << 8)) break; } }
            PG8_WAIT_L(0); PG8_BAR; }
        if constexpr (Epi::FINAL) {
            E.pre(acc, cur, wr, wc, fr, fq);
            asm volatile("s_waitcnt vmcnt(0)" ::: "memory"); PG8_BAR;
            if (tid == 0) { unsigned* f_ = E.flags + 16 * cur.pm; (void)xb_add(f_, 1u);
                unsigned sp_ = 0u; while (xb_ld(f_) < 4u) { __builtin_amdgcn_s_sleep(1); if (++sp_ > (XB_SPIN_CAP << 8)) break; } }
            PG8_BAR;
            { unsigned loff = lane * 16; asm volatile("" : "+v"(loff));
              const char* sp = (const char*)E.ss + (size_t)cur.pm * 16384 + wid * 2048 + loff;
              __builtin_amdgcn_global_load_lds((const unsigned*)sp, (LAS unsigned*)(ssimg + wid * 2048), 16, 0, PG8_AUX_SC1);
              __builtin_amdgcn_global_load_lds((const unsigned*)(sp + 1024), (LAS unsigned*)(ssimg + wid * 2048 + 1024), 16, 0, PG8_AUX_SC1); }
            asm volatile("s_waitcnt vmcnt(0)" ::: "memory"); PG8_BAR;
            { const LAS f32x4* sp = (const LAS f32x4*)(ssimg + tid * 32);
              const f32x4 sv = sp[0] + sp[1]; float p = (sv.x + sv.y) + (sv.z + sv.w); p += __shfl_xor(p, 1);
              if (!(tid & 1)) ((LAS float*)(lds + STAGE_BYTES + 16384))[tid >> 1] = rsqrtf(p * (1.0f / 1024.0f) + EPS); }
            PG8_WAIT_L(0); PG8_BAR;
            E.post(acc, cur, wr, wc, fr, fq, rstd_tab);
        } else
        E(acc, cur, wr, wc, fr, fq, rstd_tab);
        if (!has_next) break;
#pragma unroll
        for (int a = 0; a < 2; ++a)
#pragma unroll
            for (int b = 0; b < 2; ++b)
#pragma unroll
                for (int m = 0; m < 4; ++m)
#pragma unroll
                    for (int n = 0; n < 2; ++n) acc[a][b][m][n] = (f32x4){0.f, 0.f, 0.f, 0.f};
        cur = nxt; cA = nA; cB = nB; ++ui;
        if constexpr (ALIGN_EPI) { if (wr == 1) PG8_BAR; }
    }
    PG8_WAIT_V(0);
    if constexpr (!ALIGN_EPI) { if (wr == 0) PG8_BAR; }
    PG8_BAR;
#undef PG8_SA
#undef PG8_SB
#undef PG8_STAGE
#undef PG8_LDA
#undef PG8_LDB
#undef PG8_MMA
#undef PG8_WAIT_V
#undef PG8_WAIT_L
#undef PG8_BAR
#undef PG8_SCHED
}
}

struct Args {
    const float* x; const float* even_w_in; const float* even_w_out; const float* a_w_s; const float* a_b_s; const float* a_ln_g; const float* a_ln_b;
    const float* b_w_pool; const float* b_scale; const float* odd_w_in; const float* odd_w_out; const float* c_w_dw; const float* c_b_dw; const float* c_ln_g; const float* c_ln_b;
    const float* d_w_dw; const float* norm_mix_g; const float* norm_ffn_g; const float* ffn_w_gate; const float* ffn_w_up; const float* ffn_w_down; const float* final_norm_g;
    float* out; unsigned char* ws; int ph_lo, ph_hi;
};

typedef const __attribute__((address_space(4))) Args* KArgsPtr;
__device__ __forceinline__ KArgsPtr fresh_args() { return (KArgsPtr)opaque_uniform_u64((unsigned long long)__builtin_amdgcn_kernarg_segment_ptr()); }

constexpr int P0_SCR_BYTES = 64 * 65 * 4;
__device__ __forceinline__ void p0_transpose_item(const float* W, int K, int N, bf16_t* WT, int grp, int gstride, int goff, const float* gk, LAS float* scr, int item, int lane, int oddmap = 0) {
    const int nblk = N / 64, kb = item / nblk, nb = item % nblk, k0 = 64 * kb, n0 = 64 * nb;
    const int lr = lane >> 4, lc = 4 * (lane & 15);
    f32x4 v[16];
#pragma unroll
    for (int i = 0; i < 16; ++i) v[i] = __builtin_nontemporal_load((const f32x4*)(W + (size_t)(k0 + 4 * i + lr) * N + n0 + lc));
#pragma unroll
    for (int i = 0; i < 16; ++i) { LAS float* p = scr + (4 * i + lr) * 65 + lc; p[0] = v[i].x; p[1] = v[i].y; p[2] = v[i].z; p[3] = v[i].w; }
    asm volatile("s_waitcnt lgkmcnt(0)" ::: "memory");
    const int c = lane & 7;
    float gv[8];
    if (gk) { const f32x4 g0 = *(const f32x4*)(gk + k0 + 8 * c), g1 = *(const f32x4*)(gk + k0 + 8 * c + 4);
#pragma unroll
        for (int j = 0; j < 4; ++j) { gv[j] = g0[j]; gv[4 + j] = g1[j]; } }
    else {
#pragma unroll
        for (int j = 0; j < 8; ++j) gv[j] = 1.0f; }
    int drow0 = (n0 / grp) * gstride + goff + (n0 % grp);
    if (oddmap) {
        const int seg = n0 >> 9, c0 = n0 & 511, pr = (c0 >> 7) * 256 + (c0 & 127);
        drow0 = seg == 0 ? pr : seg == 1 ? pr + 128 : seg == 2 ? 2048 + c0 : seg == 3 ? 1024 + pr : 1024 + pr + 128;
    }
#pragma unroll
    for (int j = 0; j < 8; ++j) { const int n = (lane >> 3) + 8 * j; const LAS float* s = scr + (8 * c) * 65 + n;
        float o[8];
#pragma unroll
        for (int e = 0; e < 8; ++e) o[e] = s[e * 65] * gv[e];
        __builtin_nontemporal_store(pack8(o), (u32x4*)(WT + (size_t)(drow0 + n) * K + k0 + 8 * c)); }
    asm volatile("s_waitcnt lgkmcnt(0)" ::: "memory");
}

__device__ __forceinline__ void p0_prologue(LAS unsigned char* lds, int vcu, int G, int wave_id) {
    const __attribute__((address_space(4))) Args& A = *fresh_args();
    int tid_ = phase_tid(wave_id);
    const int tid = tid_, lane = tid & 63, wave = __builtin_amdgcn_readfirstlane(tid >> 6);
    LAS float* scr = (LAS float*)(lds + wave * P0_SCR_BYTES);
    const int gw = vcu * NWAVES + wave, NGW = G * NWAVES;
    unsigned char* ws = A.ws;
    constexpr int I_IN0 = 16 * (EVEN_IN / 64), I_OUT = 16 * (D / 64), I_FF = 16 * (DFF / 64), I_DN = (DFF / 64) * (D / 64), I_IN1 = 16 * (ODD_IN / 64), I_WP = 2 * 2;
    constexpr int PER_LAYER_FFN = 2 * I_FF + I_DN;
    constexpr int NITEMS = I_IN0 + I_OUT + I_IN1 + I_OUT + 2 * PER_LAYER_FFN + 4 * I_WP;
    for (int it = gw; it < NITEMS; it += NGW) {
        int r = it;
        if (r < I_IN0) { p0_transpose_item(A.even_w_in, D, EVEN_IN, (bf16_t*)(ws + WS_WIN0), EVEN_IN, 0, 0, A.norm_mix_g, scr, r, lane); continue; } r -= I_IN0;
        if (r < I_OUT) { p0_transpose_item(A.even_w_out, D, D, (bf16_t*)(ws + WS_WOUT0), D, 0, 0, nullptr, scr, r, lane); continue; } r -= I_OUT;
        if (r < I_IN1) { p0_transpose_item(A.odd_w_in, D, ODD_IN, (bf16_t*)(ws + WS_WIN1), ODD_IN, 0, 0, A.norm_mix_g + D, scr, r, lane, 1); continue; } r -= I_IN1;
        if (r < I_OUT) { p0_transpose_item(A.odd_w_out, D, D, (bf16_t*)(ws + WS_WOUT1), D, 0, 0, nullptr, scr, r, lane); continue; } r -= I_OUT;
        if (r < 2 * PER_LAYER_FFN) {
            const int layer = r / PER_LAYER_FFN; r -= layer * PER_LAYER_FFN;
            bf16_t* wgu = (bf16_t*)(ws + (layer ? WS_WGU1 : WS_WGU0)); bf16_t* wdn = (bf16_t*)(ws + (layer ? WS_WDN1 : WS_WDN0));
            const float* gk = A.norm_ffn_g + layer * D;
            if (r < I_FF) { p0_transpose_item(A.ffn_w_gate + (size_t)layer * D * DFF, D, DFF, wgu, 128, 256, 0, gk, scr, r, lane); continue; } r -= I_FF;
            if (r < I_FF) { p0_transpose_item(A.ffn_w_up + (size_t)layer * D * DFF, D, DFF, wgu, 128, 256, 128, gk, scr, r, lane); continue; } r -= I_FF;
            p0_transpose_item(A.ffn_w_down + (size_t)layer * DFF * D, DFF, D, wdn, D, 0, 0, nullptr, scr, r, lane); continue;
        }
        r -= 2 * PER_LAYER_FFN;
        { const int g = r / I_WP; r -= g * I_WP;
          p0_transpose_item(A.b_w_pool + (size_t)g * 128 * 128, 128, 128, (bf16_t*)(ws + WS_WP) + (size_t)g * 128 * 128, 128, 0, 0, nullptr, scr, r, lane); }
    }
    { bf16_t* wm = (bf16_t*)(ws + WS_WS);
      for (int e = (vcu * NTHREADS + tid) * 2; e < 4 * 128 * 128; e += G * NTHREADS * 2) {
          const int i = (e >> 7) & 127, j = e & 127; const bool keep = (i >> 6) >= (j >> 6);
          const float a = keep ? A.a_w_s[e] : 0.f, b = keep ? A.a_w_s[e + 1] : 0.f;
          *(unsigned*)(wm + e) = cvt_pk_bf16(a, b); } }
    { bf16_t* xb = (bf16_t*)(ws + WS_XB); float* ss = (float*)(ws + WS_SS);
      for (int m0 = gw * 4; m0 < M_TOK; m0 += NGW * 4) {
          f32x4 v[4][4];
#pragma unroll
          for (int r = 0; r < 4; ++r)
#pragma unroll
              for (int j = 0; j < 4; ++j) v[r][j] = __builtin_nontemporal_load((const f32x4*)(A.x + (size_t)(m0 + r) * D) + lane + 64 * j);
#pragma unroll
          for (int r = 0; r < 4; ++r) {
              float s = 0.f;
#pragma unroll
              for (int j = 0; j < 4; ++j) s += (v[r][j].x * v[r][j].x + v[r][j].y * v[r][j].y) + (v[r][j].z * v[r][j].z + v[r][j].w * v[r][j].w);
              s = wave_sum(s);
              u32x2* o8 = (u32x2*)(xb + (size_t)(m0 + r) * D) + lane;
#pragma unroll
              for (int j = 0; j < 4; ++j) { u32x2 w; w.x = cvt_pk_bf16(v[r][j].x, v[r][j].y); w.y = cvt_pk_bf16(v[r][j].z, v[r][j].w); o8[64 * j] = w; }
              if (lane < 4) { f32x4 t = (f32x4){0.f, 0.f, 0.f, 0.f}; if (lane == 0) t.x = s; *((f32x4*)(ss + (size_t)(m0 + r) * 16) + lane) = t; }
          }
      } }
}

constexpr int VN_STRIDE = 1056;
constexpr int PL_STRIDE = 1040;
__device__ __forceinline__ float seg16_sum(float v) { v += __shfl_xor(v, 1); v += __shfl_xor(v, 2); v += __shfl_xor(v, 4); v += __shfl_xor(v, 8); return v; }

template <int NCH> struct PoolVec;
template <> struct PoolVec<8> { typedef u32x4 T; static __device__ __forceinline__ T zero() { return (u32x4){0u, 0u, 0u, 0u}; }
    static __device__ __forceinline__ void unpack(const T r, float (&v)[8]) { unpack8(r, v); }
    static __device__ __forceinline__ T pack(const float (&v)[8]) { return pack8(v); } };
template <> struct PoolVec<4> { typedef u32x2 T; static __device__ __forceinline__ T zero() { return (u32x2){0u, 0u}; }
    static __device__ __forceinline__ void unpack(const T r, float (&v)[4]) { v[0] = bf_lo(r.x); v[1] = bf_hi(r.x); v[2] = bf_lo(r.y); v[3] = bf_hi(r.y); }
    static __device__ __forceinline__ T pack(const float (&v)[4]) { T o; o.x = cvt_pk_bf16(v[0], v[1]); o.y = cvt_pk_bf16(v[2], v[3]); return o; } };
template <int WIN, int NCH> __device__ __forceinline__ void pool_segment(const bf16_t* zp  , int posb, LAS unsigned char* dst  ) {
    typedef PoolVec<NCH> PV; typedef typename PV::T VT;
    constexpr int NR = 16 + WIN - 1;
    VT raw[NR];
#pragma unroll
    for (int i = 0; i < NR; ++i) { const int rel = i - (WIN - 1); const int relc = (posb + rel >= 0) ? rel : -posb;
        raw[i] = *(const VT*)(zp + (long)relc * EVEN_IN); }
#pragma unroll
    for (int i = 0; i < WIN - 1; ++i) { const int rel = i - (WIN - 1); if (posb + rel < 0) raw[i] = PV::zero(); }
    float s[NCH];
#pragma unroll
    for (int j = 0; j < NCH; ++j) s[j] = 0.f;
#pragma unroll
    for (int i = 0; i < WIN - 1; ++i) { float x[NCH]; PV::unpack(raw[i], x);
#pragma unroll
        for (int j = 0; j < NCH; ++j) s[j] += x[j]; }
#pragma unroll
    for (int i = 0; i < 16; ++i) {
        float x[NCH]; PV::unpack(raw[i + WIN - 1], x);
        const int pos = posb + i; const int cnt = (pos + 1 < WIN) ? pos + 1 : WIN; const float inv = 1.0f / (float)cnt;
        float o[NCH];
#pragma unroll
        for (int j = 0; j < NCH; ++j) { s[j] += x[j]; o[j] = s[j] * inv - x[j]; }
        *(LAS VT*)(dst + i * PL_STRIDE) = PV::pack(o);
        float y[NCH]; PV::unpack(raw[i], y);
#pragma unroll
        for (int j = 0; j < NCH; ++j) s[j] -= y[j];
    }
}

__device__ __forceinline__ void mixer_even(LAS unsigned char* lds, int vcu, int G, int wave_id) {
    const __attribute__((address_space(4))) Args& A = *fresh_args();
    int tid_ = phase_tid(wave_id);
    const int tid = tid_, lane = tid & 63, w = __builtin_amdgcn_readfirstlane(tid >> 6), fr = lane & 15, fq = lane >> 4;
    const bf16_t* Z = (const bf16_t*)(A.ws + WS_Z); bf16_t* Y = (bf16_t*)(A.ws + WS_Y);
    const bf16_t* Wm = (const bf16_t*)(A.ws + WS_WS); const bf16_t* WpT = (const bf16_t*)(A.ws + WS_WP);
    const int hg = w >> 1, dh = w & 1;
    for (int blk = vcu; blk < M_TOK / 128; blk += G) {
        const int row_base = blk * 128; const int pos_base = row_base & (SEQ - 1);
        {
            const int c = hg * 128 + 8 * fr, sg = dh * 4 + fq, ts = 16 * sg;
            const bf16_t* zp = Z + (size_t)(row_base + ts) * EVEN_IN + 1024 + c;
            LAS unsigned char* dst = lds + ts * PL_STRIDE + c * 2;
            if (hg == 0) pool_segment<2, 8>(zp, pos_base + ts, dst);
            else if (hg == 1) pool_segment<4, 8>(zp, pos_base + ts, dst);
            else if (hg == 2) pool_segment<8, 8>(zp, pos_base + ts, dst);
            else { pool_segment<16, 4>(zp, pos_base + ts, dst); pool_segment<16, 4>(zp + 4, pos_base + ts, dst + 8); }
        }
        bf16x8 wpf[4][4];
        { const bf16_t* WpT_ = WpT; OPAQUE_S(WpT_);
#pragma unroll
        for (int n = 0; n < 4; ++n)
#pragma unroll
            for (int ks = 0; ks < 4; ++ks) wpf[n][ks] = *(const bf16x8*)(WpT_ + ((size_t)(hg * 128 + dh * 64 + n * 16 + fr) * 128 + ks * 32 + 8 * fq)); }
        __syncthreads();
        {
            f32x4 sc[4]; const float* bsc = A.b_scale; OPAQUE_S(bsc);
#pragma unroll
            for (int n = 0; n < 4; ++n) sc[n] = *(const f32x4*)(bsc + hg * 128 + dh * 64 + n * 16 + 4 * fq);
#pragma unroll 2
            for (int m = 0; m < 8; ++m) {
                f32x4 acc[4];
#pragma unroll
                for (int n = 0; n < 4; ++n) acc[n] = (f32x4){0.f, 0.f, 0.f, 0.f};
#pragma unroll
                for (int ks = 0; ks < 4; ++ks) {
                    const bf16x8 pf = *(const LAS bf16x8*)(lds + (m * 16 + fr) * PL_STRIDE + (hg * 128 + ks * 32 + 8 * fq) * 2);
#pragma unroll
                    for (int n = 0; n < 4; ++n) acc[n] = __builtin_amdgcn_mfma_f32_16x16x32_bf16(wpf[n][ks], pf, acc[n], 0, 0, 0);
                }
                const size_t row = (size_t)(row_base + m * 16 + fr);
#pragma unroll
                for (int n = 0; n < 4; ++n) {
                    u32x2 o; o.x = cvt_pk_bf16(acc[n].x * sc[n].x, acc[n].y * sc[n].y); o.y = cvt_pk_bf16(acc[n].z * sc[n].z, acc[n].w * sc[n].w);
                    *(u32x2*)(Y + row * D + 512 + hg * 128 + dh * 64 + n * 16 + 4 * fq) = o;
                }
            }
        }
        __syncthreads();
        {
            u32x4 raw[4][4];
#pragma unroll
            for (int r = 0; r < 4; ++r)
#pragma unroll
                for (int j = 0; j < 4; ++j) raw[r][j] = *(const u32x4*)(Z + (size_t)(row_base + 16 * w + 4 * r + fq) * EVEN_IN + 512 + 128 * j + 8 * fr);
            float mu[4], rstd[4];
#pragma unroll
            for (int r = 0; r < 4; ++r) {
                float s = 0.f, q = 0.f;
#pragma unroll
                for (int j = 0; j < 4; ++j) { float v[8]; unpack8(raw[r][j], v);
#pragma unroll
                    for (int e = 0; e < 8; ++e) { s += v[e]; q += v[e] * v[e]; } }
                s = seg16_sum(s); q = seg16_sum(q);
                mu[r] = s * (1.0f / 512.0f); const float var = fmaxf(q * (1.0f / 512.0f) - mu[r] * mu[r], 0.f); rstd[r] = rsqrtf(var + EPS);
            }
            const float* lgp = A.a_ln_g; const float* lbp = A.a_ln_b; OPAQUE_S(lgp); OPAQUE_S(lbp);
#pragma unroll
            for (int j = 0; j < 4; ++j) {
                const f32x4 g0 = *(const f32x4*)(lgp + 128 * j + 8 * fr), g1 = *(const f32x4*)(lgp + 128 * j + 8 * fr + 4), b0 = *(const f32x4*)(lbp + 128 * j + 8 * fr), b1 = *(const f32x4*)(lbp + 128 * j + 8 * fr + 4);
#pragma unroll
                for (int r = 0; r < 4; ++r) {
                    float v[8], o[8]; unpack8(raw[r][j], v);
#pragma unroll
                    for (int e = 0; e < 4; ++e) { o[e] = (v[e] - mu[r]) * rstd[r] * g0[e] + b0[e]; o[4 + e] = (v[4 + e] - mu[r]) * rstd[r] * g1[e] + b1[e]; }
                    *(LAS u32x4*)(lds + (16 * w + 4 * r + fq) * VN_STRIDE + (128 * j + 8 * fr) * 2) = pack8(o);
                }
            }
        }
        __syncthreads();
        {
            const int h = hg;
            const int q4 = (lane >> 2) & 3, p4 = lane & 3;
            const LAS unsigned char* vbase = lds + (4 * fq + q4) * VN_STRIDE + (h * 128 + dh * 64 + 4 * p4) * 2;
#pragma unroll
            for (int mh = 0; mh < 2; ++mh) {
                u32x2 wlo[4][4], whi[4][4]; const bf16_t* Wm_ = Wm; OPAQUE_S(Wm_);
#pragma unroll
                for (int m = 0; m < 4; ++m)
#pragma unroll
                    for (int ks = 0; ks < 4; ++ks) {
                        if (mh == 0 && ks >= 2) continue;
                        const bf16_t* wp = Wm_ + ((size_t)(h * 128 + (4 * mh + m) * 16 + fr) * 128 + ks * 32 + 4 * fq);
                        wlo[m][ks] = *(const u32x2*)wp; whi[m][ks] = *(const u32x2*)(wp + 16);
                    }
                u32x2 ur[4][4]; const float* abs_ = A.a_b_s; OPAQUE_S(abs_);
#pragma unroll
                for (int m = 0; m < 4; ++m)
#pragma unroll
                    for (int n = 0; n < 4; ++n) ur[m][n] = *(const u32x2*)(Z + (size_t)(row_base + (4 * mh + m) * 16 + fr) * EVEN_IN + h * 128 + dh * 64 + n * 16 + 4 * fq);
                f32x4 acc[4][4];
#pragma unroll
                for (int m = 0; m < 4; ++m)
#pragma unroll
                    for (int n = 0; n < 4; ++n) acc[m][n] = (f32x4){0.f, 0.f, 0.f, 0.f};
#pragma unroll
                for (int ks = 0; ks < 4; ++ks) {
                    if (mh == 0 && ks >= 2) continue;
                    bf16x8 vf[4];
#pragma unroll
                    for (int n = 0; n < 4; ++n) {
                        const s16x4 lo = __builtin_amdgcn_ds_read_tr16_b64_v4i16((LAS s16x4*)(vbase + (ks * 32) * VN_STRIDE + n * 32));
                        const s16x4 hi = __builtin_amdgcn_ds_read_tr16_b64_v4i16((LAS s16x4*)(vbase + (ks * 32 + 16) * VN_STRIDE + n * 32));
                        vf[n] = (bf16x8){lo.x, lo.y, lo.z, lo.w, hi.x, hi.y, hi.z, hi.w};
                    }
#pragma unroll
                    for (int m = 0; m < 4; ++m) {
                        union { u32x4 u; bf16x8 b; } wf; wf.u = (u32x4){wlo[m][ks].x, wlo[m][ks].y, whi[m][ks].x, whi[m][ks].y};
#pragma unroll
                        for (int n = 0; n < 4; ++n) acc[m][n] = __builtin_amdgcn_mfma_f32_16x16x32_bf16(vf[n], wf.b, acc[m][n], 0, 0, 0);
                    }
                }
#pragma unroll
                for (int m = 0; m < 4; ++m) {
                    const int i = (4 * mh + m) * 16 + fr; const float bs = abs_[h * 128 + i]; const size_t row = (size_t)(row_base + i);
#pragma unroll
                    for (int n = 0; n < 4; ++n) {
                        const int d = h * 128 + dh * 64 + n * 16 + 4 * fq;
                        const f32x4 sv = acc[m][n];
                        u32x2 o; o.x = cvt_pk_bf16(bf_lo(ur[m][n].x) * (sv.x + bs), bf_hi(ur[m][n].x) * (sv.y + bs)); o.y = cvt_pk_bf16(bf_lo(ur[m][n].y) * (sv.z + bs), bf_hi(ur[m][n].y) * (sv.w + bs));
                        *(u32x2*)(Y + row * D + d) = o;
                    }
                }
            }
        }
        __syncthreads();
    }
}

template <int S, int T> __device__ __forceinline__ void conv_t(f32x2 (&acc)[32], const f32x2 (&wt)[31], const f32x2 hv) {
    if constexpr (T < 32) { if constexpr (S - T >= 0 && S - T <= 30) acc[T] = acc[T] + wt[S - T] * hv; conv_t<S, T + 1>(acc, wt, hv); }
}
template <int S> __device__ __forceinline__ void conv_s(f32x2 (&acc)[32], const f32x2 (&wt)[31], const LAS unsigned char* hp) {
    if constexpr (S < 62) {
        const unsigned hr = *(const LAS unsigned*)(hp + S * 1024);
        conv_t<S, 0>(acc, wt, (f32x2){bf_lo(hr), bf_hi(hr)});
        conv_s<S + 1>(acc, wt, hp);
    }
}
__device__ __forceinline__ void mixer_odd(LAS unsigned char* lds, int vcu, int G, int wave_id) {
    const __attribute__((address_space(4))) Args& A = *fresh_args();
    int tid_ = phase_tid(wave_id);
    const int tid = tid_, lane = tid & 63, w = __builtin_amdgcn_readfirstlane(tid >> 6), fr = lane & 15, fq = lane >> 4;
    const bf16_t* Z = (const bf16_t*)(A.ws + WS_Z); bf16_t* Y = (bf16_t*)(A.ws + WS_Y);
    constexpr int TT = 64, HALO = 30, HROWS = TT + HALO;
    const int tpv = (M_TOK / TT) / G, contig = (tpv * G == M_TOK / TT);
    for (int ti = 0; ti * G + vcu < M_TOK / TT; ++ti) {
        const int tile = contig ? vcu * tpv + ti : ti * G + vcu;
        const int t0 = tile * TT; const int pos0 = t0 & (SEQ - 1);
        for (int r = w; r < HROWS; r += NWAVES) {
            if (pos0 + r - HALO >= 0) __builtin_amdgcn_global_load_lds((const unsigned*)(Z + (size_t)(t0 + r - HALO) * EVEN_IN + 8 * lane), (LAS unsigned*)(lds + r * 1024), 16, 0, 0);
            else *(LAS u32x4*)(lds + r * 1024 + lane * 16) = (u32x4){0u, 0u, 0u, 0u};
        }
        asm volatile("s_waitcnt vmcnt(0)" ::: "memory");
        __syncthreads();
        const int cp = tid & 255, th = tid >> 8;
        f32x2 acc[32];
        {
            f32x2 wt[31];
            const float* cw = A.c_w_dw; OPAQUE_S(cw); const float* cb = A.c_b_dw; OPAQUE_S(cb);
            const float* wbase = cw + 2 * cp;
#pragma unroll
            for (int j = 0; j < 31; ++j) wt[j] = *(const f32x2*)(wbase + j * 512);
            const f32x2 bias = *(const f32x2*)(cb + 2 * cp);
#pragma unroll
            for (int t = 0; t < 32; ++t) acc[t] = bias;
            const LAS unsigned char* hp = lds + (32 * th) * 1024 + 4 * cp;
            conv_s<0>(acc, wt, hp);
        }
        __syncthreads();
#pragma unroll
        for (int t = 0; t < 32; ++t) *(LAS unsigned*)(lds + (32 * th + t) * 1024 + 4 * cp) = cvt_pk_bf16(acc[t].x, acc[t].y);
        {
            const int c8 = tid & 63, tg = tid >> 6;
            float w0[8], w1[8], w2[8];
            { const float* dw = A.d_w_dw; OPAQUE_S(dw); const float* wp = dw + 8 * c8;
              const f32x4 a0 = *(const f32x4*)wp, a1 = *(const f32x4*)(wp + 4), b0 = *(const f32x4*)(wp + 512), b1 = *(const f32x4*)(wp + 516), c0 = *(const f32x4*)(wp + 1024), c1 = *(const f32x4*)(wp + 1028);
#pragma unroll
              for (int j = 0; j < 4; ++j) { w0[j] = a0[j]; w0[4 + j] = a1[j]; w1[j] = b0[j]; w1[4 + j] = b1[j]; w2[j] = c0[j]; w2[4 + j] = c1[j]; } }
#pragma unroll 1
            for (int rd = 0; rd < 2; ++rd) {
                const int tk0 = 8 * tg + 4 * rd;
                const bf16_t* zp = Z + (size_t)(t0 + tk0) * EVEN_IN + 512 + 8 * c8;
                u32x4 rp[6], rb[4];
#pragma unroll
                for (int i = 0; i < 6; ++i) { const int rel = i - 2; const int relc = (pos0 + tk0 + rel >= 0) ? rel : 0;
                    rp[i] = *(const u32x4*)(zp + (long)relc * EVEN_IN);
                    if (pos0 + tk0 + rel < 0) rp[i] = (u32x4){0u, 0u, 0u, 0u}; }
#pragma unroll
                for (int i = 0; i < 4; ++i) rb[i] = *(const u32x4*)(zp + (long)i * EVEN_IN + 512);
                float p[6][8];
#pragma unroll
                for (int i = 0; i < 6; ++i) unpack8(rp[i], p[i]);
#pragma unroll
                for (int i = 0; i < 4; ++i) {
                    float bg[8], o[8]; unpack8(rb[i], bg);
#pragma unroll
                    for (int j = 0; j < 8; ++j) o[j] = bg[j] * (w0[j] * p[i][j] + w1[j] * p[i + 1][j] + w2[j] * p[i + 2][j]);
                    *(u32x4*)(Y + (size_t)(t0 + tk0 + i) * D + 512 + 8 * c8) = pack8(o);
                }
            }
        }
        __syncthreads();
        {
            f32x4 lg[4][2], lb[4][2]; const float* lgp = A.c_ln_g; const float* lbp = A.c_ln_b; OPAQUE_S(lgp); OPAQUE_S(lbp);
#pragma unroll
            for (int j = 0; j < 4; ++j) { lg[j][0] = *(const f32x4*)(lgp + 128 * j + 8 * fr); lg[j][1] = *(const f32x4*)(lgp + 128 * j + 8 * fr + 4);
                                          lb[j][0] = *(const f32x4*)(lbp + 128 * j + 8 * fr); lb[j][1] = *(const f32x4*)(lbp + 128 * j + 8 * fr + 4); }
#pragma unroll
            for (int r = 0; r < 2; ++r) {
                const int tok = 8 * w + 4 * r + fq;
                float v[4][8]; float s = 0.f, q = 0.f;
#pragma unroll
                for (int j = 0; j < 4; ++j) { unpack8(*(const LAS u32x4*)(lds + tok * 1024 + (128 * j + 8 * fr) * 2), v[j]);
#pragma unroll
                    for (int e = 0; e < 8; ++e) { s += v[j][e]; q += v[j][e] * v[j][e]; } }
                s = seg16_sum(s); q = seg16_sum(q);
                const float mu = s * (1.0f / 512.0f); const float var = fmaxf(q * (1.0f / 512.0f) - mu * mu, 0.f); const float rstd = rsqrtf(var + EPS);
#pragma unroll
                for (int j = 0; j < 4; ++j) {
                    float o[8];
#pragma unroll
                    for (int e = 0; e < 4; ++e) { o[e] = silu_f((v[j][e] - mu) * rstd * lg[j][0][e] + lb[j][0][e]); o[4 + e] = silu_f((v[j][4 + e] - mu) * rstd * lg[j][1][e] + lb[j][1][e]); }
                    *(u32x4*)(Y + (size_t)(t0 + tok) * D + 128 * j + 8 * fr) = pack8(o);
                }
            }
        }
        __syncthreads();
    }
}

__device__ __forceinline__ void final_norm(int vcu, int G, int wave_id) {
    const __attribute__((address_space(4))) Args& A = *fresh_args();
    int tid_ = phase_tid(wave_id);
    const int tid = tid_, lane = tid & 63, wave = __builtin_amdgcn_readfirstlane(tid >> 6);
    const int gw = vcu * NWAVES + wave, NGW = G * NWAVES;
    const float* ss = (const float*)(A.ws + WS_SS); const bf16_t* xb = (const bf16_t*)(A.ws + WS_XB);
    f32x4 gg[4];
#pragma unroll
    for (int j = 0; j < 4; ++j) gg[j] = *((const f32x4*)A.final_norm_g + 2 * lane + 128 * (j >> 1) + (j & 1));
    const int gpv = (M_TOK / 4) / G, contig = (gpv * G == M_TOK / 4) && (gpv % NWAVES == 0);
    for (int gi = 0; (gi * NGW + gw) * 4 < M_TOK; ++gi) {
        const int m0 = contig ? (vcu * gpv + gi * NWAVES + wave) * 4 : (gi * NGW + gw) * 4;
        float part[4]; u32x4 raw[4][2];
#pragma unroll
        for (int r = 0; r < 4; ++r) { part[r] = ss[(size_t)(m0 + r) * 16 + (lane & 15)];
            raw[r][0] = __builtin_nontemporal_load((const u32x4*)(xb + (size_t)(m0 + r) * D) + lane); raw[r][1] = __builtin_nontemporal_load((const u32x4*)(xb + (size_t)(m0 + r) * D) + lane + 64); }
#pragma unroll
        for (int r = 0; r < 4; ++r) {
            const float rs = rsqrtf(seg16_sum(part[r]) * (1.0f / 1024.0f) + EPS);
            f32x4* orow = (f32x4*)(A.out + (size_t)(m0 + r) * D);
#pragma unroll
            for (int hh = 0; hh < 2; ++hh) {
                float v[8]; unpack8(raw[r][hh], v);
                orow[128 * hh + 2 * lane] = (f32x4){v[0], v[1], v[2], v[3]} * rs * gg[2 * hh];
                orow[128 * hh + 2 * lane + 1] = (f32x4){v[4], v[5], v[6], v[7]} * rs * gg[2 * hh + 1];
            }
        }
    }
}

#ifndef PG8_SP2
#define PG8_SP2 true
#endif
#ifndef PG8_ALIGN
#define PG8_ALIGN true
#endif
__global__ void __launch_bounds__(NTHREADS, 2) trunk_fwd(Args args) {
    extern __shared__ __attribute__((aligned(16))) unsigned char lds_raw[];
    LAS unsigned char* lds = (LAS unsigned char*)lds_raw;
    const int G = gridDim.x, bx = blockIdx.x;
    const int wave_id = __builtin_amdgcn_readfirstlane(threadIdx.x >> 6);
    const int vcu = (G % 8 == 0) ? (bx % 8) * (G / 8) + bx / 8 : bx;
    const int lo = fresh_args()->ph_lo, hi = fresh_args()->ph_hi;
#define WSP(off) (fresh_args()->ws + (off))
#ifndef KIND_MASK
#define KIND_MASK 0xff
#endif
#define KIND(b) (((KIND_MASK) >> (b)) & 1)
#define IN(k) (lo <= (k) && (k) < hi)
#if USE_CG_SYNC
#define SEAM(k, loc, arr) do { if (IN(k) && IN((k) + 1)) { cg::this_grid().sync(); } } while (0)
#else
    if (threadIdx.x < 4) ((volatile LAS unsigned*)(lds + LDS_MISC_OFF))[threadIdx.x] = 0u;
    __syncthreads();
    XcdBarrier bar = xcd_barrier_post((unsigned*)WSP(WS_CTL) + CW_BAR, (volatile LAS unsigned*)(lds + LDS_MISC_OFF));
    if (lo < 0) cg::this_grid().sync();
#define SEAM(k, loc, arr) do { if (IN(k) && IN((k) + 1)) { xcd_barrier(bar, wave_id, (loc) ? lmode : 0u, (arr)); } } while (0)
#endif

    unsigned lmode = 0u; int bxv = bx, vcv = vcu;
    if (KIND(0) && IN(0)) { for (int rep = 0; rep < NREP(0); ++rep) p0_prologue(lds, vcu, G, wave_id); }
    SEAM(0, 0, 0u);
#if !USE_CG_SYNC
    if (IN(0) && IN(1)) {
        volatile LAS unsigned* st = (volatile LAS unsigned*)(lds + LDS_MISC_OFF);
        lmode = __builtin_amdgcn_readfirstlane(st[3]);
        if (lmode) { bxv = (int)__builtin_amdgcn_readfirstlane(st[2]) * 8 + (int)bar.x; vcv = (bxv % 8) * (G / 8) + bxv / 8; }
    }
#endif
    const bool fused_final = lmode && IN(10) && IN(11);
#pragma unroll 1
    for (int layer = 0; layer < 2; ++layer) {
        const int pb = 1 + 5 * layer;
        if (KIND(1) && IN(pb + 0)) {
            const int N = layer ? ODD_IN : EVEN_IN;
            unsigned char* ws = WSP(0); pg8::Gemm g{(const bf16_t*)(ws + WS_XB), (const bf16_t*)(ws + (layer ? WS_WIN1 : WS_WIN0)), M_TOK, N, D}; pg8::StaticOrder S; S.init(M_TOK, N, G, bxv);
            pg8::EpiScaleBf16 E{(bf16_t*)(ws + WS_Z), layer, (const float*)(ws + WS_SS)};
            pg8::gemm_phase<pg8::EpiScaleBf16, PG8_ALIGN, PG8_SP2>(lds, g, S, E, wave_id, (lmode && layer) ? (unsigned*)ws + (WS_CTL / 4 + CW_BAR + XB_DONE_B) : nullptr, (unsigned)G);
        }
        SEAM(pb + 0, 0, 0u);
        if (IN(pb + 1)) { if (layer == 0) { if (KIND(2)) for (int rep = 0; rep < NREP(2); ++rep) mixer_even(lds, vcv, G, wave_id); } else { if (KIND(3)) for (int rep = 0; rep < NREP(3); ++rep) mixer_odd(lds, vcv, G, wave_id); } }
        SEAM(pb + 1, 1, 0u);
        if (KIND(4) && IN(pb + 2)) {
            unsigned char* ws = WSP(0); pg8::Gemm g{(const bf16_t*)(ws + WS_Y), (const bf16_t*)(ws + (layer ? WS_WOUT1 : WS_WOUT0)), M_TOK, D, D}; pg8::StaticOrder S; S.init(M_TOK, D, G, bxv);
            pg8::EpiResid E{(bf16_t*)(ws + WS_XB), (float*)(ws + WS_SS)};
            pg8::gemm_phase<pg8::EpiResid, PG8_ALIGN, PG8_SP2>(lds, g, S, E, wave_id);
        }
        SEAM(pb + 2, 1, XB_DONE_A);
        if (KIND(5) && IN(pb + 3)) {
            unsigned char* ws = WSP(0); pg8::Gemm g{(const bf16_t*)(ws + WS_XB), (const bf16_t*)(ws + (layer ? WS_WGU1 : WS_WGU0)), M_TOK, GU, D}; pg8::StaticOrder S; S.init(M_TOK, GU, G, bxv);
            pg8::EpiSwiGLU E{(bf16_t*)(ws + WS_ACT), (const float*)(ws + WS_SS)};
            pg8::gemm_phase<pg8::EpiSwiGLU, PG8_ALIGN, PG8_SP2>(lds, g, S, E, wave_id, lmode ? (unsigned*)ws + (WS_CTL / 4 + CW_BAR + XB_DONE_A) : nullptr, (unsigned)G * (unsigned)(layer + 1));
        }
        SEAM(pb + 3, 1, 0u);
        if (KIND(6) && IN(pb + 4)) {
            unsigned char* ws = WSP(0); pg8::Gemm g{(const bf16_t*)(ws + WS_ACT), (const bf16_t*)(ws + (layer ? WS_WDN1 : WS_WDN0)), M_TOK, D, DFF}; pg8::StaticOrder S; S.init(M_TOK, D, G, bxv);
            if (layer == 1 && fused_final) {
                pg8::EpiFinal E{(const bf16_t*)(ws + WS_XB), (float*)(ws + WS_SS), fresh_args()->out, fresh_args()->final_norm_g, (unsigned*)ws + (WS_CTL / 4 + CW_BAR + XB_FIN(0))};
                pg8::gemm_phase<pg8::EpiFinal, PG8_ALIGN, PG8_SP2>(lds, g, S, E, wave_id);
            } else {
            pg8::EpiResid E{(bf16_t*)(ws + WS_XB), (float*)(ws + WS_SS)};
            pg8::gemm_phase<pg8::EpiResid, PG8_ALIGN, PG8_SP2>(lds, g, S, E, wave_id);
            }
        }
        if (!(layer == 1 && fused_final))
        SEAM(pb + 4, 1, layer ? 0u : XB_DONE_B);
    }
    if (KIND(7) && IN(11) && !fused_final) for (int rep = 0; rep < NREP(7); ++rep) final_norm(vcv, G, wave_id);
#undef IN
#undef SEAM
}

extern "C" void kernel_launch(void* const* d_in, const int* in_sizes, int n_in, void* d_out, int out_size, void* d_ws, size_t ws_size, hipStream_t stream) {
    static int grid = 0;
    if (grid == 0) {
        if (n_in != 22 || in_sizes[0] != M_TOK * D || out_size != M_TOK * D || ws_size < WS_END) {
            fprintf(stderr, "kernel_launch: unexpected shapes: n_in %d in0 %d out %d ws %zu (need %zu)\n", n_in, n_in > 0 ? in_sizes[0] : -1, out_size, ws_size, (size_t)WS_END); grid = -1; return; }
        int dev = 0, cus = 0, per_cu = 0;
        if (hipGetDevice(&dev) != hipSuccess || hipDeviceGetAttribute(&cus, hipDeviceAttributeMultiprocessorCount, dev) != hipSuccess) { fprintf(stderr, "kernel_launch: device query failed\n"); grid = -1; return; }
        if (hipFuncSetAttribute((const void*)trunk_fwd, hipFuncAttributeMaxDynamicSharedMemorySize, LDS_BYTES) != hipSuccess) { fprintf(stderr, "kernel_launch: hipFuncSetAttribute failed\n"); grid = -1; return; }
        if (hipOccupancyMaxActiveBlocksPerMultiprocessor(&per_cu, (const void*)trunk_fwd, NTHREADS, LDS_BYTES) != hipSuccess || per_cu < 1) { fprintf(stderr, "kernel_launch: occupancy query says %d blocks/CU\n", per_cu); per_cu = 1; }
        (void)hipGetLastError();
        grid = cus;
        fprintf(stderr, "kernel_launch: cus %d per_cu %d grid %d\n", cus, per_cu, grid);
    }
    if (grid < 0) return;
    Args a{};
    const float** f = (const float**)&a;
    for (int i = 0; i < 22; ++i) f[i] = (const float*)d_in[i];
    const size_t ws_off = ((ws_size - WS_END) / (2 * MiB)) * (2 * MiB);
    a.out = (float*)d_out; a.ws = (unsigned char*)d_ws + ws_off;
#if MK_PER_PHASE
    for (int p = 0; p < 12; ++p) {
        a.ph_lo = p; a.ph_hi = p + 1;
        for (int rep = 0; rep < 1 + ((PROBE_DUP >> p) & 1); ++rep)
            hipLaunchKernelGGL(trunk_fwd, dim3(grid), dim3(NTHREADS), LDS_BYTES, stream, a);
    }
#else
    a.ph_lo = 0; a.ph_hi = 12;
    if (hipMemsetAsync((char*)a.ws + WS_CTL, 0, 65536, stream) != hipSuccess) { fprintf(stderr, "kernel_launch: memset failed\n"); return; }
    void* kargs[] = {&a};
    hipError_t e = hipLaunchCooperativeKernel((const void*)trunk_fwd, dim3(grid), dim3(NTHREADS), kargs, LDS_BYTES, stream);
    if (e != hipSuccess) fprintf(stderr, "kernel_launch: cooperative launch failed: %s (grid %d)\n", hipGetErrorString(e), grid);
#endif
}
```
